# Optimizing an MI355X kernel written in HIP

```python
import jax, jax.numpy as jnp
from jax import lax
import numpy as np

D_MODEL = 1024
BATCH = 2
SEQ = 8192
DEPTH = 2

GRID_W = 64
CTX_LEN = 256
N_MODS = 9
FFN_HIDDEN = 2816
EPS = 1e-6

HEAD_DIM = 64
ATT_W = D_MODEL // 2
ATT_HEADS = ATT_W // HEAD_DIM
ATT_KV_HEADS = 2
ATT_GROUP = ATT_HEADS // ATT_KV_HEADS
WINDOW = 128
ATT_BLOCK = 128
ROPE_BASE = 10000.0

HG_W = D_MODEL // 4
HG_DV = 64
HG_HEADS = HG_W // HG_DV
HG_DK = 64
HG_KEY = HG_HEADS * HG_DK
HG_CHUNK = 64

RG_W = D_MODEL - ATT_W - HG_W
RG_BLOCKS = 4
RG_BW = RG_W // RG_BLOCKS
RG_CONV = 4
RG_CONV_LEFT = 2
RG_C = 8.0

SPLIT_SIZES = (ATT_W, ATT_KV_HEADS * HEAD_DIM, ATT_KV_HEADS * HEAD_DIM,
               HG_KEY, HG_KEY, HG_KEY, HG_W, HG_W,
               RG_W, RG_W)
IN_W = sum(SPLIT_SIZES)
SPLIT_POINTS = tuple(np.cumsum(SPLIT_SIZES)[:-1].tolist())
MIX_W = ATT_W + HG_W + RG_W

kernel_name = "hybrid_dit_hgrn2_rglru_swa_prefix"

F32 = jnp.float32


def _flip(t):
    return t[:, ::-1]


def _identity(t):
    return t


def rms_norm(x, g):
    xf = x.astype(F32)
    y = xf * lax.rsqrt(jnp.mean(xf * xf, axis=-1, keepdims=True) + EPS)
    return (y * g).astype(x.dtype)


def modulate(h, shift, scale):
    return h * (1 + scale) + shift


def adaln_mods(cond, w, b):
    m = jax.nn.silu(cond.reshape(-1, D_MODEL)) @ w + b
    m = m.reshape(-1, 1, N_MODS, D_MODEL)
    return [m[:, :, k] for k in range(N_MODS)]


def swiglu(h, w_in, w_out):
    a, b = jnp.split(h @ w_in, 2, axis=-1)
    return (jax.nn.silu(a) * b) @ w_out


def ffn_half(x, mods, g, w_in, w_out):
    shift, scale, gate = mods
    h = modulate(rms_norm(x, g), shift, scale)
    return x + 0.5 * gate * swiglu(h, w_in, w_out)


def axial_rope(rows):
    n_freq = HEAD_DIM // 4
    row = jnp.repeat(jnp.arange(rows), GRID_W)
    col = jnp.tile(jnp.arange(GRID_W), rows)
    inv_freq = ROPE_BASE ** (-jnp.arange(n_freq, dtype=F32) / n_freq)
    ang = jnp.stack([row[:, None] * inv_freq, col[:, None] * inv_freq], axis=1)
    return jnp.cos(ang), jnp.sin(ang)


def apply_rope(t, cos, sin):
    b, l, h, _ = t.shape
    tr = t.reshape(b, l, h, 2, 2, HEAD_DIM // 4)
    t1, t2 = tr[..., 0, :], tr[..., 1, :]
    c = cos[None, :, None].astype(t.dtype)
    s = sin[None, :, None].astype(t.dtype)
    out = jnp.stack([t1 * c - t2 * s, t2 * c + t1 * s], axis=-2)
    return out.reshape(t.shape)


def window_attention(qx, kx, vx, qc, kc, vc, sink, cos, sin, with_ctx_out):
    bsz, length, _ = qx.shape
    nb = length // ATT_BLOCK
    scale = HEAD_DIM ** -0.5
    qx = apply_rope(qx.reshape(bsz, length, ATT_HEADS, HEAD_DIM), cos, sin) * scale
    kx = apply_rope(kx.reshape(bsz, length, ATT_KV_HEADS, HEAD_DIM), cos, sin)
    vx = vx.reshape(bsz, length, ATT_KV_HEADS, HEAD_DIM)
    kc = kc.reshape(bsz, -1, ATT_KV_HEADS, HEAD_DIM)
    vc = vc.reshape(bsz, -1, ATT_KV_HEADS, HEAD_DIM)
    sink_f = sink.astype(F32).reshape(ATT_KV_HEADS, ATT_GROUP)

    def band(t):
        tp = jnp.pad(t, ((0, 0), (ATT_BLOCK, ATT_BLOCK), (0, 0), (0, 0)))
        tp = tp.reshape(bsz, nb + 2, ATT_BLOCK, ATT_KV_HEADS, HEAD_DIM)
        return jnp.concatenate([tp[:, :-2], tp[:, 1:-1], tp[:, 2:]], axis=2)

    qb = qx.reshape(bsz, nb, ATT_BLOCK, ATT_KV_HEADS, ATT_GROUP, HEAD_DIM)
    kb, vb = band(kx), band(vx)
    q_pos = jnp.arange(nb)[:, None] * ATT_BLOCK + jnp.arange(ATT_BLOCK)
    k_pos = jnp.arange(nb)[:, None] * ATT_BLOCK - ATT_BLOCK + jnp.arange(3 * ATT_BLOCK)
    kp = k_pos[:, None, :]
    valid = (jnp.abs(kp - q_pos[:, :, None]) <= WINDOW) & (kp >= 0) & (kp < length)

    s_loc = jnp.einsum('bnqhgd,bnkhd->bnhgqk', qb, kb, preferred_element_type=F32)
    s_loc = jnp.where(valid[None, :, None, None], s_loc, -jnp.inf)
    s_ctx = jnp.einsum('bnqhgd,bkhd->bnhgqk', qb, kc, preferred_element_type=F32)
    sink_b = sink_f[None, None, :, :, None, None]
    m = jnp.maximum(jnp.maximum(s_loc.max(-1, keepdims=True), s_ctx.max(-1, keepdims=True)), sink_b)
    p_loc = jnp.exp(s_loc - m)
    p_ctx = jnp.exp(s_ctx - m)
    denom = p_loc.sum(-1, keepdims=True) + p_ctx.sum(-1, keepdims=True) + jnp.exp(sink_b - m)
    o = (jnp.einsum('bnhgqk,bnkhd->bnqhgd', (p_loc / denom).astype(vx.dtype), vb)
         + jnp.einsum('bnhgqk,bkhd->bnqhgd', (p_ctx / denom).astype(vx.dtype), vc))
    yx = o.reshape(bsz, length, ATT_W)
    if not with_ctx_out:
        return yx, None
    qcg = (qc * scale).reshape(bsz, -1, ATT_KV_HEADS, ATT_GROUP, HEAD_DIM)
    s_cc = jnp.einsum('bqhgd,bkhd->bhgqk', qcg, kc, preferred_element_type=F32)
    sink_c = sink_f[None, :, :, None, None]
    m_c = jnp.maximum(s_cc.max(-1, keepdims=True), sink_c)
    p = jnp.exp(s_cc - m_c)
    p = p / (p.sum(-1, keepdims=True) + jnp.exp(sink_c - m_c))
    yc = jnp.einsum('bhgqk,bkhd->bqhgd', p.astype(vc.dtype), vc).reshape(bsz, -1, ATT_W)
    return yx, yc


def hgrn2_inputs(q, fz, i, lb):
    f = lb + (1 - lb) * jax.nn.sigmoid(fz.astype(F32))
    heads = lambda t: t.reshape(t.shape[0], t.shape[1], HG_HEADS, -1)
    return (heads(jax.nn.silu(q.astype(F32))), heads(1 - f), heads(i.astype(F32)), heads(jnp.log(f)))


def hgrn2_chunk_scan(q, k, v, logf, s0):
    bsz, length, nh, _ = q.shape
    n = length // HG_CHUNK

    def to_chunks(t):
        return t.reshape(bsz, n, HG_CHUNK, nh, t.shape[-1]).transpose(1, 0, 3, 2, 4)

    tri = jnp.tril(jnp.ones((HG_CHUNK, HG_CHUNK), dtype=bool))

    def step(state, blk):
        qc, kc, vc, gc = blk
        b = jnp.cumsum(gc, axis=2)
        o_inter = jnp.einsum('bhtk,bhkv->bhtv', qc * jnp.exp(b), state)
        rel = b[:, :, :, None, :] - b[:, :, None, :, :]
        decay = jnp.exp(jnp.where(tri[:, :, None], rel, -jnp.inf))
        att = jnp.einsum('bhtk,bhsk,bhtsk->bhts', qc, kc, decay)
        o_intra = jnp.einsum('bhts,bhsv->bhtv', att, vc)
        b_end = b[:, :, -1:, :]
        new_state = (jnp.exp(b_end[:, :, 0, :, None]) * state
                     + jnp.einsum('bhsk,bhsv->bhkv', kc * jnp.exp(b_end - b), vc))
        return new_state, o_inter + o_intra

    s_fin, o = lax.scan(step, s0, (to_chunks(q), to_chunks(k), to_chunks(v), to_chunks(logf)))
    o = o.transpose(1, 0, 3, 2, 4).reshape(bsz, length, nh, -1)
    return o, s_fin


def gated_head_norm(o, g, gate):
    y = o * lax.rsqrt(jnp.mean(o * o, axis=-1, keepdims=True) + EPS)
    y = y.reshape(o.shape[0], o.shape[1], -1)
    return (y * g * jax.nn.silu(gate.astype(F32))).astype(gate.dtype)


def hgrn2_mixer(lat, cxt, lb, norm_g, with_ctx_out):
    qx, ffx, fbx, ix, gx = lat
    qc, ffc, fbc, ic, gc = cxt
    s_zero = jnp.zeros((qx.shape[0], HG_HEADS, HG_DK, HG_DV), F32)
    outs_x, outs_c = [], []
    for d, (fzx, fzc) in enumerate(((ffx, ffc), (fbx, fbc))):
        rev = _flip if d == 1 else _identity
        o_c, state_c = hgrn2_chunk_scan(*[rev(t) for t in hgrn2_inputs(qc, fzc, ic, lb[d])], s_zero)
        o_x, _ = hgrn2_chunk_scan(*[rev(t) for t in hgrn2_inputs(qx, fzx, ix, lb[d])], state_c)
        outs_x.append(rev(o_x))
        outs_c.append(rev(o_c))
    yx = gated_head_norm(outs_x[0] + outs_x[1], norm_g, gx)
    yc = gated_head_norm(outs_c[0] + outs_c[1], norm_g, gc) if with_ctx_out else None
    return yx, yc


def centred_dwconv(x, w, b):
    length = x.shape[1]
    xp = jnp.pad(x, ((0, 0), (RG_CONV_LEFT, RG_CONV - 1 - RG_CONV_LEFT), (0, 0)))
    out = b
    for j in range(RG_CONV):
        out = out + xp[:, j:j + length] * w[j]
    return out


def rglru_scan(xs, wa, ba, wx, bx, lam, h0):
    bsz, length, _ = xs.shape
    xg = xs.reshape(bsz, length, RG_BLOCKS, RG_BW)
    r = jax.nn.sigmoid(jnp.einsum('blnd,nde->blne', xg, wa).reshape(bsz, length, RG_W) + ba)
    i = jax.nn.sigmoid(jnp.einsum('blnd,nde->blne', xg, wx).reshape(bsz, length, RG_W) + bx)
    log_a = -RG_C * r * jax.nn.softplus(-lam)
    a = jnp.exp(log_a)
    u = jnp.sqrt(-jnp.expm1(2.0 * log_a)) * (i * xs)
    u = u.at[:, 0].add(a[:, 0] * h0)

    def combine(p, q):
        a1, b1 = p
        a2, b2 = q
        return a1 * a2, a2 * b1 + b2

    _, h = lax.associative_scan(combine, (a, u), axis=1)
    return h


def rglru_mixer(lat, cxt, conv_w, conv_b, ga_w, ga_b, gx_w, gx_b, lam, with_ctx_out):
    xx, gate_x = lat
    xc, gate_c = cxt
    ux = centred_dwconv(xx.astype(F32), conv_w, conv_b)
    uc = centred_dwconv(xc.astype(F32), conv_w, conv_b)
    h0 = jnp.zeros((xx.shape[0], RG_W), F32)
    hx_list, hc_list = [], []
    for d in range(2):
        rev = _flip if d == 1 else _identity
        hc = rglru_scan(rev(uc), ga_w[d], ga_b[d], gx_w[d], gx_b[d], lam[d], h0)
        hx = rglru_scan(rev(ux), ga_w[d], ga_b[d], gx_w[d], gx_b[d], lam[d], hc[:, -1])
        hx_list.append(rev(hx))
        hc_list.append(rev(hc))
    yx = (jax.nn.gelu(gate_x.astype(F32)) * (hx_list[0] + hx_list[1])).astype(xx.dtype)
    if not with_ctx_out:
        return yx, None
    yc = (jax.nn.gelu(gate_c.astype(F32)) * (hc_list[0] + hc_list[1])).astype(xc.dtype)
    return yx, yc


def token_mixing(hx, hc, w_in, w_out, sink, lb, hg_norm, conv_w, conv_b, ga_w, ga_b, gx_w, gx_b, lam,
                 cos, sin, with_ctx_out):
    px = jnp.split(hx @ w_in, SPLIT_POINTS, axis=-1)
    pc = jnp.split(hc @ w_in, SPLIT_POINTS, axis=-1)
    ax, ac = window_attention(px[0], px[1], px[2], pc[0], pc[1], pc[2], sink, cos, sin, with_ctx_out)
    gx, gc = hgrn2_mixer(px[3:8], pc[3:8], lb, hg_norm, with_ctx_out)
    rx, rc = rglru_mixer(px[8:10], pc[8:10], conv_w, conv_b, ga_w, ga_b, gx_w, gx_b, lam, with_ctx_out)
    yx = jnp.concatenate([ax, gx, rx], axis=-1) @ w_out
    yc = jnp.concatenate([ac, gc, rc], axis=-1) @ w_out if with_ctx_out else None
    return yx, yc


def setup_inputs(seed: int = 0) -> dict:
    key = jax.random.key(seed)
    ks = jax.random.split(key, 32)
    D, F = D_MODEL, FFN_HIDDEN

    def nrm(k, shape, s):
        return jax.random.normal(k, shape, F32) * s

    def gain(k, shape):
        return 1.0 + 0.05 * jax.random.normal(k, shape, F32)

    u = jax.random.uniform(ks[21], (DEPTH, 2, RG_W), F32, minval=0.9, maxval=0.999)
    a = u ** (1.0 / RG_C)
    return {
        "x": nrm(ks[0], (BATCH, SEQ, D), 1.0),
        "c": nrm(ks[1], (BATCH, D), 1.0),
        "ctx": nrm(ks[2], (BATCH, CTX_LEN, D), 1.0),
        "c_ctx": nrm(ks[3], (D,), 1.0),
        "ada_w": nrm(ks[4], (DEPTH, D, N_MODS * D), 0.5 * D ** -0.5),
        "ada_b": nrm(ks[5], (DEPTH, N_MODS * D), 0.02),
        "norm_ffn1": gain(ks[6], (DEPTH, D)),
        "ffn1_w_in": nrm(ks[7], (DEPTH, D, 2 * F), D ** -0.5),
        "ffn1_w_out": nrm(ks[8], (DEPTH, F, D), F ** -0.5),
        "norm_mix": gain(ks[9], (DEPTH, D)),
        "w_in": nrm(ks[10], (DEPTH, D, IN_W), D ** -0.5),
        "w_out": nrm(ks[11], (DEPTH, MIX_W, D), MIX_W ** -0.5),
        "attn_sink": nrm(ks[12], (DEPTH, ATT_HEADS), 0.5),
        "hg_lb_logits": nrm(ks[13], (DEPTH, 2, HG_KEY), 0.5),
        "hg_norm": gain(ks[14], (DEPTH, HG_W)),
        "rg_conv_w": nrm(ks[15], (DEPTH, RG_CONV, RG_W), RG_CONV ** -0.5),
        "rg_conv_b": nrm(ks[16], (DEPTH, RG_W), 0.02),
        "rg_gate_a_w": nrm(ks[17], (DEPTH, 2, RG_BLOCKS, RG_BW, RG_BW), RG_BW ** -0.5),
        "rg_gate_a_b": nrm(ks[18], (DEPTH, 2, RG_W), 0.02),
        "rg_gate_x_w": nrm(ks[19], (DEPTH, 2, RG_BLOCKS, RG_BW, RG_BW), RG_BW ** -0.5),
        "rg_gate_x_b": nrm(ks[20], (DEPTH, 2, RG_W), 0.02),
        "rg_lambda": jnp.log(a) - jnp.log1p(-a),
        "norm_ffn2": gain(ks[22], (DEPTH, D)),
        "ffn2_w_in": nrm(ks[23], (DEPTH, D, 2 * F), D ** -0.5),
        "ffn2_w_out": nrm(ks[24], (DEPTH, F, D), F ** -0.5),
        "final_norm": gain(ks[25], (D,)),
    }


def reference(x, c, ctx, c_ctx, ada_w, ada_b, norm_ffn1, ffn1_w_in, ffn1_w_out, norm_mix, w_in, w_out,
              attn_sink, hg_lb_logits, hg_norm, rg_conv_w, rg_conv_b, rg_gate_a_w, rg_gate_a_b,
              rg_gate_x_w, rg_gate_x_b, rg_lambda, norm_ffn2, ffn2_w_in, ffn2_w_out, final_norm):
    rows = x.shape[1] // GRID_W
    cos, sin = axial_rope(rows)
    lb_p = jax.nn.softmax(hg_lb_logits.astype(F32), axis=0)
    hg_lb = jnp.cumsum(lb_p, axis=0) - lb_p[0]
    for l in range(DEPTH):
        with_ctx_out = l < DEPTH - 1
        mx = adaln_mods(c, ada_w[l], ada_b[l])
        mc = adaln_mods(c_ctx, ada_w[l], ada_b[l])
        x = ffn_half(x, mx[0:3], norm_ffn1[l], ffn1_w_in[l], ffn1_w_out[l])
        ctx = ffn_half(ctx, mc[0:3], norm_ffn1[l], ffn1_w_in[l], ffn1_w_out[l])
        hx = modulate(rms_norm(x, norm_mix[l]), mx[3], mx[4])
        hc = modulate(rms_norm(ctx, norm_mix[l]), mc[3], mc[4])
        yx, yc = token_mixing(hx, hc, w_in[l], w_out[l], attn_sink[l], hg_lb[l], hg_norm[l],
                              rg_conv_w[l], rg_conv_b[l], rg_gate_a_w[l], rg_gate_a_b[l],
                              rg_gate_x_w[l], rg_gate_x_b[l], rg_lambda[l], cos, sin, with_ctx_out)
        x = x + mx[5] * yx
        x = ffn_half(x, mx[6:9], norm_ffn2[l], ffn2_w_in[l], ffn2_w_out[l])
        if with_ctx_out:
            ctx = ctx + mc[5] * yc
            ctx = ffn_half(ctx, mc[6:9], norm_ffn2[l], ffn2_w_in[l], ffn2_w_out[l])
    return rms_norm(x, final_norm)
```

```cpp
#include <hip/hip_runtime.h>
#include <cstdio>
#include <cstdint>

namespace {
constexpr int DM = 1024, BATCH = 2, SEQ = 8192, DEPTH = 2, CTXL = 256, NMODS = 9, FH = 2816;
constexpr int MLAT = BATCH * SEQ, MCTX = BATCH * CTXL, MTOT = MLAT + MCTX;
constexpr int INW = 2560;
constexpr int C_Q = 0, C_K = 512, C_V = 640, C_HQ = 768, C_HF = 1024, C_HB = 1280, C_HI = 1536, C_HG = 1792, C_RX = 2048, C_RG = 2304;
constexpr float EPS = 1e-6f;

typedef unsigned short bf16_t;
typedef short bf16x8 __attribute__((ext_vector_type(8)));
typedef float f32x4 __attribute__((ext_vector_type(4)));
typedef unsigned u32x4 __attribute__((ext_vector_type(4)));

constexpr size_t MiB = 1u << 20;
constexpr size_t WS_CTL = 0;
constexpr size_t WS_MODS = 1 * MiB;
constexpr size_t WS_ROPE = 1 * MiB + 512 * 1024;
constexpr size_t WS_LB = WS_ROPE + 32 * 1024;
constexpr size_t WS_XCTX = 2 * MiB;
constexpr size_t WS_W = 4 * MiB;
constexpr size_t W_L_STRIDE = 40 * MiB;
constexpr size_t W_1IN = 0, W_1OUT = 11 * MiB, W_IN = 16 * MiB + 512 * 1024, W_OUT = 21 * MiB + 512 * 1024, W_2IN = 23 * MiB + 512 * 1024, W_2OUT = 34 * MiB + 512 * 1024;
constexpr size_t WS_XN = 84 * MiB;
constexpr size_t WS_H = 117 * MiB;
constexpr size_t WS_T = 208 * MiB;
constexpr size_t WS_END = 242 * MiB;

__device__ __forceinline__ float bf2f(bf16_t v) { return __uint_as_float(((unsigned)v) << 16); }
__device__ __forceinline__ bf16_t f2bf(float f) { unsigned u = __float_as_uint(f); return (bf16_t)((u + 0x7fffu + ((u >> 16) & 1u)) >> 16); }
__device__ __forceinline__ float sigmoidf_(float x) { return 1.f / (1.f + __expf(-x)); }
__device__ __forceinline__ float siluf_(float x) { return x / (1.f + __expf(-x)); }
__device__ __forceinline__ float gelu_tanh(float x) { const float u = 0.7978845608028654f * (x + 0.044715f * x * x * x); return 0.5f * x * (1.f + tanhf(u)); }
__device__ __forceinline__ float wave_sum(float v) {
#pragma unroll
    for (int o = 1; o < 64; o <<= 1) v += __shfl_xor(v, o);
    return v;
}

__global__ void __launch_bounds__(256) k_mods(const float* c, const float* c_ctx, const float* ada_w, const float* ada_b, float* mods) {
    __shared__ float sc[3][DM];
    for (int i = threadIdx.x; i < 3 * DM; i += 256) { const int mi = i / DM, k = i % DM; const float v = mi < 2 ? c[mi * DM + k] : c_ctx[k]; sc[mi][k] = siluf_(v); }
    __syncthreads();
    const int gid = blockIdx.x * 256 + threadIdx.x;
    const int l = gid / (NMODS * DM), n = gid % (NMODS * DM);
    const float* w = ada_w + (size_t)l * DM * NMODS * DM + n;
    float a0 = 0.f, a1 = 0.f, a2 = 0.f;
    for (int k = 0; k < DM; ++k) { const float wv = w[(size_t)k * NMODS * DM]; a0 += sc[0][k] * wv; a1 += sc[1][k] * wv; a2 += sc[2][k] * wv; }
    const float b = ada_b[l * NMODS * DM + n];
    float* m = mods + (size_t)l * 3 * NMODS * DM;
    m[0 * NMODS * DM + n] = a0 + b; m[1 * NMODS * DM + n] = a1 + b; m[2 * NMODS * DM + n] = a2 + b;
}
__global__ void __launch_bounds__(256) k_tables(const float* lb_logits, float* rope, float* lb) {
    const int tid = blockIdx.x * 256 + threadIdx.x;
    if (tid < 128 * 16) { const int pos = tid / 16, f = tid % 16; const float inv = powf(10000.f, -(float)f / 16.f); const float ang = (float)pos * inv; rope[tid] = cosf(ang); rope[2048 + tid] = sinf(ang); }
    if (tid < 2 * 256) {
        const float l0 = lb_logits[tid], l1 = lb_logits[512 + tid]; const float mx = fmaxf(l0, l1); const float e0 = expf(l0 - mx), e1 = expf(l1 - mx);
        lb[tid] = 0.f; lb[512 + tid] = e1 / (e0 + e1);
    }
}
template <int MODE> __global__ void __launch_bounds__(256) k_transpose(const float* W, bf16_t* WT, int K, int N) {
    __shared__ float t[32][33];
    const int n0 = blockIdx.x * 32, k0 = blockIdx.y * 32, tx = threadIdx.x & 31, ty = threadIdx.x >> 5;
    for (int i = ty; i < 32; i += 8) t[i][tx] = W[(size_t)(k0 + i) * N + n0 + tx];
    __syncthreads();
    for (int i = ty; i < 32; i += 8) { const int n = n0 + i; int nd = n;
        if (MODE == 1) { const int half = n >= FH, nn = half ? n - FH : n; nd = 256 * (nn / 128) + 128 * half + (nn % 128); }
        WT[(size_t)nd * K + k0 + tx] = f2bf(t[tx][i]); }
}

__global__ void __launch_bounds__(256) k_normmod(const float* xlat, const float* xctx, const float* g, const float* mods_l, int i_shift, int i_scale, bf16_t* XN, int nrows) {
    const int row = blockIdx.x * 4 + (threadIdx.x >> 6), lane = threadIdx.x & 63;
    if (row >= nrows) return;
    const float* xr = row < MLAT ? xlat + (size_t)row * DM : xctx + (size_t)(row - MLAT) * DM;
    const int mi = row < MLAT ? row / SEQ : 2;
    const float* sh = mods_l + (size_t)mi * NMODS * DM + i_shift * DM; const float* sc = mods_l + (size_t)mi * NMODS * DM + i_scale * DM;
    f32x4 v[4]; float ss = 0.f;
#pragma unroll
    for (int j = 0; j < 4; ++j) { v[j] = *(const f32x4*)(xr + 256 * j + 4 * lane); ss += v[j].x * v[j].x + v[j].y * v[j].y + v[j].z * v[j].z + v[j].w * v[j].w; }
    const float rstd = rsqrtf(wave_sum(ss) * (1.f / DM) + EPS);
#pragma unroll
    for (int j = 0; j < 4; ++j) { const int c0 = 256 * j + 4 * lane; const f32x4 gg = *(const f32x4*)(g + c0), s1 = *(const f32x4*)(sc + c0), s0 = *(const f32x4*)(sh + c0);
        bf16_t o[4];
#pragma unroll
        for (int e = 0; e < 4; ++e) o[e] = f2bf(v[j][e] * rstd * gg[e] * (1.f + s1[e]) + s0[e]);
        *(uint2*)(XN + (size_t)row * DM + c0) = make_uint2((unsigned)o[0] | ((unsigned)o[1] << 16), (unsigned)o[2] | ((unsigned)o[3] << 16)); }
}
__global__ void __launch_bounds__(256) k_final_norm(float* x, const float* g) {
    const int row = blockIdx.x * 4 + (threadIdx.x >> 6), lane = threadIdx.x & 63;
    float* xr = x + (size_t)row * DM;
    f32x4 v[4]; float ss = 0.f;
#pragma unroll
    for (int j = 0; j < 4; ++j) { v[j] = *(const f32x4*)(xr + 256 * j + 4 * lane); ss += v[j].x * v[j].x + v[j].y * v[j].y + v[j].z * v[j].z + v[j].w * v[j].w; }
    const float rstd = rsqrtf(wave_sum(ss) * (1.f / DM) + EPS);
#pragma unroll
    for (int j = 0; j < 4; ++j) { const int c0 = 256 * j + 4 * lane; const f32x4 gg = *(const f32x4*)(g + c0); *(f32x4*)(xr + c0) = v[j] * rstd * gg; }
}

struct EpiArgs {
    bf16_t* H;
    const float* src_lat; const float* src_ctx; float* dst_lat; float* dst_ctx; const float* mods_l; int i_gate; float gsc;
    bf16_t* P; const float* rope; const float* lb_l;
};
enum { EPI_SWIGLU = 0, EPI_RESID = 1, EPI_INPROJ = 2 };

template <int EPI> __global__ void __launch_bounds__(256) k_gemm(const bf16_t* A, const bf16_t* Bt, int K, EpiArgs e) {
    constexpr bool DUAL = (EPI == EPI_SWIGLU);
    __shared__ __attribute__((aligned(16))) bf16_t As[64][40];
    __shared__ __attribute__((aligned(16))) bf16_t Bs[DUAL ? 128 : 64][40];
    __shared__ float Cs[DUAL ? 2 : 1][64][65];
    const int tid = threadIdx.x, lane = tid & 63, w = tid >> 6, wr = w >> 1, wc = w & 1;
    const int row0 = blockIdx.y * 64, ct = blockIdx.x;
    int brow0;
    if (DUAL) brow0 = 256 * (ct >> 1) + 64 * (ct & 1); else brow0 = ct * 64;
    f32x4 acc[DUAL ? 2 : 1][2][2];
#pragma unroll
    for (int d = 0; d < (DUAL ? 2 : 1); ++d)
#pragma unroll
        for (int i = 0; i < 2; ++i)
#pragma unroll
            for (int j = 0; j < 2; ++j) acc[d][i][j] = (f32x4){0.f, 0.f, 0.f, 0.f};
    const int lr = tid >> 2, lk = (tid & 3) * 8;
    for (int k0 = 0; k0 < K; k0 += 32) {
        *(u32x4*)&As[lr][lk] = *(const u32x4*)(A + (size_t)(row0 + lr) * K + k0 + lk);
        *(u32x4*)&Bs[lr][lk] = *(const u32x4*)(Bt + (size_t)(brow0 + lr) * K + k0 + lk);
        if (DUAL) *(u32x4*)&Bs[64 + lr][lk] = *(const u32x4*)(Bt + (size_t)(brow0 + 128 + lr) * K + k0 + lk);
        __syncthreads();
        bf16x8 a[2], b[DUAL ? 2 : 1][2];
#pragma unroll
        for (int i = 0; i < 2; ++i) a[i] = *(const bf16x8*)&As[wr * 32 + i * 16 + (lane & 15)][(lane >> 4) * 8];
#pragma unroll
        for (int d = 0; d < (DUAL ? 2 : 1); ++d)
#pragma unroll
            for (int j = 0; j < 2; ++j) b[d][j] = *(const bf16x8*)&Bs[d * 64 + wc * 32 + j * 16 + (lane & 15)][(lane >> 4) * 8];
#pragma unroll
        for (int d = 0; d < (DUAL ? 2 : 1); ++d)
#pragma unroll
            for (int i = 0; i < 2; ++i)
#pragma unroll
                for (int j = 0; j < 2; ++j) acc[d][i][j] = __builtin_amdgcn_mfma_f32_16x16x32_bf16(a[i], b[d][j], acc[d][i][j], 0, 0, 0);
        __syncthreads();
    }
#pragma unroll
    for (int d = 0; d < (DUAL ? 2 : 1); ++d)
#pragma unroll
        for (int i = 0; i < 2; ++i)
#pragma unroll
            for (int j = 0; j < 2; ++j)
#pragma unroll
                for (int q = 0; q < 4; ++q) Cs[d][wr * 32 + i * 16 + (lane >> 4) * 4 + q][wc * 32 + j * 16 + (lane & 15)] = acc[d][i][j][q];
    __syncthreads();
    for (int el = tid; el < 64 * 64; el += 256) {
        const int r = el >> 6, c = el & 63, row = row0 + r, col = ct * 64 + c;
        if (EPI == EPI_SWIGLU) {
            e.H[(size_t)row * FH + col] = f2bf(siluf_(Cs[0][r][c]) * Cs[DUAL ? 1 : 0][r][c]);
        } else if (EPI == EPI_RESID) {
            const int mi = row < MLAT ? row / SEQ : 2;
            const float gate = e.mods_l[(size_t)mi * NMODS * DM + e.i_gate * DM + col];
            const size_t off = row < MLAT ? (size_t)row * DM + col : (size_t)(row - MLAT) * DM + col;
            const float base = row < MLAT ? e.src_lat[off] : e.src_ctx[off];
            const float o = base + e.gsc * gate * Cs[0][r][c];
            if (row < MLAT) e.dst_lat[off] = o; else e.dst_ctx[off] = o;
        } else {
            const float v = Cs[0][r][c]; float o = v;
            const bool lat = row < MLAT;
            if (col < C_V) {
                if (lat) { const int t = row % SEQ, d = c, ax = d >> 5, half = (d >> 4) & 1, f = d & 15; const int pos = ax == 0 ? (t >> 6) : (t & 63);
                    const float cs = e.rope[pos * 16 + f], sn = e.rope[2048 + pos * 16 + f]; const float vp = Cs[0][r][half ? c - 16 : c + 16];
                    o = half ? v * cs + vp * sn : v * cs - vp * sn; }
                if (col < C_K) o *= 0.125f;
            } else if (col >= C_HQ && col < C_HF) { o = siluf_(v); }
            else if (col >= C_HF && col < C_HI) { const int dir = col >= C_HB, ch = col - (dir ? C_HB : C_HF); const float lbv = e.lb_l[dir * 256 + ch]; o = __logf(lbv + (1.f - lbv) * sigmoidf_(v)); }
            else if (col >= C_HG && col < C_RX) { o = siluf_(v); }
            else if (col >= C_RG) { o = gelu_tanh(v); }
            e.P[(size_t)row * INW + col] = f2bf(o);
        }
    }
}

__global__ void __launch_bounds__(64) k_attn_naive(const bf16_t* P, const float* sink_l, bf16_t* Y, int nrows) {
    const int gid = blockIdx.x * 64 + threadIdx.x; const int row = gid >> 3, h = gid & 7, kvh = h >> 2;
    if (row >= nrows) return;
    const bool lat = row < MLAT; const int b = lat ? row / SEQ : (row - MLAT) / CTXL, t = lat ? row % SEQ : 0;
    float q[64], o[64];
#pragma unroll
    for (int d = 0; d < 64; ++d) { q[d] = bf2f(P[(size_t)row * INW + C_Q + h * 64 + d]); o[d] = 0.f; }
    float m = sink_l[h], l = 1.f;
    const int nloc = lat ? 257 : 0;
    for (int i = 0; i < nloc + CTXL; ++i) {
        int kr;
        if (i < nloc) { const int kp = t - 128 + i; if (kp < 0 || kp >= SEQ) continue; kr = b * SEQ + kp; } else kr = MLAT + b * CTXL + (i - nloc);
        const bf16_t* kp_ = P + (size_t)kr * INW + C_K + kvh * 64; const bf16_t* vp_ = P + (size_t)kr * INW + C_V + kvh * 64;
        float s = 0.f;
#pragma unroll
        for (int d = 0; d < 64; ++d) s += q[d] * bf2f(kp_[d]);
        const float mn = fmaxf(m, s), sc = __expf(m - mn), p = __expf(s - mn);
        l = l * sc + p; m = mn;
#pragma unroll
        for (int d = 0; d < 64; ++d) o[d] = o[d] * sc + p * bf2f(vp_[d]);
    }
    const float il = 1.f / l;
#pragma unroll
    for (int d = 0; d < 64; ++d) Y[(size_t)row * DM + h * 64 + d] = f2bf(o[d] * il);
}

__global__ void __launch_bounds__(64) k_hgrn_naive(const bf16_t* P, const float* hg_norm_l, float* Ofwd, bf16_t* Y, int with_ctx) {
    const int b = blockIdx.x >> 2, h = blockIdx.x & 3, v = threadIdx.x;
    __shared__ float sq[64], sf[64];
    for (int dir = 0; dir < 2; ++dir) {
        float S[64];
#pragma unroll
        for (int k = 0; k < 64; ++k) S[k] = 0.f;
        for (int step = 0; step < CTXL + SEQ; ++step) {
            int row;
            if (step < CTXL) { const int tc = dir == 0 ? step : CTXL - 1 - step; row = MLAT + b * CTXL + tc; }
            else { const int tt = step - CTXL; const int t = dir == 0 ? tt : SEQ - 1 - tt; row = b * SEQ + t; }
            const bf16_t* pr = P + (size_t)row * INW;
            __syncthreads();
            sq[v] = bf2f(pr[C_HQ + h * 64 + v]); sf[v] = __expf(bf2f(pr[(dir ? C_HB : C_HF) + h * 64 + v]));
            __syncthreads();
            const float vv = bf2f(pr[C_HI + h * 64 + v]);
            float o = 0.f;
#pragma unroll
            for (int k = 0; k < 64; ++k) { const float f = sf[k]; S[k] = f * S[k] + (1.f - f) * vv; o += S[k] * sq[k]; }
            const bool need = row < MLAT || with_ctx;
            if (dir == 0) { if (need) Ofwd[(size_t)row * 256 + h * 64 + v] = o; }
            else if (need) {
                const float os = o + Ofwd[(size_t)row * 256 + h * 64 + v];
                const float ms = wave_sum(os * os) * (1.f / 64.f);
                const float y = os * rsqrtf(ms + EPS) * hg_norm_l[h * 64 + v] * bf2f(pr[C_HG + h * 64 + v]);
                Y[(size_t)row * DM + 512 + h * 64 + v] = f2bf(y);
            }
        }
    }
}

__global__ void __launch_bounds__(64) k_rg_naive(const bf16_t* P, const float* conv_w, const float* conv_b, const float* ga_w, const float* ga_b, const float* gx_w, const float* gx_b, const float* lam,
                                                float* Hfwd, bf16_t* Y, int with_ctx) {
    const int b = blockIdx.x >> 2, n = blockIdx.x & 3, e = threadIdx.x, c = n * 64 + e;
    __shared__ float sx[64];
    const float cw0 = conv_w[0 * 256 + c], cw1 = conv_w[1 * 256 + c], cw2 = conv_w[2 * 256 + c], cw3 = conv_w[3 * 256 + c], cb = conv_b[c];
    for (int dir = 0; dir < 2; ++dir) {
        float wa[64], wx[64];
#pragma unroll
        for (int d = 0; d < 64; ++d) { wa[d] = ga_w[((size_t)(dir * 4 + n) * 64 + d) * 64 + e]; wx[d] = gx_w[((size_t)(dir * 4 + n) * 64 + d) * 64 + e]; }
        const float ba = ga_b[dir * 256 + c], bx = gx_b[dir * 256 + c];
        const float lm = lam[dir * 256 + c]; const float sp = log1pf(__expf(-lm));
        float hst = 0.f;
        for (int step = 0; step < CTXL + SEQ; ++step) {
            int row, t, len, base;
            if (step < CTXL) { t = dir == 0 ? step : CTXL - 1 - step; len = CTXL; base = MLAT + b * CTXL; }
            else { const int tt = step - CTXL; t = dir == 0 ? tt : SEQ - 1 - tt; len = SEQ; base = b * SEQ; }
            row = base + t;
            float u = cb;
            if (t - 2 >= 0) u += cw0 * bf2f(P[(size_t)(row - 2) * INW + C_RX + c]);
            if (t - 1 >= 0) u += cw1 * bf2f(P[(size_t)(row - 1) * INW + C_RX + c]);
            u += cw2 * bf2f(P[(size_t)row * INW + C_RX + c]);
            if (t + 1 < len) u += cw3 * bf2f(P[(size_t)(row + 1) * INW + C_RX + c]);
            __syncthreads();
            sx[e] = u;
            __syncthreads();
            float ra = ba, ri = bx;
#pragma unroll
            for (int d = 0; d < 64; ++d) { const float xv = sx[d]; ra += xv * wa[d]; ri += xv * wx[d]; }
            const float r = sigmoidf_(ra), ig = sigmoidf_(ri);
            const float log_a = -8.f * r * sp; const float a = __expf(log_a);
            const float uu = sqrtf(fmaxf(-expm1f(2.f * log_a), 0.f)) * (ig * u);
            hst = a * hst + uu;
            const bool need = row < MLAT || with_ctx;
            if (dir == 0) { if (need) Hfwd[(size_t)row * 256 + c] = hst; }
            else if (need) { const float y = bf2f(P[(size_t)row * INW + C_RG + c]) * (hst + Hfwd[(size_t)row * 256 + c]); Y[(size_t)row * DM + 768 + c] = f2bf(y); }
        }
    }
}
}

extern "C" void kernel_launch(void* const* d_in, const int* in_sizes, int n_in, void* d_out, int out_size, void* d_ws, size_t ws_size, hipStream_t stream) {
    if (n_in != 26 || out_size != MLAT * DM || ws_size < WS_END) { fprintf(stderr, "kernel_launch: unexpected problem (n_in %d out %d ws %zu)\n", n_in, out_size, ws_size); return; }
    const float* x = (const float*)d_in[0]; const float* c = (const float*)d_in[1]; const float* ctx = (const float*)d_in[2]; const float* c_ctx = (const float*)d_in[3];
    const float* ada_w = (const float*)d_in[4]; const float* ada_b = (const float*)d_in[5]; const float* norm_ffn1 = (const float*)d_in[6];
    const float* ffn1_w_in = (const float*)d_in[7]; const float* ffn1_w_out = (const float*)d_in[8]; const float* norm_mix = (const float*)d_in[9];
    const float* w_in = (const float*)d_in[10]; const float* w_out = (const float*)d_in[11]; const float* attn_sink = (const float*)d_in[12];
    const float* hg_lb_logits = (const float*)d_in[13]; const float* hg_norm = (const float*)d_in[14]; const float* rg_conv_w = (const float*)d_in[15];
    const float* rg_conv_b = (const float*)d_in[16]; const float* rg_ga_w = (const float*)d_in[17]; const float* rg_ga_b = (const float*)d_in[18];
    const float* rg_gx_w = (const float*)d_in[19]; const float* rg_gx_b = (const float*)d_in[20]; const float* rg_lambda = (const float*)d_in[21];
    const float* norm_ffn2 = (const float*)d_in[22]; const float* ffn2_w_in = (const float*)d_in[23]; const float* ffn2_w_out = (const float*)d_in[24]; const float* final_norm = (const float*)d_in[25];
    unsigned char* ws = (unsigned char*)d_ws; float* out = (float*)d_out;
    float* mods = (float*)(ws + WS_MODS); float* rope = (float*)(ws + WS_ROPE); float* lb = (float*)(ws + WS_LB); float* xctx = (float*)(ws + WS_XCTX);
    bf16_t* XN = (bf16_t*)(ws + WS_XN); bf16_t* Y = XN; bf16_t* H = (bf16_t*)(ws + WS_H); bf16_t* P = H;
    float* T0 = (float*)(ws + WS_T); float* T1 = T0 + (size_t)MTOT * 256;

    k_mods<<<DEPTH * NMODS * DM / 256, 256, 0, stream>>>(c, c_ctx, ada_w, ada_b, mods);
    k_tables<<<8, 256, 0, stream>>>(hg_lb_logits, rope, lb);
    for (int l = 0; l < DEPTH; ++l) {
        unsigned char* wl = ws + WS_W + l * W_L_STRIDE;
        k_transpose<1><<<dim3(2 * FH / 32, DM / 32), 256, 0, stream>>>(ffn1_w_in + (size_t)l * DM * 2 * FH, (bf16_t*)(wl + W_1IN), DM, 2 * FH);
        k_transpose<0><<<dim3(DM / 32, FH / 32), 256, 0, stream>>>(ffn1_w_out + (size_t)l * FH * DM, (bf16_t*)(wl + W_1OUT), FH, DM);
        k_transpose<0><<<dim3(INW / 32, DM / 32), 256, 0, stream>>>(w_in + (size_t)l * DM * INW, (bf16_t*)(wl + W_IN), DM, INW);
        k_transpose<0><<<dim3(DM / 32, DM / 32), 256, 0, stream>>>(w_out + (size_t)l * DM * DM, (bf16_t*)(wl + W_OUT), DM, DM);
        k_transpose<1><<<dim3(2 * FH / 32, DM / 32), 256, 0, stream>>>(ffn2_w_in + (size_t)l * DM * 2 * FH, (bf16_t*)(wl + W_2IN), DM, 2 * FH);
        k_transpose<0><<<dim3(DM / 32, FH / 32), 256, 0, stream>>>(ffn2_w_out + (size_t)l * FH * DM, (bf16_t*)(wl + W_2OUT), FH, DM);
    }
    for (int l = 0; l < DEPTH; ++l) {
        unsigned char* wl = ws + WS_W + l * W_L_STRIDE;
        const float* mods_l = mods + (size_t)l * 3 * NMODS * DM;
        const bool wc = l < DEPTH - 1;
        const float* src_lat = l == 0 ? x : out; const float* src_ctx = l == 0 ? ctx : xctx;
        EpiArgs e{};
        k_normmod<<<MTOT / 4, 256, 0, stream>>>(src_lat, src_ctx, norm_ffn1 + l * DM, mods_l, 0, 1, XN, MTOT);
        e = EpiArgs{}; e.H = H;
        k_gemm<EPI_SWIGLU><<<dim3(FH / 64, MTOT / 64), 256, 0, stream>>>(XN, (const bf16_t*)(wl + W_1IN), DM, e);
        e = EpiArgs{}; e.src_lat = src_lat; e.src_ctx = src_ctx; e.dst_lat = out; e.dst_ctx = xctx; e.mods_l = mods_l; e.i_gate = 2; e.gsc = 0.5f;
        k_gemm<EPI_RESID><<<dim3(DM / 64, MTOT / 64), 256, 0, stream>>>(H, (const bf16_t*)(wl + W_1OUT), FH, e);
        k_normmod<<<MTOT / 4, 256, 0, stream>>>(out, xctx, norm_mix + l * DM, mods_l, 3, 4, XN, MTOT);
        e = EpiArgs{}; e.P = P; e.rope = rope; e.lb_l = lb + l * 512;
        k_gemm<EPI_INPROJ><<<dim3(INW / 64, MTOT / 64), 256, 0, stream>>>(XN, (const bf16_t*)(wl + W_IN), DM, e);
        const int nrows_mix = wc ? MTOT : MLAT;
        k_attn_naive<<<nrows_mix * 8 / 64, 64, 0, stream>>>(P, attn_sink + l * 8, Y, nrows_mix);
        k_hgrn_naive<<<8, 64, 0, stream>>>(P, hg_norm + l * 256, T0, Y, wc ? 1 : 0);
        k_rg_naive<<<8, 64, 0, stream>>>(P, rg_conv_w + l * 1024, rg_conv_b + l * 256, rg_ga_w + (size_t)l * 2 * 4 * 64 * 64, rg_ga_b + l * 512, rg_gx_w + (size_t)l * 2 * 4 * 64 * 64, rg_gx_b + l * 512,
                                          rg_lambda + l * 512, T1, Y, wc ? 1 : 0);
        e = EpiArgs{}; e.src_lat = out; e.src_ctx = xctx; e.dst_lat = out; e.dst_ctx = xctx; e.mods_l = mods_l; e.i_gate = 5; e.gsc = 1.f;
        k_gemm<EPI_RESID><<<dim3(DM / 64, nrows_mix / 64), 256, 0, stream>>>(Y, (const bf16_t*)(wl + W_OUT), DM, e);
        k_normmod<<<nrows_mix / 4, 256, 0, stream>>>(out, xctx, norm_ffn2 + l * DM, mods_l, 6, 7, XN, nrows_mix);
        e = EpiArgs{}; e.H = H;
        k_gemm<EPI_SWIGLU><<<dim3(FH / 64, nrows_mix / 64), 256, 0, stream>>>(XN, (const bf16_t*)(wl + W_2IN), DM, e);
        e = EpiArgs{}; e.src_lat = out; e.src_ctx = xctx; e.dst_lat = out; e.dst_ctx = xctx; e.mods_l = mods_l; e.i_gate = 8; e.gsc = 0.5f;
        k_gemm<EPI_RESID><<<dim3(DM / 64, nrows_mix / 64), 256, 0, stream>>>(H, (const bf16_t*)(wl + W_2OUT), FH, e);
    }
    k_final_norm<<<MLAT / 4, 256, 0, stream>>>(out, final_norm);
}
```

```cpp
#include <hip/hip_runtime.h>
#include <cstdio>
#include <cstdint>
#include <hip/hip_cooperative_groups.h>
namespace cg = cooperative_groups;

namespace {
constexpr int DM = 1024, BATCH = 2, SEQ = 8192, DEPTH = 2, CTXL = 256, NMODS = 9, FH = 2816;
constexpr int MLAT = BATCH * SEQ, MCTX = BATCH * CTXL, MTOT = MLAT + MCTX;
constexpr int INW = 2560;
constexpr int C_Q = 0, C_K = 512, C_V = 640, C_HQ = 768, C_HF = 1024, C_HB = 1280, C_HI = 1536, C_HG = 1792, C_RX = 2048, C_RG = 2304;
constexpr float EPS = 1e-6f;

typedef unsigned short bf16_t;
typedef short bf16x8 __attribute__((ext_vector_type(8)));
typedef float f32x4 __attribute__((ext_vector_type(4)));
typedef unsigned u32x4 __attribute__((ext_vector_type(4)));

constexpr size_t MiB = 1u << 20;
constexpr size_t WS_CTL = 0;
constexpr size_t WS_MODS = 1 * MiB;
constexpr size_t WS_ROPE = 1 * MiB + 512 * 1024;
constexpr size_t WS_LB = WS_ROPE + 32 * 1024;
constexpr size_t WS_XCTX = 2 * MiB;
constexpr size_t WS_W = 4 * MiB;
constexpr size_t W_L_STRIDE = 40 * MiB;
constexpr size_t W_1IN = 0, W_1OUT = 11 * MiB, W_IN = 16 * MiB + 512 * 1024, W_OUT = 21 * MiB + 512 * 1024, W_2IN = 23 * MiB + 512 * 1024, W_2OUT = 34 * MiB + 512 * 1024;
constexpr size_t WS_XN = 84 * MiB;
constexpr size_t WS_H = 117 * MiB;
constexpr size_t WS_T = 208 * MiB;
constexpr size_t WS_END = 242 * MiB;

__device__ __forceinline__ float bf2f(bf16_t v) { return __uint_as_float(((unsigned)v) << 16); }
__device__ __forceinline__ bf16_t f2bf(float f) { unsigned u = __float_as_uint(f); return (bf16_t)((u + 0x7fffu + ((u >> 16) & 1u)) >> 16); }
__device__ __forceinline__ float sigmoidf_(float x) { return 1.f / (1.f + __expf(-x)); }
__device__ __forceinline__ float siluf_(float x) { return x / (1.f + __expf(-x)); }
__device__ __forceinline__ float gelu_tanh(float x) { const float u = 0.7978845608028654f * (x + 0.044715f * x * x * x); return 0.5f * x * (1.f + tanhf(u)); }
__device__ __forceinline__ float wave_sum(float v) {
#pragma unroll
    for (int o = 1; o < 64; o <<= 1) v += __shfl_xor(v, o);
    return v;
}

namespace pg8 {
#define PG8_LAS __attribute__((address_space(3)))
typedef unsigned short bf16_t;
typedef short bf16x8 __attribute__((ext_vector_type(8)));
typedef float f32x4 __attribute__((ext_vector_type(4)));
typedef unsigned u32x4 __attribute__((ext_vector_type(4)));
constexpr int BM = 256, BK = 64, HALF = 128, HTB = HALF * BK * 2  , STAGE_BYTES = 8 * HTB, NXCD = 8, WGM = 8;

__host__ __device__ __forceinline__ int lds_byte(int r, int c) { const int st = (r >> 4) * 2 + (c >> 5), rr = r & 15, cc = c & 31, ob = rr * 64 + cc * 2; return st * 1024 + (ob ^ (((ob >> 9) & 1) << 5)); }
__host__ __device__ __forceinline__ void stage_rc(int b, int& R, int& C) { const int st = b / 1024, sb = b % 1024, swz = sb ^ (((sb >> 9) & 1) << 5); R = (st >> 1) * 16 + swz / 64; C = (st & 1) * 32 + (swz % 64) / 2; }
__host__ __device__ __forceinline__ int perm32(int rho) { const int n = rho >> 4, i = rho & 15; return 8 * (i >> 2) + 4 * n + (i & 3); }

struct Unit { int pm, pn; };
struct Gemm { const bf16_t* A; const bf16_t* Bt; int M, N, K; };

struct StaticOrder {
    int nM, nN, nwg, G, c;
    __host__ __device__ void init(int M, int N, int G_, int c_) { nM = M / BM; nN = N / BM; nwg = nM * nN; G = G_; c = c_; }
    __host__ __device__ bool next(int i, Unit& u) const {
        const long L = (long)i * G + c; if (L >= nwg) return false;
        int wgid = (int)L; { const int q = nwg / NXCD, r = nwg % NXCD, xcd = wgid % NXCD, off = wgid / NXCD; wgid = (xcd < r ? xcd * (q + 1) : r * (q + 1) + (xcd - r) * q) + off; }
        const int nig = WGM * nN, gid = wgid / nig, fm = gid * WGM, gsz = (nM - fm) < WGM ? (nM - fm) : WGM;
        u.pm = fm + ((wgid % nig) % gsz); u.pn = (wgid % nig) / gsz; return true;
    }
    __device__ __forceinline__ void a_ready(const Unit&) const {}
    __device__ __forceinline__ void done(const Unit&) const {}
};

template <class Epi, class Sched, bool ALIGN_EPI = false, bool SP2 = false>
__device__ __forceinline__ void gemm_phase(PG8_LAS unsigned char* lds, const Gemm g, const Sched& S, const Epi& E) {
    int tid_ = threadIdx.x; asm volatile("" : "+v"(tid_));
    const int tid = tid_, wid = __builtin_amdgcn_readfirstlane(tid >> 6), lane = tid & 63, wr = wid >> 2, wc = wid & 3, fr = lane & 15, fq = lane >> 4;
    const int K = g.K, nt = K / BK;
    unsigned voffA[2], voffB[2];
#pragma unroll
    for (int i = 0; i < 2; ++i) { int R, C; stage_rc(tid * 16 + i * 8192, R, C); const int Rb = Epi::PERM ? ((R & ~31) + perm32(R & 31)) : R;
        voffA[i] = (unsigned)(R * K + C) * 2u; voffB[i] = (unsigned)(Rb * K + C) * 2u; }
    const size_t kstep = (size_t)(BK * 2);
    const size_t hstep = (size_t)HALF * K * 2;
    const size_t tstep = 2 * hstep;
    const unsigned ldsw = (unsigned)wid * 1024u;
    const int aoff = lds_byte(wr * 64 + fr, fq * 8), boff = lds_byte(wc * 32 + fr, fq * 8);
#define PG8_SA(b, h) (((b) * 2 + (h)) * HTB)
#define PG8_SB(b, h) ((4 + (b) * 2 + (h)) * HTB)
#define PG8_STAGE(bufoff, gbase, voff) do { _Pragma("unroll") for (int _i = 0; _i < 2; ++_i) \
        __builtin_amdgcn_global_load_lds((const unsigned*)((const char*)(gbase) + (voff)[_i]), (PG8_LAS unsigned*)(lds + (bufoff) + ldsw + _i * 8192), 16, 0, 0); } while (0)
#define PG8_LDA(dst, b, h) do { _Pragma("unroll") for (int m = 0; m < 4; ++m) _Pragma("unroll") for (int k = 0; k < 2; ++k) dst[m][k] = *(const PG8_LAS bf16x8*)(lds + PG8_SA(b, h) + aoff + m * 2048 + k * 1024); } while (0)
#define PG8_LDB(dst, b, h) do { _Pragma("unroll") for (int n = 0; n < 2; ++n) _Pragma("unroll") for (int k = 0; k < 2; ++k) dst[n][k] = *(const PG8_LAS bf16x8*)(lds + PG8_SB(b, h) + boff + n * 2048 + k * 1024); } while (0)
#define PG8_MMA(ai, bj, At, Bt) do { __builtin_amdgcn_s_setprio(1); _Pragma("unroll") for (int m = 0; m < 4; ++m) _Pragma("unroll") for (int n = 0; n < 2; ++n) _Pragma("unroll") for (int k = 0; k < 2; ++k) \
        acc[ai][bj][m][n] = __builtin_amdgcn_mfma_f32_16x16x32_bf16(Bt[n][k], At[m][k], acc[ai][bj][m][n], 0, 0, 0); __builtin_amdgcn_s_setprio(0); } while (0)
#define PG8_WAIT_V(n) asm volatile("s_waitcnt vmcnt(" #n ")" ::: "memory")
#define PG8_WAIT_L(n) asm volatile("s_waitcnt lgkmcnt(" #n ")" ::: "memory")
#define PG8_BAR __builtin_amdgcn_s_barrier()
#define PG8_SCHED __builtin_amdgcn_sched_barrier(0)
    Unit cur, nxt; int ui = 0;
    if (!S.next(0, cur)) return;
    f32x4 acc[2][2][4][2];
#pragma unroll
    for (int a = 0; a < 2; ++a)
#pragma unroll
        for (int b = 0; b < 2; ++b)
#pragma unroll
            for (int m = 0; m < 4; ++m)
#pragma unroll
                for (int n = 0; n < 2; ++n) acc[a][b][m][n] = (f32x4){0.f, 0.f, 0.f, 0.f};
    bf16x8 At[4][2], B0[2][2], B1[2][2];
    const char* cA = (const char*)g.A + (size_t)cur.pm * tstep; const char* cB = (const char*)g.Bt + (size_t)cur.pn * tstep;
    S.a_ready(cur);
    if constexpr (SP2) {
        PG8_STAGE(PG8_SB(0, 0), cB, voffB); PG8_STAGE(PG8_SB(0, 1), cB + hstep, voffB); PG8_STAGE(PG8_SA(0, 0), cA, voffA); PG8_STAGE(PG8_SA(0, 1), cA + hstep, voffA);
        if (wr == 1) PG8_BAR;
        PG8_WAIT_V(2); PG8_BAR;
        PG8_STAGE(PG8_SB(1, 0), cB + kstep, voffB); PG8_STAGE(PG8_SA(1, 0), cA + kstep, voffA); PG8_STAGE(PG8_SB(1, 1), cB + hstep + kstep, voffB);
        PG8_WAIT_V(6); PG8_BAR;
    } else {
        PG8_STAGE(PG8_SB(0, 0), cB, voffB); PG8_STAGE(PG8_SA(0, 0), cA, voffA); PG8_STAGE(PG8_SB(0, 1), cB + hstep, voffB); PG8_STAGE(PG8_SA(0, 1), cA + hstep, voffA);
        if (wr == 1) PG8_BAR;
        PG8_WAIT_V(4); PG8_BAR;
        PG8_STAGE(PG8_SB(1, 0), cB + kstep, voffB); PG8_STAGE(PG8_SA(1, 0), cA + kstep, voffA); PG8_STAGE(PG8_SB(1, 1), cB + hstep + kstep, voffB);
        PG8_WAIT_V(6); PG8_BAR;
    }
    for (;;) {
        const bool has_next = S.next(ui + 1, nxt);
        const char* nA = has_next ? (const char*)g.A + (size_t)nxt.pm * tstep : cA; const char* nB = has_next ? (const char*)g.Bt + (size_t)nxt.pn * tstep : cB;
        for (int t = 0; t < nt; t += 2) {
            const bool last = (t == nt - 2);
            const char* a1 = cA + (size_t)(t + 1) * kstep;
            const char* a2 = last ? nA : cA + (size_t)(t + 2) * kstep; const char* b2 = last ? nB : cB + (size_t)(t + 2) * kstep;
            const char* a3 = a2 + kstep; const char* b3 = b2 + kstep;
            if (last && has_next) S.a_ready(nxt);
            if constexpr (SP2) {
            PG8_LDB(B0, 0, 0); PG8_LDB(B1, 0, 1); PG8_SCHED; PG8_LDA(At, 0, 0); PG8_STAGE(PG8_SA(1, 1), a1 + hstep, voffA);
            PG8_WAIT_V(8); PG8_WAIT_L(0); PG8_BAR; PG8_MMA(0, 0, At, B0); PG8_MMA(0, 1, At, B1); PG8_BAR; PG8_SCHED;
            PG8_LDA(At, 0, 1); PG8_STAGE(PG8_SB(0, 0), b2, voffB); PG8_STAGE(PG8_SB(0, 1), b2 + hstep, voffB); PG8_STAGE(PG8_SA(0, 0), a2, voffA);
            PG8_WAIT_V(8); PG8_WAIT_L(0); PG8_BAR; PG8_MMA(1, 0, At, B0); PG8_MMA(1, 1, At, B1); PG8_BAR; PG8_SCHED;
            PG8_LDB(B0, 1, 0); PG8_LDB(B1, 1, 1); PG8_SCHED; PG8_LDA(At, 1, 0); PG8_STAGE(PG8_SA(0, 1), a2 + hstep, voffA);
            PG8_WAIT_V(8); PG8_WAIT_L(0); PG8_BAR; PG8_MMA(0, 0, At, B0); PG8_MMA(0, 1, At, B1); PG8_BAR; PG8_SCHED;
            PG8_LDA(At, 1, 1); PG8_STAGE(PG8_SB(1, 0), b3, voffB); PG8_STAGE(PG8_SB(1, 1), b3 + hstep, voffB); PG8_STAGE(PG8_SA(1, 0), a3, voffA);
            PG8_WAIT_V(8); PG8_WAIT_L(0); PG8_BAR; PG8_MMA(1, 0, At, B0); PG8_MMA(1, 1, At, B1); PG8_BAR; PG8_SCHED;
            } else {
            PG8_LDB(B0, 0, 0); PG8_SCHED; PG8_LDA(At, 0, 0); PG8_STAGE(PG8_SA(1, 1), a1 + hstep, voffA);
            PG8_WAIT_L(8); PG8_BAR; PG8_WAIT_L(0); PG8_MMA(0, 0, At, B0); PG8_BAR; PG8_SCHED;
            PG8_LDB(B1, 0, 1); PG8_STAGE(PG8_SB(0, 0), b2, voffB);
            PG8_BAR; PG8_WAIT_L(0); PG8_MMA(0, 1, At, B1); PG8_BAR;
            PG8_LDA(At, 0, 1); PG8_STAGE(PG8_SA(0, 0), a2, voffA);
            PG8_BAR; PG8_WAIT_L(0); PG8_MMA(1, 0, At, B0); PG8_BAR; PG8_SCHED;
            PG8_STAGE(PG8_SB(0, 1), b2 + hstep, voffB);
            PG8_WAIT_V(6); PG8_BAR; PG8_MMA(1, 1, At, B1); PG8_BAR;
            PG8_LDB(B0, 1, 0); PG8_SCHED; PG8_LDA(At, 1, 0); PG8_STAGE(PG8_SA(0, 1), a2 + hstep, voffA);
            PG8_WAIT_L(8); PG8_BAR; PG8_WAIT_L(0); PG8_MMA(0, 0, At, B0); PG8_BAR; PG8_SCHED;
            PG8_LDB(B1, 1, 1); PG8_STAGE(PG8_SB(1, 0), b3, voffB);
            PG8_BAR; PG8_WAIT_L(0); PG8_MMA(0, 1, At, B1); PG8_BAR;
            PG8_LDA(At, 1, 1); PG8_STAGE(PG8_SA(1, 0), a3, voffA);
            PG8_BAR; PG8_WAIT_L(0); PG8_MMA(1, 0, At, B0); PG8_BAR; PG8_SCHED;
            PG8_STAGE(PG8_SB(1, 1), b3 + hstep, voffB);
            PG8_WAIT_V(6); PG8_BAR; PG8_MMA(1, 1, At, B1); PG8_BAR;
            }
        }
        if constexpr (ALIGN_EPI) { if (wr == 0) PG8_BAR; }
        if constexpr (!Epi::AFTER_DRAIN) { E(acc, cur, wr, wc, fr, fq); S.done(cur); }
        if (!has_next) break;
#pragma unroll
        for (int a = 0; a < 2; ++a)
#pragma unroll
            for (int b = 0; b < 2; ++b)
#pragma unroll
                for (int m = 0; m < 4; ++m)
#pragma unroll
                    for (int n = 0; n < 2; ++n) acc[a][b][m][n] = (f32x4){0.f, 0.f, 0.f, 0.f};
        cur = nxt; cA = nA; cB = nB; ++ui;
        if constexpr (ALIGN_EPI) { if (wr == 1) PG8_BAR; }
    }
    PG8_WAIT_V(0);
    if constexpr (!ALIGN_EPI) { if (wr == 0) PG8_BAR; }
    PG8_BAR;
    if constexpr (Epi::AFTER_DRAIN) { E.fused(acc, cur, wr, wc, fr, fq, lds, wid, lane); S.done(cur); }
#undef PG8_SA
#undef PG8_SB
#undef PG8_STAGE
#undef PG8_LDA
#undef PG8_LDB
#undef PG8_MMA
#undef PG8_WAIT_V
#undef PG8_WAIT_L
#undef PG8_BAR
#undef PG8_SCHED
}
}


namespace pg8 {
__device__ __forceinline__ unsigned cvt_pk_bf16(float lo, float hi) { unsigned r; asm volatile("v_cvt_pk_bf16_f32 %0, %1, %2" : "=v"(r) : "v"(lo), "v"(hi)); return r; }
__device__ __forceinline__ float fast_sigmoid(float x) { return __builtin_amdgcn_rcpf(1.f + __expf(-x)); }
__device__ __forceinline__ float fast_silu(float x) { return x * __builtin_amdgcn_rcpf(1.f + __expf(-x)); }
__device__ __forceinline__ float fast_gelu_tanh(float x) { const float u = 0.7978845608028654f * (x + 0.044715f * x * x * x); const float e = __expf(2.f * u); const float th = 1.f - 2.f * __builtin_amdgcn_rcpf(e + 1.f); return 0.5f * x * (1.f + th); }

struct EpiSwiglu {
    static constexpr bool PERM = true, AFTER_DRAIN = false;
    bf16_t* H; int ldh;
    __device__ __forceinline__ void operator()(const f32x4 (&acc)[2][2][4][2], const Unit& u, int wr, int wc, int fr, int fq) const {
        const int row0 = u.pm * BM + wr * 64 + fr, hc0 = u.pn * HALF + wc * 32 + 8 * fq;
#pragma unroll
        for (int ai = 0; ai < 2; ++ai)
#pragma unroll
            for (int m = 0; m < 4; ++m) {
                bf16_t* rowp = H + (size_t)(row0 + ai * HALF + m * 16) * ldh + hc0;
                const f32x4 a0 = acc[ai][0][m][0], a1 = acc[ai][0][m][1], b0 = acc[ai][1][m][0], b1 = acc[ai][1][m][1];
                float h[8];
#pragma unroll
                for (int j = 0; j < 4; ++j) { h[j] = fast_silu(a0[j]) * b0[j]; h[4 + j] = fast_silu(a1[j]) * b1[j]; }
                u32x4 w; w.x = cvt_pk_bf16(h[0], h[1]); w.y = cvt_pk_bf16(h[2], h[3]); w.z = cvt_pk_bf16(h[4], h[5]); w.w = cvt_pk_bf16(h[6], h[7]);
                *(u32x4*)rowp = w;
            }
    }
};
struct EpiResid {
    static constexpr bool PERM = false, AFTER_DRAIN = false;
    const float* src_lat; const float* src_ctx; float* dst_lat; float* dst_ctx; const float* gate_l; float gsc;
    __device__ __forceinline__ void operator()(const f32x4 (&acc)[2][2][4][2], const Unit& u, int wr, int wc, int fr, int fq) const {
        const bool lat = u.pm < 64; const int mi = lat ? (u.pm >> 5) : 2;
        const int rowl = (lat ? u.pm : u.pm - 64) * BM + wr * 64 + fr, col0 = u.pn * BM + wc * 32 + 4 * fq;
        const float* src = (lat ? src_lat : src_ctx) + (size_t)rowl * 1024 + col0; float* dst = (lat ? dst_lat : dst_ctx) + (size_t)rowl * 1024 + col0;
        const float* gp = gate_l + (size_t)mi * 9216 + col0;
#pragma unroll
        for (int bj = 0; bj < 2; ++bj)
#pragma unroll
            for (int n = 0; n < 2; ++n) { const f32x4 g = *(const f32x4*)(gp + bj * HALF + n * 16) * gsc;
#pragma unroll
                for (int ai = 0; ai < 2; ++ai) {
#pragma unroll
                    for (int m = 0; m < 4; ++m) { const size_t ro = (size_t)(ai * HALF + m * 16) * 1024 + bj * HALF + n * 16;
                        const f32x4 b = *(const f32x4*)(src + ro); *(f32x4*)(dst + ro) = b + g * acc[ai][bj][m][n]; }
                    asm volatile("" ::: "memory"); } }
    }
};
struct EpiInproj {
    static constexpr bool PERM = false, AFTER_DRAIN = false;
    bf16_t* P; const float* rope; const float* lb_l;
    __device__ __forceinline__ void operator()(const f32x4 (&acc)[2][2][4][2], const Unit& u, int wr, int wc, int fr, int fq) const {
        const bool lat = u.pm < 64;
        const int row0 = u.pm * BM + wr * 64 + fr, cw = wc * 32 + 4 * fq;
#pragma unroll
        for (int bj = 0; bj < 2; ++bj) {
            const int seg = u.pn * 2 + bj, colb = seg * HALF + cw;
            f32x4 lbv[2] = {(f32x4){0.f, 0.f, 0.f, 0.f}, (f32x4){0.f, 0.f, 0.f, 0.f}};
            if (seg >= 8 && seg < 12) { const int o = (seg - 8) * HALF + cw; lbv[0] = *(const f32x4*)(lb_l + o); lbv[1] = *(const f32x4*)(lb_l + o + 16); }
#pragma unroll
            for (int ai = 0; ai < 2; ++ai)
#pragma unroll
                for (int m = 0; m < 4; ++m) {
                    const int row = row0 + ai * HALF + m * 16;
                    f32x4 v0 = acc[ai][bj][m][0], v1 = acc[ai][bj][m][1];
                    if (seg < 5) {
                        if (lat) { const int t = row & (SEQ - 1); const int pos = (wc & 1) ? (t & 63) : (t >> 6);
                            const f32x4 cs = *(const f32x4*)(rope + pos * 16 + 4 * fq), sn = *(const f32x4*)(rope + 2048 + pos * 16 + 4 * fq);
                            const f32x4 o0 = v0 * cs - v1 * sn, o1 = v1 * cs + v0 * sn; v0 = o0; v1 = o1; }
                        if (seg < 4) { v0 = v0 * 0.125f; v1 = v1 * 0.125f; }
                    } else if (seg == 6 || seg == 7 || seg == 14 || seg == 15) {
#pragma unroll
                        for (int j = 0; j < 4; ++j) { v0[j] = fast_silu(v0[j]); v1[j] = fast_silu(v1[j]); }
                    } else if (seg >= 8 && seg < 12) {
#pragma unroll
                        for (int j = 0; j < 4; ++j) { v0[j] = __logf(lbv[0][j] + (1.f - lbv[0][j]) * fast_sigmoid(v0[j])); v1[j] = __logf(lbv[1][j] + (1.f - lbv[1][j]) * fast_sigmoid(v1[j])); }
                    } else if (seg >= 18) {
#pragma unroll
                        for (int j = 0; j < 4; ++j) { v0[j] = fast_gelu_tanh(v0[j]); v1[j] = fast_gelu_tanh(v1[j]); }
                    }
                    bf16_t* pp = P + (size_t)row * 2560 + colb;
                    *(uint2*)pp = make_uint2(cvt_pk_bf16(v0[0], v0[1]), cvt_pk_bf16(v0[2], v0[3]));
                    *(uint2*)(pp + 16) = make_uint2(cvt_pk_bf16(v1[0], v1[1]), cvt_pk_bf16(v1[2], v1[3]));
                    asm volatile("" ::: "memory");
                }
        }
    }
};
}
__global__ void __launch_bounds__(256) k_mods(const float* c, const float* c_ctx, const float* ada_w, const float* ada_b, float* mods) {
    __shared__ float sc[3][DM];
    for (int i = threadIdx.x; i < 3 * DM; i += 256) { const int mi = i / DM, k = i % DM; const float v = mi < 2 ? c[mi * DM + k] : c_ctx[k]; sc[mi][k] = siluf_(v); }
    __syncthreads();
    const int gid = blockIdx.x * 256 + threadIdx.x;
    const int l = gid / (NMODS * DM), n = gid % (NMODS * DM);
    const float* w = ada_w + (size_t)l * DM * NMODS * DM + n;
    float a0 = 0.f, a1 = 0.f, a2 = 0.f;
    for (int k = 0; k < DM; ++k) { const float wv = w[(size_t)k * NMODS * DM]; a0 += sc[0][k] * wv; a1 += sc[1][k] * wv; a2 += sc[2][k] * wv; }
    const float b = ada_b[l * NMODS * DM + n];
    float* m = mods + (size_t)l * 3 * NMODS * DM;
    m[0 * NMODS * DM + n] = a0 + b; m[1 * NMODS * DM + n] = a1 + b; m[2 * NMODS * DM + n] = a2 + b;
}
__global__ void __launch_bounds__(256) k_tables(const float* lb_logits, float* rope, float* lb) {
    const int tid = blockIdx.x * 256 + threadIdx.x;
    if (tid < 128 * 16) { const int pos = tid / 16, f = tid % 16; const float inv = powf(10000.f, -(float)f / 16.f); const float ang = (float)pos * inv; rope[tid] = cosf(ang); rope[2048 + tid] = sinf(ang); }
    if (tid < 2 * 256) {
        const float l0 = lb_logits[tid], l1 = lb_logits[512 + tid]; const float mx = fmaxf(l0, l1); const float e0 = expf(l0 - mx), e1 = expf(l1 - mx);
        lb[tid] = 0.f; lb[512 + tid] = e1 / (e0 + e1);
    }
}
template <int MODE> __global__ void __launch_bounds__(256) k_transpose(const float* W, bf16_t* WT, int K, int N) {
    __shared__ float t[32][33];
    const int n0 = blockIdx.x * 32, k0 = blockIdx.y * 32, tx = threadIdx.x & 31, ty = threadIdx.x >> 5;
    for (int i = ty; i < 32; i += 8) t[i][tx] = W[(size_t)(k0 + i) * N + n0 + tx];
    __syncthreads();
    for (int i = ty; i < 32; i += 8) { const int n = n0 + i; int nd = n;
        if (MODE == 1) { const int half = n >= FH, nn = half ? n - FH : n; nd = 256 * (nn / 128) + 128 * half + (nn % 128); }
        WT[(size_t)nd * K + k0 + tx] = f2bf(t[tx][i]); }
}

__global__ void __launch_bounds__(256) k_normmod(const float* xlat, const float* xctx, const float* g, const float* mods_l, int i_shift, int i_scale, bf16_t* XN, int nrows) {
    const int row = blockIdx.x * 4 + (threadIdx.x >> 6), lane = threadIdx.x & 63;
    if (row >= nrows) return;
    const float* xr = row < MLAT ? xlat + (size_t)row * DM : xctx + (size_t)(row - MLAT) * DM;
    const int mi = row < MLAT ? row / SEQ : 2;
    const float* sh = mods_l + (size_t)mi * NMODS * DM + i_shift * DM; const float* sc = mods_l + (size_t)mi * NMODS * DM + i_scale * DM;
    f32x4 v[4]; float ss = 0.f;
#pragma unroll
    for (int j = 0; j < 4; ++j) { v[j] = *(const f32x4*)(xr + 256 * j + 4 * lane); ss += v[j].x * v[j].x + v[j].y * v[j].y + v[j].z * v[j].z + v[j].w * v[j].w; }
    const float rstd = rsqrtf(wave_sum(ss) * (1.f / DM) + EPS);
#pragma unroll
    for (int j = 0; j < 4; ++j) { const int c0 = 256 * j + 4 * lane; const f32x4 gg = *(const f32x4*)(g + c0), s1 = *(const f32x4*)(sc + c0), s0 = *(const f32x4*)(sh + c0);
        bf16_t o[4];
#pragma unroll
        for (int e = 0; e < 4; ++e) o[e] = f2bf(v[j][e] * rstd * gg[e] * (1.f + s1[e]) + s0[e]);
        *(uint2*)(XN + (size_t)row * DM + c0) = make_uint2((unsigned)o[0] | ((unsigned)o[1] << 16), (unsigned)o[2] | ((unsigned)o[3] << 16)); }
}
__global__ void __launch_bounds__(256) k_final_norm(float* x, const float* g) {
    const int row = blockIdx.x * 4 + (threadIdx.x >> 6), lane = threadIdx.x & 63;
    float* xr = x + (size_t)row * DM;
    f32x4 v[4]; float ss = 0.f;
#pragma unroll
    for (int j = 0; j < 4; ++j) { v[j] = *(const f32x4*)(xr + 256 * j + 4 * lane); ss += v[j].x * v[j].x + v[j].y * v[j].y + v[j].z * v[j].z + v[j].w * v[j].w; }
    const float rstd = rsqrtf(wave_sum(ss) * (1.f / DM) + EPS);
#pragma unroll
    for (int j = 0; j < 4; ++j) { const int c0 = 256 * j + 4 * lane; const f32x4 gg = *(const f32x4*)(g + c0); *(f32x4*)(xr + c0) = v[j] * rstd * gg; }
}

struct EpiArgs {
    bf16_t* H;
    const float* src_lat; const float* src_ctx; float* dst_lat; float* dst_ctx; const float* mods_l; int i_gate; float gsc;
    bf16_t* P; const float* rope; const float* lb_l;
};
enum { EPI_SWIGLU = 0, EPI_RESID = 1, EPI_INPROJ = 2 };

template <int EPI> __global__ void __launch_bounds__(256) k_gemm(const bf16_t* A, const bf16_t* Bt, int K, EpiArgs e) {
    constexpr bool DUAL = (EPI == EPI_SWIGLU);
    __shared__ __attribute__((aligned(16))) bf16_t As[64][40];
    __shared__ __attribute__((aligned(16))) bf16_t Bs[DUAL ? 128 : 64][40];
    __shared__ float Cs[DUAL ? 2 : 1][64][65];
    const int tid = threadIdx.x, lane = tid & 63, w = tid >> 6, wr = w >> 1, wc = w & 1;
    const int row0 = blockIdx.y * 64, ct = blockIdx.x;
    int brow0;
    if (DUAL) brow0 = 256 * (ct >> 1) + 64 * (ct & 1); else brow0 = ct * 64;
    f32x4 acc[DUAL ? 2 : 1][2][2];
#pragma unroll
    for (int d = 0; d < (DUAL ? 2 : 1); ++d)
#pragma unroll
        for (int i = 0; i < 2; ++i)
#pragma unroll
            for (int j = 0; j < 2; ++j) acc[d][i][j] = (f32x4){0.f, 0.f, 0.f, 0.f};
    const int lr = tid >> 2, lk = (tid & 3) * 8;
    for (int k0 = 0; k0 < K; k0 += 32) {
        *(u32x4*)&As[lr][lk] = *(const u32x4*)(A + (size_t)(row0 + lr) * K + k0 + lk);
        *(u32x4*)&Bs[lr][lk] = *(const u32x4*)(Bt + (size_t)(brow0 + lr) * K + k0 + lk);
        if (DUAL) *(u32x4*)&Bs[64 + lr][lk] = *(const u32x4*)(Bt + (size_t)(brow0 + 128 + lr) * K + k0 + lk);
        __syncthreads();
        bf16x8 a[2], b[DUAL ? 2 : 1][2];
#pragma unroll
        for (int i = 0; i < 2; ++i) a[i] = *(const bf16x8*)&As[wr * 32 + i * 16 + (lane & 15)][(lane >> 4) * 8];
#pragma unroll
        for (int d = 0; d < (DUAL ? 2 : 1); ++d)
#pragma unroll
            for (int j = 0; j < 2; ++j) b[d][j] = *(const bf16x8*)&Bs[d * 64 + wc * 32 + j * 16 + (lane & 15)][(lane >> 4) * 8];
#pragma unroll
        for (int d = 0; d < (DUAL ? 2 : 1); ++d)
#pragma unroll
            for (int i = 0; i < 2; ++i)
#pragma unroll
                for (int j = 0; j < 2; ++j) acc[d][i][j] = __builtin_amdgcn_mfma_f32_16x16x32_bf16(a[i], b[d][j], acc[d][i][j], 0, 0, 0);
        __syncthreads();
    }
#pragma unroll
    for (int d = 0; d < (DUAL ? 2 : 1); ++d)
#pragma unroll
        for (int i = 0; i < 2; ++i)
#pragma unroll
            for (int j = 0; j < 2; ++j)
#pragma unroll
                for (int q = 0; q < 4; ++q) Cs[d][wr * 32 + i * 16 + (lane >> 4) * 4 + q][wc * 32 + j * 16 + (lane & 15)] = acc[d][i][j][q];
    __syncthreads();
    for (int el = tid; el < 64 * 64; el += 256) {
        const int r = el >> 6, c = el & 63, row = row0 + r, col = ct * 64 + c;
        if (EPI == EPI_SWIGLU) {
            e.H[(size_t)row * FH + col] = f2bf(siluf_(Cs[0][r][c]) * Cs[DUAL ? 1 : 0][r][c]);
        } else if (EPI == EPI_RESID) {
            const int mi = row < MLAT ? row / SEQ : 2;
            const float gate = e.mods_l[(size_t)mi * NMODS * DM + e.i_gate * DM + col];
            const size_t off = row < MLAT ? (size_t)row * DM + col : (size_t)(row - MLAT) * DM + col;
            const float base = row < MLAT ? e.src_lat[off] : e.src_ctx[off];
            const float o = base + e.gsc * gate * Cs[0][r][c];
            if (row < MLAT) e.dst_lat[off] = o; else e.dst_ctx[off] = o;
        } else {
            const float v = Cs[0][r][c]; float o = v;
            const bool lat = row < MLAT;
            if (col < C_V) {
                if (lat) { const int t = row % SEQ, d = c, ax = d >> 5, half = (d >> 4) & 1, f = d & 15; const int pos = ax == 0 ? (t >> 6) : (t & 63);
                    const float cs = e.rope[pos * 16 + f], sn = e.rope[2048 + pos * 16 + f]; const float vp = Cs[0][r][half ? c - 16 : c + 16];
                    o = half ? v * cs + vp * sn : v * cs - vp * sn; }
                if (col < C_K) o *= 0.125f;
            } else if (col >= C_HQ && col < C_HF) { o = siluf_(v); }
            else if (col >= C_HF && col < C_HI) { const int dir = col >= C_HB, ch = col - (dir ? C_HB : C_HF); const float lbv = e.lb_l[dir * 256 + ch]; o = __logf(lbv + (1.f - lbv) * sigmoidf_(v)); }
            else if (col >= C_HG && col < C_RX) { o = siluf_(v); }
            else if (col >= C_RG) { o = gelu_tanh(v); }
            e.P[(size_t)row * INW + col] = f2bf(o);
        }
    }
}

__global__ void __launch_bounds__(64) k_attn_naive(const bf16_t* P, const float* sink_l, bf16_t* Y, int nrows) {
    const int gid = blockIdx.x * 64 + threadIdx.x; const int row = gid >> 3, h = gid & 7, kvh = h >> 2;
    if (row >= nrows) return;
    const bool lat = row < MLAT; const int b = lat ? row / SEQ : (row - MLAT) / CTXL, t = lat ? row % SEQ : 0;
    float q[64], o[64];
#pragma unroll
    for (int d = 0; d < 64; ++d) { q[d] = bf2f(P[(size_t)row * INW + C_Q + h * 64 + d]); o[d] = 0.f; }
    float m = sink_l[h], l = 1.f;
    const int nloc = lat ? 257 : 0;
    for (int i = 0; i < nloc + CTXL; ++i) {
        int kr;
        if (i < nloc) { const int kp = t - 128 + i; if (kp < 0 || kp >= SEQ) continue; kr = b * SEQ + kp; } else kr = MLAT + b * CTXL + (i - nloc);
        const bf16_t* kp_ = P + (size_t)kr * INW + C_K + kvh * 64; const bf16_t* vp_ = P + (size_t)kr * INW + C_V + kvh * 64;
        float s = 0.f;
#pragma unroll
        for (int d = 0; d < 64; ++d) s += q[d] * bf2f(kp_[d]);
        const float mn = fmaxf(m, s), sc = __expf(m - mn), p = __expf(s - mn);
        l = l * sc + p; m = mn;
#pragma unroll
        for (int d = 0; d < 64; ++d) o[d] = o[d] * sc + p * bf2f(vp_[d]);
    }
    const float il = 1.f / l;
#pragma unroll
    for (int d = 0; d < 64; ++d) Y[(size_t)row * DM + h * 64 + d] = f2bf(o[d] * il);
}

__global__ void __launch_bounds__(64) k_hgrn_naive(const bf16_t* P, const float* hg_norm_l, float* Ofwd, bf16_t* Y, int with_ctx) {
    const int b = blockIdx.x >> 2, h = blockIdx.x & 3, v = threadIdx.x;
    __shared__ float sq[64], sf[64];
    for (int dir = 0; dir < 2; ++dir) {
        float S[64];
#pragma unroll
        for (int k = 0; k < 64; ++k) S[k] = 0.f;
        for (int step = 0; step < CTXL + SEQ; ++step) {
            int row;
            if (step < CTXL) { const int tc = dir == 0 ? step : CTXL - 1 - step; row = MLAT + b * CTXL + tc; }
            else { const int tt = step - CTXL; const int t = dir == 0 ? tt : SEQ - 1 - tt; row = b * SEQ + t; }
            const bf16_t* pr = P + (size_t)row * INW;
            __syncthreads();
            sq[v] = bf2f(pr[C_HQ + h * 64 + v]); sf[v] = __expf(bf2f(pr[(dir ? C_HB : C_HF) + h * 64 + v]));
            __syncthreads();
            const float vv = bf2f(pr[C_HI + h * 64 + v]);
            float o = 0.f;
#pragma unroll
            for (int k = 0; k < 64; ++k) { const float f = sf[k]; S[k] = f * S[k] + (1.f - f) * vv; o += S[k] * sq[k]; }
            const bool need = row < MLAT || with_ctx;
            if (dir == 0) { if (need) Ofwd[(size_t)row * 256 + h * 64 + v] = o; }
            else if (need) {
                const float os = o + Ofwd[(size_t)row * 256 + h * 64 + v];
                const float ms = wave_sum(os * os) * (1.f / 64.f);
                const float y = os * rsqrtf(ms + EPS) * hg_norm_l[h * 64 + v] * bf2f(pr[C_HG + h * 64 + v]);
                Y[(size_t)row * DM + 512 + h * 64 + v] = f2bf(y);
            }
        }
    }
}

__global__ void __launch_bounds__(64) k_rg_naive(const bf16_t* P, const float* conv_w, const float* conv_b, const float* ga_w, const float* ga_b, const float* gx_w, const float* gx_b, const float* lam,
                                                float* Hfwd, bf16_t* Y, int with_ctx) {
    const int b = blockIdx.x >> 2, n = blockIdx.x & 3, e = threadIdx.x, c = n * 64 + e;
    __shared__ float sx[64];
    const float cw0 = conv_w[0 * 256 + c], cw1 = conv_w[1 * 256 + c], cw2 = conv_w[2 * 256 + c], cw3 = conv_w[3 * 256 + c], cb = conv_b[c];
    for (int dir = 0; dir < 2; ++dir) {
        float wa[64], wx[64];
#pragma unroll
        for (int d = 0; d < 64; ++d) { wa[d] = ga_w[((size_t)(dir * 4 + n) * 64 + d) * 64 + e]; wx[d] = gx_w[((size_t)(dir * 4 + n) * 64 + d) * 64 + e]; }
        const float ba = ga_b[dir * 256 + c], bx = gx_b[dir * 256 + c];
        const float lm = lam[dir * 256 + c]; const float sp = log1pf(__expf(-lm));
        float hst = 0.f;
        for (int step = 0; step < CTXL + SEQ; ++step) {
            int row, t, len, base;
            if (step < CTXL) { t = dir == 0 ? step : CTXL - 1 - step; len = CTXL; base = MLAT + b * CTXL; }
            else { const int tt = step - CTXL; t = dir == 0 ? tt : SEQ - 1 - tt; len = SEQ; base = b * SEQ; }
            row = base + t;
            float u = cb;
            if (t - 2 >= 0) u += cw0 * bf2f(P[(size_t)(row - 2) * INW + C_RX + c]);
            if (t - 1 >= 0) u += cw1 * bf2f(P[(size_t)(row - 1) * INW + C_RX + c]);
            u += cw2 * bf2f(P[(size_t)row * INW + C_RX + c]);
            if (t + 1 < len) u += cw3 * bf2f(P[(size_t)(row + 1) * INW + C_RX + c]);
            __syncthreads();
            sx[e] = u;
            __syncthreads();
            float ra = ba, ri = bx;
#pragma unroll
            for (int d = 0; d < 64; ++d) { const float xv = sx[d]; ra += xv * wa[d]; ri += xv * wx[d]; }
            const float r = sigmoidf_(ra), ig = sigmoidf_(ri);
            const float log_a = -8.f * r * sp; const float a = __expf(log_a);
            const float uu = sqrtf(fmaxf(-expm1f(2.f * log_a), 0.f)) * (ig * u);
            hst = a * hst + uu;
            const bool need = row < MLAT || with_ctx;
            if (dir == 0) { if (need) Hfwd[(size_t)row * 256 + c] = hst; }
            else if (need) { const float y = bf2f(P[(size_t)row * INW + C_RG + c]) * (hst + Hfwd[(size_t)row * 256 + c]); Y[(size_t)row * DM + 768 + c] = f2bf(y); }
        }
    }
}

#define LAS __attribute__((address_space(3)))
constexpr int NWAVES = 8, NTHREADS = 512;
constexpr int LDS_BYTES = 147456;
struct Params { const float* in[26]; float* out; unsigned char* ws; int ph_lo, ph_hi; };
constexpr int PH_PRO_A = 0, PH_PRO_B = 1, PH_LAYER0 = 2, PH_PER_LAYER = 12, N_PHASES = PH_LAYER0 + DEPTH * PH_PER_LAYER;
enum { S_FFN1_IN = 0, S_FFN1_OUT = 1, S_NORM_MIX = 2, S_INPROJ = 3, S_MIX1 = 4, S_MIX2 = 5, S_MIX3 = 6, S_OUTPROJ = 7, S_NORM_FFN2 = 8, S_FFN2_IN = 9, S_FFN2_OUT = 10, S_NEXT_NORM = 11 };

__device__ __forceinline__ void ph_normmod(const float* xlat, const float* xctx, const float* g, const float* mods_l, int i_shift, int i_scale, bf16_t* XN, int nrows) {
    int tid_ = threadIdx.x; asm volatile("" : "+v"(tid_));
    const int lane = tid_ & 63, gw = blockIdx.x * NWAVES + (tid_ >> 6), ngw = gridDim.x * NWAVES;
    for (int row = gw; row < nrows; row += ngw) {
        const float* xr = row < MLAT ? xlat + (size_t)row * DM : xctx + (size_t)(row - MLAT) * DM;
        const int mi = row < MLAT ? row / SEQ : 2;
        const float* sh = mods_l + (size_t)mi * NMODS * DM + i_shift * DM; const float* sc = mods_l + (size_t)mi * NMODS * DM + i_scale * DM;
        f32x4 v[4]; float ss = 0.f;
#pragma unroll
        for (int j = 0; j < 4; ++j) { v[j] = *(const f32x4*)(xr + 256 * j + 4 * lane); ss += v[j].x * v[j].x + v[j].y * v[j].y + v[j].z * v[j].z + v[j].w * v[j].w; }
        const float rstd = rsqrtf(wave_sum(ss) * (1.f / DM) + EPS);
#pragma unroll
        for (int j = 0; j < 4; ++j) { const int c0 = 256 * j + 4 * lane; const f32x4 gg = *(const f32x4*)(g + c0), s1 = *(const f32x4*)(sc + c0), s0 = *(const f32x4*)(sh + c0);
            const f32x4 o = v[j] * rstd * gg * (s1 + 1.f) + s0;
            *(uint2*)(XN + (size_t)row * DM + c0) = make_uint2(pg8::cvt_pk_bf16(o[0], o[1]), pg8::cvt_pk_bf16(o[2], o[3])); }
    }
}
__device__ __forceinline__ void ph_final_norm(float* x, const float* g) {
    int tid_ = threadIdx.x; asm volatile("" : "+v"(tid_));
    const int lane = tid_ & 63, gw = blockIdx.x * NWAVES + (tid_ >> 6), ngw = gridDim.x * NWAVES;
    for (int row = gw; row < MLAT; row += ngw) {
        float* xr = x + (size_t)row * DM;
        f32x4 v[4]; float ss = 0.f;
#pragma unroll
        for (int j = 0; j < 4; ++j) { v[j] = *(const f32x4*)(xr + 256 * j + 4 * lane); ss += v[j].x * v[j].x + v[j].y * v[j].y + v[j].z * v[j].z + v[j].w * v[j].w; }
        const float rstd = rsqrtf(wave_sum(ss) * (1.f / DM) + EPS);
#pragma unroll
        for (int j = 0; j < 4; ++j) { const int c0 = 256 * j + 4 * lane; const f32x4 gg = *(const f32x4*)(g + c0); *(f32x4*)(xr + c0) = v[j] * rstd * gg; }
    }
}

__device__ __forceinline__ void run_phase(const Params& p, LAS unsigned char* lds, int ph) {
    unsigned char* ws = p.ws; float* out = p.out;
    float* mods = (float*)(ws + WS_MODS); float* rope = (float*)(ws + WS_ROPE); float* lb = (float*)(ws + WS_LB); float* xctx = (float*)(ws + WS_XCTX);
    bf16_t* XN = (bf16_t*)(ws + WS_XN); bf16_t* Y = XN; bf16_t* H = (bf16_t*)(ws + WS_H); bf16_t* P = H;
    const int G = gridDim.x, bid = blockIdx.x;
    if (ph == PH_PRO_A) { return; }
    if (ph == PH_PRO_B) { ph_normmod(p.in[0], p.in[2], p.in[6], mods, 0, 1, XN, MTOT); return; }
    const int q = ph - PH_LAYER0, l = q / PH_PER_LAYER, s = q % PH_PER_LAYER;
    const bool wctx = l < DEPTH - 1; const int Mmix = wctx ? MTOT : MLAT;
    unsigned char* wl = ws + WS_W + l * W_L_STRIDE; const float* mods_l = mods + (size_t)l * 3 * NMODS * DM;
    const float* src_lat = l == 0 ? p.in[0] : out; const float* src_ctx = l == 0 ? p.in[2] : xctx;
    switch (s) {
    case S_FFN1_IN: case S_FFN2_IN: {
        const int M = s == S_FFN1_IN ? MTOT : Mmix;
        pg8::Gemm g{XN, (const bf16_t*)(wl + (s == S_FFN1_IN ? W_1IN : W_2IN)), M, 2 * FH, DM}; pg8::StaticOrder S; S.init(M, 2 * FH, G, bid);
        pg8::EpiSwiglu E{H, FH};
        pg8::gemm_phase<pg8::EpiSwiglu, pg8::StaticOrder, true, true>(lds, g, S, E);
    } break;
    case S_FFN1_OUT: case S_OUTPROJ: case S_FFN2_OUT: {
        const int M = s == S_FFN1_OUT ? MTOT : Mmix; const int K = s == S_OUTPROJ ? DM : FH;
        const bf16_t* A = s == S_OUTPROJ ? Y : H; const size_t wo = s == S_FFN1_OUT ? W_1OUT : (s == S_OUTPROJ ? W_OUT : W_2OUT);
        const int ig = s == S_FFN1_OUT ? 2 : (s == S_OUTPROJ ? 5 : 8);
        pg8::Gemm g{A, (const bf16_t*)(wl + wo), M, DM, K}; pg8::StaticOrder S; S.init(M, DM, G, bid);
        pg8::EpiResid E{s == S_FFN1_OUT ? src_lat : out, s == S_FFN1_OUT ? src_ctx : xctx, out, xctx, mods_l + ig * DM, s == S_OUTPROJ ? 1.f : 0.5f};
        pg8::gemm_phase<pg8::EpiResid, pg8::StaticOrder, true, true>(lds, g, S, E);
    } break;
    case S_INPROJ: {
        pg8::Gemm g{XN, (const bf16_t*)(wl + W_IN), MTOT, INW, DM}; pg8::StaticOrder S; S.init(MTOT, INW, G, bid);
        pg8::EpiInproj E{P, rope, lb + l * 512};
        pg8::gemm_phase<pg8::EpiInproj, pg8::StaticOrder, true, true>(lds, g, S, E);
    } break;
    case S_NORM_MIX: ph_normmod(out, xctx, p.in[9] + l * DM, mods_l, 3, 4, XN, MTOT); break;
    case S_NORM_FFN2: ph_normmod(out, xctx, p.in[22] + l * DM, mods_l, 6, 7, XN, Mmix); break;
    case S_NEXT_NORM:
        if (l + 1 < DEPTH) ph_normmod(out, xctx, p.in[6] + (l + 1) * DM, mods_l + 3 * NMODS * DM, 0, 1, XN, MTOT);
        else ph_final_norm(out, p.in[25]);
        break;
    default: break;
    }
}

__global__ void __launch_bounds__(NTHREADS, 2) mk(Params p) {
    extern __shared__ __attribute__((aligned(16))) unsigned char lds_raw[];
    LAS unsigned char* lds = (LAS unsigned char*)lds_raw;
    cg::grid_group grid = cg::this_grid();
    for (int ph = p.ph_lo; ph < p.ph_hi; ++ph) {
        run_phase(p, lds, ph);
        if (ph + 1 < p.ph_hi) grid.sync();
    }
}
}

extern "C" void kernel_launch(void* const* d_in, const int* in_sizes, int n_in, void* d_out, int out_size, void* d_ws, size_t ws_size, hipStream_t stream) {
    if (n_in != 26 || out_size != MLAT * DM || ws_size < WS_END) { fprintf(stderr, "kernel_launch: unexpected problem (n_in %d out %d ws %zu)\n", n_in, out_size, ws_size); return; }
    static int grid = 0;
    if (grid == 0) {
        int dev = 0, cus = 0, per_cu = 0;
        hipGetDevice(&dev); hipDeviceGetAttribute(&cus, hipDeviceAttributeMultiprocessorCount, dev);
        hipFuncSetAttribute((const void*)mk, hipFuncAttributeMaxDynamicSharedMemorySize, LDS_BYTES);
        hipOccupancyMaxActiveBlocksPerMultiprocessor(&per_cu, (const void*)mk, NTHREADS, LDS_BYTES);
        if (per_cu < 1) { fprintf(stderr, "kernel_launch: occupancy query says %d blocks per CU\n", per_cu); per_cu = 1; }
        grid = cus;
        (void)hipGetLastError();
    }
    const float* c = (const float*)d_in[1]; const float* c_ctx = (const float*)d_in[3];
    const float* ada_w = (const float*)d_in[4]; const float* ada_b = (const float*)d_in[5];
    const float* ffn1_w_in = (const float*)d_in[7]; const float* ffn1_w_out = (const float*)d_in[8];
    const float* w_in = (const float*)d_in[10]; const float* w_out = (const float*)d_in[11]; const float* attn_sink = (const float*)d_in[12];
    const float* hg_lb_logits = (const float*)d_in[13]; const float* hg_norm = (const float*)d_in[14]; const float* rg_conv_w = (const float*)d_in[15];
    const float* rg_conv_b = (const float*)d_in[16]; const float* rg_ga_w = (const float*)d_in[17]; const float* rg_ga_b = (const float*)d_in[18];
    const float* rg_gx_w = (const float*)d_in[19]; const float* rg_gx_b = (const float*)d_in[20]; const float* rg_lambda = (const float*)d_in[21];
    const float* ffn2_w_in = (const float*)d_in[23]; const float* ffn2_w_out = (const float*)d_in[24];
    unsigned char* ws = (unsigned char*)d_ws;
    float* mods = (float*)(ws + WS_MODS); float* rope = (float*)(ws + WS_ROPE); float* lb = (float*)(ws + WS_LB);
    bf16_t* XN = (bf16_t*)(ws + WS_XN); bf16_t* Y = XN; bf16_t* H = (bf16_t*)(ws + WS_H); bf16_t* P = H;
    float* T0 = (float*)(ws + WS_T); float* T1 = T0 + (size_t)MTOT * 256;
    Params prm{}; for (int i = 0; i < 26; ++i) prm.in[i] = (const float*)d_in[i]; prm.out = (float*)d_out; prm.ws = ws;
    auto run = [&](int lo, int hi) { prm.ph_lo = lo; prm.ph_hi = hi; hipLaunchKernelGGL(mk, dim3(grid), dim3(NTHREADS), LDS_BYTES, stream, prm); };

    k_mods<<<DEPTH * NMODS * DM / 256, 256, 0, stream>>>(c, c_ctx, ada_w, ada_b, mods);
    k_tables<<<8, 256, 0, stream>>>(hg_lb_logits, rope, lb);
    for (int l = 0; l < DEPTH; ++l) {
        unsigned char* wl = ws + WS_W + l * W_L_STRIDE;
        k_transpose<1><<<dim3(2 * FH / 32, DM / 32), 256, 0, stream>>>(ffn1_w_in + (size_t)l * DM * 2 * FH, (bf16_t*)(wl + W_1IN), DM, 2 * FH);
        k_transpose<0><<<dim3(DM / 32, FH / 32), 256, 0, stream>>>(ffn1_w_out + (size_t)l * FH * DM, (bf16_t*)(wl + W_1OUT), FH, DM);
        k_transpose<0><<<dim3(INW / 32, DM / 32), 256, 0, stream>>>(w_in + (size_t)l * DM * INW, (bf16_t*)(wl + W_IN), DM, INW);
        k_transpose<0><<<dim3(DM / 32, DM / 32), 256, 0, stream>>>(w_out + (size_t)l * DM * DM, (bf16_t*)(wl + W_OUT), DM, DM);
        k_transpose<1><<<dim3(2 * FH / 32, DM / 32), 256, 0, stream>>>(ffn2_w_in + (size_t)l * DM * 2 * FH, (bf16_t*)(wl + W_2IN), DM, 2 * FH);
        k_transpose<0><<<dim3(DM / 32, FH / 32), 256, 0, stream>>>(ffn2_w_out + (size_t)l * FH * DM, (bf16_t*)(wl + W_2OUT), FH, DM);
    }
    run(PH_PRO_B, PH_PRO_B + 1);
    for (int l = 0; l < DEPTH; ++l) {
        const int base = PH_LAYER0 + l * PH_PER_LAYER; const bool wc = l < DEPTH - 1; const int nrows_mix = wc ? MTOT : MLAT;
        for (int s = S_FFN1_IN; s <= S_INPROJ; ++s) run(base + s, base + s + 1);
        k_attn_naive<<<nrows_mix * 8 / 64, 64, 0, stream>>>(P, attn_sink + l * 8, Y, nrows_mix);
        k_hgrn_naive<<<8, 64, 0, stream>>>(P, hg_norm + l * 256, T0, Y, wc ? 1 : 0);
        k_rg_naive<<<8, 64, 0, stream>>>(P, rg_conv_w + l * 1024, rg_conv_b + l * 256, rg_ga_w + (size_t)l * 2 * 4 * 64 * 64, rg_ga_b + l * 512, rg_gx_w + (size_t)l * 2 * 4 * 64 * 64, rg_gx_b + l * 512,
                                          rg_lambda + l * 512, T1, Y, wc ? 1 : 0);
        for (int s = S_OUTPROJ; s <= S_NEXT_NORM; ++s) run(base + s, base + s + 1);
    }
}
```

```cpp
#include <hip/hip_runtime.h>
#include <cstdio>
#include <cstdint>
#include <hip/hip_cooperative_groups.h>
namespace cg = cooperative_groups;

namespace {
constexpr int DM = 1024, BATCH = 2, SEQ = 8192, DEPTH = 2, CTXL = 256, NMODS = 9, FH = 2816;
constexpr int MLAT = BATCH * SEQ, MCTX = BATCH * CTXL, MTOT = MLAT + MCTX;
constexpr int INW = 2560;
constexpr int C_Q = 0, C_K = 512, C_V = 640, C_HQ = 768, C_HF = 1024, C_HB = 1280, C_HI = 1536, C_HG = 1792, C_RX = 2048, C_RG = 2304;
constexpr float EPS = 1e-6f;

typedef unsigned short bf16_t;
typedef short bf16x8 __attribute__((ext_vector_type(8)));
typedef float f32x4 __attribute__((ext_vector_type(4)));
typedef unsigned u32x4 __attribute__((ext_vector_type(4)));
typedef float f32x16 __attribute__((ext_vector_type(16)));
typedef unsigned u32x2 __attribute__((ext_vector_type(2)));

constexpr size_t MiB = 1u << 20;
constexpr size_t WS_CTL = 0;
constexpr size_t WS_MODS = 1 * MiB;
constexpr size_t WS_ROPE = 1 * MiB + 512 * 1024;
constexpr size_t WS_LB = WS_ROPE + 32 * 1024;
constexpr size_t WS_XCTX = 2 * MiB;
constexpr size_t WS_W = 4 * MiB;
constexpr size_t W_L_STRIDE = 40 * MiB;
constexpr size_t W_1IN = 0, W_1OUT = 11 * MiB, W_IN = 16 * MiB + 512 * 1024, W_OUT = 21 * MiB + 512 * 1024, W_2IN = 23 * MiB + 512 * 1024, W_2OUT = 34 * MiB + 512 * 1024;
constexpr size_t WS_XN = 84 * MiB;
constexpr size_t WS_H = 117 * MiB;
constexpr size_t WS_T = 208 * MiB;
constexpr size_t WS_GW = 1 * MiB + 768 * 1024;
constexpr size_t WS_HD = 241 * MiB;
constexpr size_t WS_RS = 242 * MiB;
constexpr size_t WS_RE = 243 * MiB + 512 * 1024;
constexpr size_t WS_END = 245 * MiB;
constexpr int NCHK = 132;

__device__ __forceinline__ float bf2f(bf16_t v) { return __uint_as_float(((unsigned)v) << 16); }
__device__ __forceinline__ bf16_t f2bf(float f) { unsigned u = __float_as_uint(f); return (bf16_t)((u + 0x7fffu + ((u >> 16) & 1u)) >> 16); }
__device__ __forceinline__ float sigmoidf_(float x) { return 1.f / (1.f + __expf(-x)); }
__device__ __forceinline__ float siluf_(float x) { return x / (1.f + __expf(-x)); }
__device__ __forceinline__ float gelu_tanh(float x) { const float u = 0.7978845608028654f * (x + 0.044715f * x * x * x); return 0.5f * x * (1.f + tanhf(u)); }
__device__ __forceinline__ float wave_sum(float v) {
#pragma unroll
    for (int o = 1; o < 64; o <<= 1) v += __shfl_xor(v, o);
    return v;
}

namespace pg8 {
#define PG8_LAS __attribute__((address_space(3)))
typedef unsigned short bf16_t;
typedef short bf16x8 __attribute__((ext_vector_type(8)));
typedef float f32x4 __attribute__((ext_vector_type(4)));
typedef unsigned u32x4 __attribute__((ext_vector_type(4)));
constexpr int BM = 256, BK = 64, HALF = 128, HTB = HALF * BK * 2  , STAGE_BYTES = 8 * HTB, NXCD = 8, WGM = 8;

__host__ __device__ __forceinline__ int lds_byte(int r, int c) { const int st = (r >> 4) * 2 + (c >> 5), rr = r & 15, cc = c & 31, ob = rr * 64 + cc * 2; return st * 1024 + (ob ^ (((ob >> 9) & 1) << 5)); }
__host__ __device__ __forceinline__ void stage_rc(int b, int& R, int& C) { const int st = b / 1024, sb = b % 1024, swz = sb ^ (((sb >> 9) & 1) << 5); R = (st >> 1) * 16 + swz / 64; C = (st & 1) * 32 + (swz % 64) / 2; }
__host__ __device__ __forceinline__ int perm32(int rho) { const int n = rho >> 4, i = rho & 15; return 8 * (i >> 2) + 4 * n + (i & 3); }

struct Unit { int pm, pn; };
struct Gemm { const bf16_t* A; const bf16_t* Bt; int M, N, K; };

struct StaticOrder {
    int nM, nN, nwg, G, c;
    __host__ __device__ void init(int M, int N, int G_, int c_) { nM = M / BM; nN = N / BM; nwg = nM * nN; G = G_; c = c_; }
    __host__ __device__ bool next(int i, Unit& u) const {
        const long L = (long)i * G + c; if (L >= nwg) return false;
        int wgid = (int)L; { const int q = nwg / NXCD, r = nwg % NXCD, xcd = wgid % NXCD, off = wgid / NXCD; wgid = (xcd < r ? xcd * (q + 1) : r * (q + 1) + (xcd - r) * q) + off; }
        const int nig = WGM * nN, gid = wgid / nig, fm = gid * WGM, gsz = (nM - fm) < WGM ? (nM - fm) : WGM;
        u.pm = fm + ((wgid % nig) % gsz); u.pn = (wgid % nig) / gsz; return true;
    }
    __device__ __forceinline__ void a_ready(const Unit&) const {}
    __device__ __forceinline__ void done(const Unit&) const {}
};

template <class Epi, class Sched, bool ALIGN_EPI = false, bool SP2 = false>
__device__ __forceinline__ void gemm_phase(PG8_LAS unsigned char* lds, const Gemm g, const Sched& S, const Epi& E) {
    int tid_ = threadIdx.x; asm volatile("" : "+v"(tid_));
    const int tid = tid_, wid = __builtin_amdgcn_readfirstlane(tid >> 6), lane = tid & 63, wr = wid >> 2, wc = wid & 3, fr = lane & 15, fq = lane >> 4;
    const int K = g.K, nt = K / BK;
    unsigned voffA[2], voffB[2];
#pragma unroll
    for (int i = 0; i < 2; ++i) { int R, C; stage_rc(tid * 16 + i * 8192, R, C); const int Rb = Epi::PERM ? ((R & ~31) + perm32(R & 31)) : R;
        voffA[i] = (unsigned)(R * K + C) * 2u; voffB[i] = (unsigned)(Rb * K + C) * 2u; }
    const size_t kstep = (size_t)(BK * 2);
    const size_t hstep = (size_t)HALF * K * 2;
    const size_t tstep = 2 * hstep;
    const unsigned ldsw = (unsigned)wid * 1024u;
    const int aoff = lds_byte(wr * 64 + fr, fq * 8), boff = lds_byte(wc * 32 + fr, fq * 8);
#define PG8_SA(b, h) (((b) * 2 + (h)) * HTB)
#define PG8_SB(b, h) ((4 + (b) * 2 + (h)) * HTB)
#define PG8_STAGE(bufoff, gbase, voff) do { _Pragma("unroll") for (int _i = 0; _i < 2; ++_i) \
        __builtin_amdgcn_global_load_lds((const unsigned*)((const char*)(gbase) + (voff)[_i]), (PG8_LAS unsigned*)(lds + (bufoff) + ldsw + _i * 8192), 16, 0, 0); } while (0)
#define PG8_LDA(dst, b, h) do { _Pragma("unroll") for (int m = 0; m < 4; ++m) _Pragma("unroll") for (int k = 0; k < 2; ++k) dst[m][k] = *(const PG8_LAS bf16x8*)(lds + PG8_SA(b, h) + aoff + m * 2048 + k * 1024); } while (0)
#define PG8_LDB(dst, b, h) do { _Pragma("unroll") for (int n = 0; n < 2; ++n) _Pragma("unroll") for (int k = 0; k < 2; ++k) dst[n][k] = *(const PG8_LAS bf16x8*)(lds + PG8_SB(b, h) + boff + n * 2048 + k * 1024); } while (0)
#define PG8_MMA(ai, bj, At, Bt) do { __builtin_amdgcn_s_setprio(1); _Pragma("unroll") for (int m = 0; m < 4; ++m) _Pragma("unroll") for (int n = 0; n < 2; ++n) _Pragma("unroll") for (int k = 0; k < 2; ++k) \
        acc[ai][bj][m][n] = __builtin_amdgcn_mfma_f32_16x16x32_bf16(Bt[n][k], At[m][k], acc[ai][bj][m][n], 0, 0, 0); __builtin_amdgcn_s_setprio(0); } while (0)
#define PG8_WAIT_V(n) asm volatile("s_waitcnt vmcnt(" #n ")" ::: "memory")
#define PG8_WAIT_L(n) asm volatile("s_waitcnt lgkmcnt(" #n ")" ::: "memory")
#define PG8_BAR __builtin_amdgcn_s_barrier()
#define PG8_SCHED __builtin_amdgcn_sched_barrier(0)
    Unit cur, nxt; int ui = 0;
    if (!S.next(0, cur)) return;
    f32x4 acc[2][2][4][2];
#pragma unroll
    for (int a = 0; a < 2; ++a)
#pragma unroll
        for (int b = 0; b < 2; ++b)
#pragma unroll
            for (int m = 0; m < 4; ++m)
#pragma unroll
                for (int n = 0; n < 2; ++n) acc[a][b][m][n] = (f32x4){0.f, 0.f, 0.f, 0.f};
    bf16x8 At[4][2], B0[2][2], B1[2][2];
    const char* cA = (const char*)g.A + (size_t)cur.pm * tstep; const char* cB = (const char*)g.Bt + (size_t)cur.pn * tstep;
    S.a_ready(cur);
    if constexpr (SP2) {
        PG8_STAGE(PG8_SB(0, 0), cB, voffB); PG8_STAGE(PG8_SB(0, 1), cB + hstep, voffB); PG8_STAGE(PG8_SA(0, 0), cA, voffA); PG8_STAGE(PG8_SA(0, 1), cA + hstep, voffA);
        if (wr == 1) PG8_BAR;
        PG8_WAIT_V(2); PG8_BAR;
        PG8_STAGE(PG8_SB(1, 0), cB + kstep, voffB); PG8_STAGE(PG8_SA(1, 0), cA + kstep, voffA); PG8_STAGE(PG8_SB(1, 1), cB + hstep + kstep, voffB);
        PG8_WAIT_V(6); PG8_BAR;
    } else {
        PG8_STAGE(PG8_SB(0, 0), cB, voffB); PG8_STAGE(PG8_SA(0, 0), cA, voffA); PG8_STAGE(PG8_SB(0, 1), cB + hstep, voffB); PG8_STAGE(PG8_SA(0, 1), cA + hstep, voffA);
        if (wr == 1) PG8_BAR;
        PG8_WAIT_V(4); PG8_BAR;
        PG8_STAGE(PG8_SB(1, 0), cB + kstep, voffB); PG8_STAGE(PG8_SA(1, 0), cA + kstep, voffA); PG8_STAGE(PG8_SB(1, 1), cB + hstep + kstep, voffB);
        PG8_WAIT_V(6); PG8_BAR;
    }
    for (;;) {
        const bool has_next = S.next(ui + 1, nxt);
        const char* nA = has_next ? (const char*)g.A + (size_t)nxt.pm * tstep : cA; const char* nB = has_next ? (const char*)g.Bt + (size_t)nxt.pn * tstep : cB;
        for (int t = 0; t < nt; t += 2) {
            const bool last = (t == nt - 2);
            const char* a1 = cA + (size_t)(t + 1) * kstep;
            const char* a2 = last ? nA : cA + (size_t)(t + 2) * kstep; const char* b2 = last ? nB : cB + (size_t)(t + 2) * kstep;
            const char* a3 = a2 + kstep; const char* b3 = b2 + kstep;
            if (last && has_next) S.a_ready(nxt);
            if constexpr (SP2) {
            PG8_LDB(B0, 0, 0); PG8_LDB(B1, 0, 1); PG8_SCHED; PG8_LDA(At, 0, 0); PG8_STAGE(PG8_SA(1, 1), a1 + hstep, voffA);
            PG8_WAIT_V(8); PG8_WAIT_L(0); PG8_BAR; PG8_MMA(0, 0, At, B0); PG8_MMA(0, 1, At, B1); PG8_BAR; PG8_SCHED;
            PG8_LDA(At, 0, 1); PG8_STAGE(PG8_SB(0, 0), b2, voffB); PG8_STAGE(PG8_SB(0, 1), b2 + hstep, voffB); PG8_STAGE(PG8_SA(0, 0), a2, voffA);
            PG8_WAIT_V(8); PG8_WAIT_L(0); PG8_BAR; PG8_MMA(1, 0, At, B0); PG8_MMA(1, 1, At, B1); PG8_BAR; PG8_SCHED;
            PG8_LDB(B0, 1, 0); PG8_LDB(B1, 1, 1); PG8_SCHED; PG8_LDA(At, 1, 0); PG8_STAGE(PG8_SA(0, 1), a2 + hstep, voffA);
            PG8_WAIT_V(8); PG8_WAIT_L(0); PG8_BAR; PG8_MMA(0, 0, At, B0); PG8_MMA(0, 1, At, B1); PG8_BAR; PG8_SCHED;
            PG8_LDA(At, 1, 1); PG8_STAGE(PG8_SB(1, 0), b3, voffB); PG8_STAGE(PG8_SB(1, 1), b3 + hstep, voffB); PG8_STAGE(PG8_SA(1, 0), a3, voffA);
            PG8_WAIT_V(8); PG8_WAIT_L(0); PG8_BAR; PG8_MMA(1, 0, At, B0); PG8_MMA(1, 1, At, B1); PG8_BAR; PG8_SCHED;
            } else {
            PG8_LDB(B0, 0, 0); PG8_SCHED; PG8_LDA(At, 0, 0); PG8_STAGE(PG8_SA(1, 1), a1 + hstep, voffA);
            PG8_WAIT_L(8); PG8_BAR; PG8_WAIT_L(0); PG8_MMA(0, 0, At, B0); PG8_BAR; PG8_SCHED;
            PG8_LDB(B1, 0, 1); PG8_STAGE(PG8_SB(0, 0), b2, voffB);
            PG8_BAR; PG8_WAIT_L(0); PG8_MMA(0, 1, At, B1); PG8_BAR;
            PG8_LDA(At, 0, 1); PG8_STAGE(PG8_SA(0, 0), a2, voffA);
            PG8_BAR; PG8_WAIT_L(0); PG8_MMA(1, 0, At, B0); PG8_BAR; PG8_SCHED;
            PG8_STAGE(PG8_SB(0, 1), b2 + hstep, voffB);
            PG8_WAIT_V(6); PG8_BAR; PG8_MMA(1, 1, At, B1); PG8_BAR;
            PG8_LDB(B0, 1, 0); PG8_SCHED; PG8_LDA(At, 1, 0); PG8_STAGE(PG8_SA(0, 1), a2 + hstep, voffA);
            PG8_WAIT_L(8); PG8_BAR; PG8_WAIT_L(0); PG8_MMA(0, 0, At, B0); PG8_BAR; PG8_SCHED;
            PG8_LDB(B1, 1, 1); PG8_STAGE(PG8_SB(1, 0), b3, voffB);
            PG8_BAR; PG8_WAIT_L(0); PG8_MMA(0, 1, At, B1); PG8_BAR;
            PG8_LDA(At, 1, 1); PG8_STAGE(PG8_SA(1, 0), a3, voffA);
            PG8_BAR; PG8_WAIT_L(0); PG8_MMA(1, 0, At, B0); PG8_BAR; PG8_SCHED;
            PG8_STAGE(PG8_SB(1, 1), b3 + hstep, voffB);
            PG8_WAIT_V(6); PG8_BAR; PG8_MMA(1, 1, At, B1); PG8_BAR;
            }
        }
        if constexpr (ALIGN_EPI) { if (wr == 0) PG8_BAR; }
        if constexpr (!Epi::AFTER_DRAIN) { E(acc, cur, wr, wc, fr, fq); S.done(cur); }
        if (!has_next) break;
#pragma unroll
        for (int a = 0; a < 2; ++a)
#pragma unroll
            for (int b = 0; b < 2; ++b)
#pragma unroll
                for (int m = 0; m < 4; ++m)
#pragma unroll
                    for (int n = 0; n < 2; ++n) acc[a][b][m][n] = (f32x4){0.f, 0.f, 0.f, 0.f};
        cur = nxt; cA = nA; cB = nB; ++ui;
        if constexpr (ALIGN_EPI) { if (wr == 1) PG8_BAR; }
    }
    PG8_WAIT_V(0);
    if constexpr (!ALIGN_EPI) { if (wr == 0) PG8_BAR; }
    PG8_BAR;
    if constexpr (Epi::AFTER_DRAIN) { E.fused(acc, cur, wr, wc, fr, fq, lds, wid, lane); S.done(cur); }
#undef PG8_SA
#undef PG8_SB
#undef PG8_STAGE
#undef PG8_LDA
#undef PG8_LDB
#undef PG8_MMA
#undef PG8_WAIT_V
#undef PG8_WAIT_L
#undef PG8_BAR
#undef PG8_SCHED
}
}


namespace pg8 {
__device__ __forceinline__ unsigned cvt_pk_bf16(float lo, float hi) { unsigned r; asm volatile("v_cvt_pk_bf16_f32 %0, %1, %2" : "=v"(r) : "v"(lo), "v"(hi)); return r; }
__device__ __forceinline__ float fast_sigmoid(float x) { return __builtin_amdgcn_rcpf(1.f + __expf(-x)); }
__device__ __forceinline__ float fast_silu(float x) { return x * __builtin_amdgcn_rcpf(1.f + __expf(-x)); }
__device__ __forceinline__ float fast_gelu_tanh(float x) { const float u = 0.7978845608028654f * (x + 0.044715f * x * x * x); const float e = __expf(2.f * u); const float th = 1.f - 2.f * __builtin_amdgcn_rcpf(e + 1.f); return 0.5f * x * (1.f + th); }

struct EpiSwiglu {
    static constexpr bool PERM = true, AFTER_DRAIN = false;
    bf16_t* H; int ldh;
    __device__ __forceinline__ void operator()(const f32x4 (&acc)[2][2][4][2], const Unit& u, int wr, int wc, int fr, int fq) const {
        const int row0 = u.pm * BM + wr * 64 + fr, hc0 = u.pn * HALF + wc * 32 + 8 * fq;
#pragma unroll
        for (int ai = 0; ai < 2; ++ai)
#pragma unroll
            for (int m = 0; m < 4; ++m) {
                bf16_t* rowp = H + (size_t)(row0 + ai * HALF + m * 16) * ldh + hc0;
                const f32x4 a0 = acc[ai][0][m][0], a1 = acc[ai][0][m][1], b0 = acc[ai][1][m][0], b1 = acc[ai][1][m][1];
                float h[8];
#pragma unroll
                for (int j = 0; j < 4; ++j) { h[j] = fast_silu(a0[j]) * b0[j]; h[4 + j] = fast_silu(a1[j]) * b1[j]; }
                u32x4 w; w.x = cvt_pk_bf16(h[0], h[1]); w.y = cvt_pk_bf16(h[2], h[3]); w.z = cvt_pk_bf16(h[4], h[5]); w.w = cvt_pk_bf16(h[6], h[7]);
                *(u32x4*)rowp = w;
            }
    }
};
struct EpiResid {
    static constexpr bool PERM = false, AFTER_DRAIN = false;
    const float* src_lat; const float* src_ctx; float* dst_lat; float* dst_ctx; const float* gate_l; float gsc;
    __device__ __forceinline__ void operator()(const f32x4 (&acc)[2][2][4][2], const Unit& u, int wr, int wc, int fr, int fq) const {
        const bool lat = u.pm < 64; const int mi = lat ? (u.pm >> 5) : 2;
        const int rowl = (lat ? u.pm : u.pm - 64) * BM + wr * 64 + fr, col0 = u.pn * BM + wc * 32 + 4 * fq;
        const float* src = (lat ? src_lat : src_ctx) + (size_t)rowl * 1024 + col0; float* dst = (lat ? dst_lat : dst_ctx) + (size_t)rowl * 1024 + col0;
        const float* gp = gate_l + (size_t)mi * 9216 + col0;
#pragma unroll
        for (int bj = 0; bj < 2; ++bj)
#pragma unroll
            for (int n = 0; n < 2; ++n) { const f32x4 g = *(const f32x4*)(gp + bj * HALF + n * 16) * gsc;
#pragma unroll
                for (int ai = 0; ai < 2; ++ai) {
#pragma unroll
                    for (int m = 0; m < 4; ++m) { const size_t ro = (size_t)(ai * HALF + m * 16) * 1024 + bj * HALF + n * 16;
                        const f32x4 b = *(const f32x4*)(src + ro); *(f32x4*)(dst + ro) = b + g * acc[ai][bj][m][n]; }
                    asm volatile("" ::: "memory"); } }
    }
};
struct EpiInproj {
    static constexpr bool PERM = false, AFTER_DRAIN = false;
    bf16_t* P; const float* rope; const float* lb_l;
    __device__ __forceinline__ void operator()(const f32x4 (&acc)[2][2][4][2], const Unit& u, int wr, int wc, int fr, int fq) const {
        const bool lat = u.pm < 64;
        const int row0 = u.pm * BM + wr * 64 + fr, cw = wc * 32 + 4 * fq;
#pragma unroll
        for (int bj = 0; bj < 2; ++bj) {
            const int seg = u.pn * 2 + bj, colb = seg * HALF + cw;
            f32x4 lbv[2] = {(f32x4){0.f, 0.f, 0.f, 0.f}, (f32x4){0.f, 0.f, 0.f, 0.f}};
            if (seg >= 8 && seg < 12) { const int o = (seg - 8) * HALF + cw; lbv[0] = *(const f32x4*)(lb_l + o); lbv[1] = *(const f32x4*)(lb_l + o + 16); }
#pragma unroll
            for (int ai = 0; ai < 2; ++ai)
#pragma unroll
                for (int m = 0; m < 4; ++m) {
                    const int row = row0 + ai * HALF + m * 16;
                    f32x4 v0 = acc[ai][bj][m][0], v1 = acc[ai][bj][m][1];
                    if (seg < 5) {
                        if (lat) { const int t = row & (SEQ - 1); const int pos = (wc & 1) ? (t & 63) : (t >> 6);
                            const f32x4 cs = *(const f32x4*)(rope + pos * 16 + 4 * fq), sn = *(const f32x4*)(rope + 2048 + pos * 16 + 4 * fq);
                            const f32x4 o0 = v0 * cs - v1 * sn, o1 = v1 * cs + v0 * sn; v0 = o0; v1 = o1; }
                        if (seg < 4) { v0 = v0 * 0.125f; v1 = v1 * 0.125f; }
                    } else if (seg == 6 || seg == 7 || seg == 14 || seg == 15) {
#pragma unroll
                        for (int j = 0; j < 4; ++j) { v0[j] = fast_silu(v0[j]); v1[j] = fast_silu(v1[j]); }
                    } else if (seg >= 8 && seg < 12) {
#pragma unroll
                        for (int j = 0; j < 4; ++j) { v0[j] = __logf(lbv[0][j] + (1.f - lbv[0][j]) * fast_sigmoid(v0[j])); v1[j] = __logf(lbv[1][j] + (1.f - lbv[1][j]) * fast_sigmoid(v1[j])); }
                    } else if (seg >= 18) {
#pragma unroll
                        for (int j = 0; j < 4; ++j) { v0[j] = fast_gelu_tanh(v0[j]); v1[j] = fast_gelu_tanh(v1[j]); }
                    }
                    bf16_t* pp = P + (size_t)row * 2560 + colb;
                    *(uint2*)pp = make_uint2(cvt_pk_bf16(v0[0], v0[1]), cvt_pk_bf16(v0[2], v0[3]));
                    *(uint2*)(pp + 16) = make_uint2(cvt_pk_bf16(v1[0], v1[1]), cvt_pk_bf16(v1[2], v1[3]));
                    asm volatile("" ::: "memory");
                }
        }
    }
};
}
__global__ void __launch_bounds__(256) k_mods(const float* c, const float* c_ctx, const float* ada_w, const float* ada_b, float* mods) {
    __shared__ float sc[3][DM];
    for (int i = threadIdx.x; i < 3 * DM; i += 256) { const int mi = i / DM, k = i % DM; const float v = mi < 2 ? c[mi * DM + k] : c_ctx[k]; sc[mi][k] = siluf_(v); }
    __syncthreads();
    const int gid = blockIdx.x * 256 + threadIdx.x;
    const int l = gid / (NMODS * DM), n = gid % (NMODS * DM);
    const float* w = ada_w + (size_t)l * DM * NMODS * DM + n;
    float a0 = 0.f, a1 = 0.f, a2 = 0.f;
    for (int k = 0; k < DM; ++k) { const float wv = w[(size_t)k * NMODS * DM]; a0 += sc[0][k] * wv; a1 += sc[1][k] * wv; a2 += sc[2][k] * wv; }
    const float b = ada_b[l * NMODS * DM + n];
    float* m = mods + (size_t)l * 3 * NMODS * DM;
    m[0 * NMODS * DM + n] = a0 + b; m[1 * NMODS * DM + n] = a1 + b; m[2 * NMODS * DM + n] = a2 + b;
}
__global__ void __launch_bounds__(256) k_tables(const float* lb_logits, float* rope, float* lb) {
    const int tid = blockIdx.x * 256 + threadIdx.x;
    if (tid < 128 * 16) { const int pos = tid / 16, f = tid % 16; const float inv = powf(10000.f, -(float)f / 16.f); const float ang = (float)pos * inv; rope[tid] = cosf(ang); rope[2048 + tid] = sinf(ang); }
    if (tid < 2 * 256) {
        const float l0 = lb_logits[tid], l1 = lb_logits[512 + tid]; const float mx = fmaxf(l0, l1); const float e0 = expf(l0 - mx), e1 = expf(l1 - mx);
        lb[tid] = 0.f; lb[512 + tid] = e1 / (e0 + e1);
    }
}
template <int MODE> __global__ void __launch_bounds__(256) k_transpose(const float* W, bf16_t* WT, int K, int N) {
    __shared__ float t[32][33];
    const int n0 = blockIdx.x * 32, k0 = blockIdx.y * 32, tx = threadIdx.x & 31, ty = threadIdx.x >> 5;
    for (int i = ty; i < 32; i += 8) t[i][tx] = W[(size_t)(k0 + i) * N + n0 + tx];
    __syncthreads();
    for (int i = ty; i < 32; i += 8) { const int n = n0 + i; int nd = n;
        if (MODE == 1) { const int half = n >= FH, nn = half ? n - FH : n; nd = 256 * (nn / 128) + 128 * half + (nn % 128); }
        WT[(size_t)nd * K + k0 + tx] = f2bf(t[tx][i]); }
}

__global__ void __launch_bounds__(256) k_normmod(const float* xlat, const float* xctx, const float* g, const float* mods_l, int i_shift, int i_scale, bf16_t* XN, int nrows) {
    const int row = blockIdx.x * 4 + (threadIdx.x >> 6), lane = threadIdx.x & 63;
    if (row >= nrows) return;
    const float* xr = row < MLAT ? xlat + (size_t)row * DM : xctx + (size_t)(row - MLAT) * DM;
    const int mi = row < MLAT ? row / SEQ : 2;
    const float* sh = mods_l + (size_t)mi * NMODS * DM + i_shift * DM; const float* sc = mods_l + (size_t)mi * NMODS * DM + i_scale * DM;
    f32x4 v[4]; float ss = 0.f;
#pragma unroll
    for (int j = 0; j < 4; ++j) { v[j] = *(const f32x4*)(xr + 256 * j + 4 * lane); ss += v[j].x * v[j].x + v[j].y * v[j].y + v[j].z * v[j].z + v[j].w * v[j].w; }
    const float rstd = rsqrtf(wave_sum(ss) * (1.f / DM) + EPS);
#pragma unroll
    for (int j = 0; j < 4; ++j) { const int c0 = 256 * j + 4 * lane; const f32x4 gg = *(const f32x4*)(g + c0), s1 = *(const f32x4*)(sc + c0), s0 = *(const f32x4*)(sh + c0);
        bf16_t o[4];
#pragma unroll
        for (int e = 0; e < 4; ++e) o[e] = f2bf(v[j][e] * rstd * gg[e] * (1.f + s1[e]) + s0[e]);
        *(uint2*)(XN + (size_t)row * DM + c0) = make_uint2((unsigned)o[0] | ((unsigned)o[1] << 16), (unsigned)o[2] | ((unsigned)o[3] << 16)); }
}
__global__ void __launch_bounds__(256) k_final_norm(float* x, const float* g) {
    const int row = blockIdx.x * 4 + (threadIdx.x >> 6), lane = threadIdx.x & 63;
    float* xr = x + (size_t)row * DM;
    f32x4 v[4]; float ss = 0.f;
#pragma unroll
    for (int j = 0; j < 4; ++j) { v[j] = *(const f32x4*)(xr + 256 * j + 4 * lane); ss += v[j].x * v[j].x + v[j].y * v[j].y + v[j].z * v[j].z + v[j].w * v[j].w; }
    const float rstd = rsqrtf(wave_sum(ss) * (1.f / DM) + EPS);
#pragma unroll
    for (int j = 0; j < 4; ++j) { const int c0 = 256 * j + 4 * lane; const f32x4 gg = *(const f32x4*)(g + c0); *(f32x4*)(xr + c0) = v[j] * rstd * gg; }
}

struct EpiArgs {
    bf16_t* H;
    const float* src_lat; const float* src_ctx; float* dst_lat; float* dst_ctx; const float* mods_l; int i_gate; float gsc;
    bf16_t* P; const float* rope; const float* lb_l;
};
enum { EPI_SWIGLU = 0, EPI_RESID = 1, EPI_INPROJ = 2 };

template <int EPI> __global__ void __launch_bounds__(256) k_gemm(const bf16_t* A, const bf16_t* Bt, int K, EpiArgs e) {
    constexpr bool DUAL = (EPI == EPI_SWIGLU);
    __shared__ __attribute__((aligned(16))) bf16_t As[64][40];
    __shared__ __attribute__((aligned(16))) bf16_t Bs[DUAL ? 128 : 64][40];
    __shared__ float Cs[DUAL ? 2 : 1][64][65];
    const int tid = threadIdx.x, lane = tid & 63, w = tid >> 6, wr = w >> 1, wc = w & 1;
    const int row0 = blockIdx.y * 64, ct = blockIdx.x;
    int brow0;
    if (DUAL) brow0 = 256 * (ct >> 1) + 64 * (ct & 1); else brow0 = ct * 64;
    f32x4 acc[DUAL ? 2 : 1][2][2];
#pragma unroll
    for (int d = 0; d < (DUAL ? 2 : 1); ++d)
#pragma unroll
        for (int i = 0; i < 2; ++i)
#pragma unroll
            for (int j = 0; j < 2; ++j) acc[d][i][j] = (f32x4){0.f, 0.f, 0.f, 0.f};
    const int lr = tid >> 2, lk = (tid & 3) * 8;
    for (int k0 = 0; k0 < K; k0 += 32) {
        *(u32x4*)&As[lr][lk] = *(const u32x4*)(A + (size_t)(row0 + lr) * K + k0 + lk);
        *(u32x4*)&Bs[lr][lk] = *(const u32x4*)(Bt + (size_t)(brow0 + lr) * K + k0 + lk);
        if (DUAL) *(u32x4*)&Bs[64 + lr][lk] = *(const u32x4*)(Bt + (size_t)(brow0 + 128 + lr) * K + k0 + lk);
        __syncthreads();
        bf16x8 a[2], b[DUAL ? 2 : 1][2];
#pragma unroll
        for (int i = 0; i < 2; ++i) a[i] = *(const bf16x8*)&As[wr * 32 + i * 16 + (lane & 15)][(lane >> 4) * 8];
#pragma unroll
        for (int d = 0; d < (DUAL ? 2 : 1); ++d)
#pragma unroll
            for (int j = 0; j < 2; ++j) b[d][j] = *(const bf16x8*)&Bs[d * 64 + wc * 32 + j * 16 + (lane & 15)][(lane >> 4) * 8];
#pragma unroll
        for (int d = 0; d < (DUAL ? 2 : 1); ++d)
#pragma unroll
            for (int i = 0; i < 2; ++i)
#pragma unroll
                for (int j = 0; j < 2; ++j) acc[d][i][j] = __builtin_amdgcn_mfma_f32_16x16x32_bf16(a[i], b[d][j], acc[d][i][j], 0, 0, 0);
        __syncthreads();
    }
#pragma unroll
    for (int d = 0; d < (DUAL ? 2 : 1); ++d)
#pragma unroll
        for (int i = 0; i < 2; ++i)
#pragma unroll
            for (int j = 0; j < 2; ++j)
#pragma unroll
                for (int q = 0; q < 4; ++q) Cs[d][wr * 32 + i * 16 + (lane >> 4) * 4 + q][wc * 32 + j * 16 + (lane & 15)] = acc[d][i][j][q];
    __syncthreads();
    for (int el = tid; el < 64 * 64; el += 256) {
        const int r = el >> 6, c = el & 63, row = row0 + r, col = ct * 64 + c;
        if (EPI == EPI_SWIGLU) {
            e.H[(size_t)row * FH + col] = f2bf(siluf_(Cs[0][r][c]) * Cs[DUAL ? 1 : 0][r][c]);
        } else if (EPI == EPI_RESID) {
            const int mi = row < MLAT ? row / SEQ : 2;
            const float gate = e.mods_l[(size_t)mi * NMODS * DM + e.i_gate * DM + col];
            const size_t off = row < MLAT ? (size_t)row * DM + col : (size_t)(row - MLAT) * DM + col;
            const float base = row < MLAT ? e.src_lat[off] : e.src_ctx[off];
            const float o = base + e.gsc * gate * Cs[0][r][c];
            if (row < MLAT) e.dst_lat[off] = o; else e.dst_ctx[off] = o;
        } else {
            const float v = Cs[0][r][c]; float o = v;
            const bool lat = row < MLAT;
            if (col < C_V) {
                if (lat) { const int t = row % SEQ, d = c, ax = d >> 5, half = (d >> 4) & 1, f = d & 15; const int pos = ax == 0 ? (t >> 6) : (t & 63);
                    const float cs = e.rope[pos * 16 + f], sn = e.rope[2048 + pos * 16 + f]; const float vp = Cs[0][r][half ? c - 16 : c + 16];
                    o = half ? v * cs + vp * sn : v * cs - vp * sn; }
                if (col < C_K) o *= 0.125f;
            } else if (col >= C_HQ && col < C_HF) { o = siluf_(v); }
            else if (col >= C_HF && col < C_HI) { const int dir = col >= C_HB, ch = col - (dir ? C_HB : C_HF); const float lbv = e.lb_l[dir * 256 + ch]; o = __logf(lbv + (1.f - lbv) * sigmoidf_(v)); }
            else if (col >= C_HG && col < C_RX) { o = siluf_(v); }
            else if (col >= C_RG) { o = gelu_tanh(v); }
            e.P[(size_t)row * INW + col] = f2bf(o);
        }
    }
}

__global__ void __launch_bounds__(64) k_attn_naive(const bf16_t* P, const float* sink_l, bf16_t* Y, int nrows) {
    const int gid = blockIdx.x * 64 + threadIdx.x; const int row = gid >> 3, h = gid & 7, kvh = h >> 2;
    if (row >= nrows) return;
    const bool lat = row < MLAT; const int b = lat ? row / SEQ : (row - MLAT) / CTXL, t = lat ? row % SEQ : 0;
    float q[64], o[64];
#pragma unroll
    for (int d = 0; d < 64; ++d) { q[d] = bf2f(P[(size_t)row * INW + C_Q + h * 64 + d]); o[d] = 0.f; }
    float m = sink_l[h], l = 1.f;
    const int nloc = lat ? 257 : 0;
    for (int i = 0; i < nloc + CTXL; ++i) {
        int kr;
        if (i < nloc) { const int kp = t - 128 + i; if (kp < 0 || kp >= SEQ) continue; kr = b * SEQ + kp; } else kr = MLAT + b * CTXL + (i - nloc);
        const bf16_t* kp_ = P + (size_t)kr * INW + C_K + kvh * 64; const bf16_t* vp_ = P + (size_t)kr * INW + C_V + kvh * 64;
        float s = 0.f;
#pragma unroll
        for (int d = 0; d < 64; ++d) s += q[d] * bf2f(kp_[d]);
        const float mn = fmaxf(m, s), sc = __expf(m - mn), p = __expf(s - mn);
        l = l * sc + p; m = mn;
#pragma unroll
        for (int d = 0; d < 64; ++d) o[d] = o[d] * sc + p * bf2f(vp_[d]);
    }
    const float il = 1.f / l;
#pragma unroll
    for (int d = 0; d < 64; ++d) Y[(size_t)row * DM + h * 64 + d] = f2bf(o[d] * il);
}

__global__ void __launch_bounds__(64) k_hgrn_naive(const bf16_t* P, const float* hg_norm_l, float* Ofwd, bf16_t* Y, int with_ctx) {
    const int b = blockIdx.x >> 2, h = blockIdx.x & 3, v = threadIdx.x;
    __shared__ float sq[64], sf[64];
    for (int dir = 0; dir < 2; ++dir) {
        float S[64];
#pragma unroll
        for (int k = 0; k < 64; ++k) S[k] = 0.f;
        for (int step = 0; step < CTXL + SEQ; ++step) {
            int row;
            if (step < CTXL) { const int tc = dir == 0 ? step : CTXL - 1 - step; row = MLAT + b * CTXL + tc; }
            else { const int tt = step - CTXL; const int t = dir == 0 ? tt : SEQ - 1 - tt; row = b * SEQ + t; }
            const bf16_t* pr = P + (size_t)row * INW;
            __syncthreads();
            sq[v] = bf2f(pr[C_HQ + h * 64 + v]); sf[v] = __expf(bf2f(pr[(dir ? C_HB : C_HF) + h * 64 + v]));
            __syncthreads();
            const float vv = bf2f(pr[C_HI + h * 64 + v]);
            float o = 0.f;
#pragma unroll
            for (int k = 0; k < 64; ++k) { const float f = sf[k]; S[k] = f * S[k] + (1.f - f) * vv; o += S[k] * sq[k]; }
            const bool need = row < MLAT || with_ctx;
            if (dir == 0) { if (need) Ofwd[(size_t)row * 256 + h * 64 + v] = o; }
            else if (need) {
                const float os = o + Ofwd[(size_t)row * 256 + h * 64 + v];
                const float ms = wave_sum(os * os) * (1.f / 64.f);
                const float y = os * rsqrtf(ms + EPS) * hg_norm_l[h * 64 + v] * bf2f(pr[C_HG + h * 64 + v]);
                Y[(size_t)row * DM + 512 + h * 64 + v] = f2bf(y);
            }
        }
    }
}

__global__ void __launch_bounds__(64) k_rg_naive(const bf16_t* P, const float* conv_w, const float* conv_b, const float* ga_w, const float* ga_b, const float* gx_w, const float* gx_b, const float* lam,
                                                float* Hfwd, bf16_t* Y, int with_ctx) {
    const int b = blockIdx.x >> 2, n = blockIdx.x & 3, e = threadIdx.x, c = n * 64 + e;
    __shared__ float sx[64];
    const float cw0 = conv_w[0 * 256 + c], cw1 = conv_w[1 * 256 + c], cw2 = conv_w[2 * 256 + c], cw3 = conv_w[3 * 256 + c], cb = conv_b[c];
    for (int dir = 0; dir < 2; ++dir) {
        float wa[64], wx[64];
#pragma unroll
        for (int d = 0; d < 64; ++d) { wa[d] = ga_w[((size_t)(dir * 4 + n) * 64 + d) * 64 + e]; wx[d] = gx_w[((size_t)(dir * 4 + n) * 64 + d) * 64 + e]; }
        const float ba = ga_b[dir * 256 + c], bx = gx_b[dir * 256 + c];
        const float lm = lam[dir * 256 + c]; const float sp = log1pf(__expf(-lm));
        float hst = 0.f;
        for (int step = 0; step < CTXL + SEQ; ++step) {
            int row, t, len, base;
            if (step < CTXL) { t = dir == 0 ? step : CTXL - 1 - step; len = CTXL; base = MLAT + b * CTXL; }
            else { const int tt = step - CTXL; t = dir == 0 ? tt : SEQ - 1 - tt; len = SEQ; base = b * SEQ; }
            row = base + t;
            float u = cb;
            if (t - 2 >= 0) u += cw0 * bf2f(P[(size_t)(row - 2) * INW + C_RX + c]);
            if (t - 1 >= 0) u += cw1 * bf2f(P[(size_t)(row - 1) * INW + C_RX + c]);
            u += cw2 * bf2f(P[(size_t)row * INW + C_RX + c]);
            if (t + 1 < len) u += cw3 * bf2f(P[(size_t)(row + 1) * INW + C_RX + c]);
            __syncthreads();
            sx[e] = u;
            __syncthreads();
            float ra = ba, ri = bx;
#pragma unroll
            for (int d = 0; d < 64; ++d) { const float xv = sx[d]; ra += xv * wa[d]; ri += xv * wx[d]; }
            const float r = sigmoidf_(ra), ig = sigmoidf_(ri);
            const float log_a = -8.f * r * sp; const float a = __expf(log_a);
            const float uu = sqrtf(fmaxf(-expm1f(2.f * log_a), 0.f)) * (ig * u);
            hst = a * hst + uu;
            const bool need = row < MLAT || with_ctx;
            if (dir == 0) { if (need) Hfwd[(size_t)row * 256 + c] = hst; }
            else if (need) { const float y = bf2f(P[(size_t)row * INW + C_RG + c]) * (hst + Hfwd[(size_t)row * 256 + c]); Y[(size_t)row * DM + 768 + c] = f2bf(y); }
        }
    }
}

#define LAS __attribute__((address_space(3)))
constexpr int NWAVES = 8, NTHREADS = 512;
constexpr int LDS_BYTES = 147456;
struct Params { const float* in[26]; float* out; unsigned char* ws; int ph_lo, ph_hi; };
constexpr int PH_PRO_A = 0, PH_PRO_B = 1, PH_LAYER0 = 2, PH_PER_LAYER = 12, N_PHASES = PH_LAYER0 + DEPTH * PH_PER_LAYER;
enum { S_FFN1_IN = 0, S_FFN1_OUT = 1, S_NORM_MIX = 2, S_INPROJ = 3, S_MIX1 = 4, S_MIX2 = 5, S_MIX3 = 6, S_OUTPROJ = 7, S_NORM_FFN2 = 8, S_FFN2_IN = 9, S_FFN2_OUT = 10, S_NEXT_NORM = 11 };


constexpr int AT_KS = 72;
constexpr int AT_LDS_K = 0, AT_LDS_V = 64 * AT_KS * 2;
constexpr float LOG2E = 1.4426950408889634f;
__device__ __forceinline__ void attn_unit(LAS unsigned char* lds, const bf16_t* P, const float* sink_l, bf16_t* Y, int b, int qblk, int kvh, bool ctxq) {
    int tid_ = threadIdx.x; asm volatile("" : "+v"(tid_));
    const int tid = tid_, lane = tid & 63, wid = __builtin_amdgcn_readfirstlane(tid >> 6), g = wid & 3, th = wid >> 2, h = kvh * 4 + g, l31 = lane & 31, hi = lane >> 5;
    LAS bf16_t* Ks = (LAS bf16_t*)(lds + AT_LDS_K); LAS bf16_t* Vt = (LAS bf16_t*)(lds + AT_LDS_V);
    const int q0w = qblk * 128 + th * 64;
    const size_t rq0 = (ctxq ? (size_t)MLAT + b * CTXL : (size_t)b * SEQ) + q0w;
    bf16x8 Qf[2][4];
#pragma unroll
    for (int qb = 0; qb < 2; ++qb)
#pragma unroll
        for (int s = 0; s < 4; ++s) Qf[qb][s] = *(const bf16x8*)(P + (rq0 + qb * 32 + l31) * INW + C_Q + h * 64 + s * 16 + hi * 8);
    f32x16 O[2][2];
#pragma unroll
    for (int i = 0; i < 2; ++i)
#pragma unroll
        for (int j = 0; j < 2; ++j)
#pragma unroll
            for (int r = 0; r < 16; ++r) O[i][j][r] = 0.f;
    const float sk = sink_l[h] * LOG2E;
    float m[2] = {sk, sk}, ls[2] = {hi == 0 ? 1.f : 0.f, hi == 0 ? 1.f : 0.f};
    const int jbeg = ctxq ? 6 : 0;
    const int lr = tid >> 3, lc = (tid & 7) * 8;
    u32x4 kreg, vreg; int jn = jbeg;
    auto tile_row0 = [&](int j) -> long { if (j >= 6) return (long)MLAT + b * CTXL + (j - 6) * 64; const int kp0 = qblk * 128 - 128 + 64 * j; return (kp0 < 0 || kp0 >= SEQ) ? -1L : (long)b * SEQ + kp0; };
    while (jn < 10 && tile_row0(jn) < 0) ++jn;
    { const long r0 = tile_row0(jn); kreg = *(const u32x4*)(P + (size_t)(r0 + lr) * INW + C_K + kvh * 64 + lc); vreg = *(const u32x4*)(P + (size_t)(r0 + lr) * INW + C_V + kvh * 64 + lc); }
    while (jn < 10) {
        const int j = jn;
        __syncthreads();
        *(LAS u32x4*)(Ks + lr * AT_KS + lc) = kreg;
        { const unsigned vv[4] = {vreg.x, vreg.y, vreg.z, vreg.w};
#pragma unroll
          for (int i = 0; i < 4; ++i) { Vt[(lc + 2 * i) * AT_KS + lr] = (bf16_t)(vv[i] & 0xffffu); Vt[(lc + 2 * i + 1) * AT_KS + lr] = (bf16_t)(vv[i] >> 16); } }
        __syncthreads();
        ++jn; while (jn < 10 && tile_row0(jn) < 0) ++jn;
        if (jn < 10) { const long r0 = tile_row0(jn); kreg = *(const u32x4*)(P + (size_t)(r0 + lr) * INW + C_K + kvh * 64 + lc); vreg = *(const u32x4*)(P + (size_t)(r0 + lr) * INW + C_V + kvh * 64 + lc); }
        const bool local = j < 6; const int kp0 = qblk * 128 - 128 + 64 * j;
        if (local && (kp0 + 63 < q0w - 128 || kp0 > q0w + 63 + 128)) continue;
        f32x16 St[2][2];
#pragma unroll
        for (int kb = 0; kb < 2; ++kb) {
            bf16x8 Kf[4];
#pragma unroll
            for (int s = 0; s < 4; ++s) Kf[s] = *(const LAS bf16x8*)(Ks + (kb * 32 + l31) * AT_KS + s * 16 + hi * 8);
#pragma unroll
            for (int qb = 0; qb < 2; ++qb) {
                f32x16 a;
#pragma unroll
                for (int r = 0; r < 16; ++r) a[r] = 0.f;
#pragma unroll
                for (int s = 0; s < 4; ++s) a = __builtin_amdgcn_mfma_f32_32x32x16_bf16(Kf[s], Qf[qb][s], a, 0, 0, 0);
                St[kb][qb] = a;
            }
        }
        const bool partial = local && (kp0 < q0w + 63 - 128 || kp0 + 63 > q0w + 128);
#pragma unroll
        for (int qb = 0; qb < 2; ++qb) {
            const int qp = q0w + qb * 32 + l31;
            float tmax = -1e30f;
#pragma unroll
            for (int kb = 0; kb < 2; ++kb)
#pragma unroll
                for (int r = 0; r < 16; ++r) {
                    float s = St[kb][qb][r] * LOG2E;
                    if (partial) { const int kp = kp0 + kb * 32 + (r & 3) + 8 * (r >> 2) + 4 * hi; const int dlt = kp - qp; if (dlt > 128 || dlt < -128) s = -1e30f; }
                    St[kb][qb][r] = s; tmax = fmaxf(tmax, s);
                }
            tmax = fmaxf(tmax, __shfl_xor(tmax, 32));
            const float mn = fmaxf(m[qb], tmax), alpha = __builtin_amdgcn_exp2f(m[qb] - mn);
            m[qb] = mn;
            float psum = 0.f;
#pragma unroll
            for (int kb = 0; kb < 2; ++kb)
#pragma unroll
                for (int r = 0; r < 16; ++r) { const float pv = __builtin_amdgcn_exp2f(St[kb][qb][r] - mn); St[kb][qb][r] = pv; psum += pv; }
            ls[qb] = ls[qb] * alpha + psum;
#pragma unroll
            for (int db = 0; db < 2; ++db)
#pragma unroll
                for (int r = 0; r < 16; ++r) O[db][qb][r] *= alpha;
        }
#pragma unroll
        for (int kb = 0; kb < 2; ++kb)
#pragma unroll
            for (int s2 = 0; s2 < 2; ++s2) {
                bf16x8 Pf[2];
#pragma unroll
                for (int qb = 0; qb < 2; ++qb) { u32x4 w; w.x = pg8::cvt_pk_bf16(St[kb][qb][8 * s2 + 0], St[kb][qb][8 * s2 + 1]); w.y = pg8::cvt_pk_bf16(St[kb][qb][8 * s2 + 2], St[kb][qb][8 * s2 + 3]);
                    w.z = pg8::cvt_pk_bf16(St[kb][qb][8 * s2 + 4], St[kb][qb][8 * s2 + 5]); w.w = pg8::cvt_pk_bf16(St[kb][qb][8 * s2 + 6], St[kb][qb][8 * s2 + 7]); Pf[qb] = __builtin_bit_cast(bf16x8, w); }
#pragma unroll
                for (int db = 0; db < 2; ++db) {
                    const LAS bf16_t* vp = Vt + (db * 32 + l31) * AT_KS + kb * 32 + s2 * 16 + 4 * hi;
                    const u32x2 v0 = *(const LAS u32x2*)vp, v1 = *(const LAS u32x2*)(vp + 8);
                    u32x4 vw; vw.x = v0.x; vw.y = v0.y; vw.z = v1.x; vw.w = v1.y; const bf16x8 Vf = __builtin_bit_cast(bf16x8, vw);
#pragma unroll
                    for (int qb = 0; qb < 2; ++qb) O[db][qb] = __builtin_amdgcn_mfma_f32_32x32x16_bf16(Vf, Pf[qb], O[db][qb], 0, 0, 0);
                }
            }
    }
#pragma unroll
    for (int qb = 0; qb < 2; ++qb) {
        const float lt = ls[qb] + __shfl_xor(ls[qb], 32); const float il = 1.f / lt;
        bf16_t* yr = Y + (rq0 + qb * 32 + l31) * DM + h * 64;
#pragma unroll
        for (int db = 0; db < 2; ++db)
#pragma unroll
            for (int i = 0; i < 4; ++i) *(uint2*)(yr + db * 32 + 8 * i + 4 * hi) = make_uint2(pg8::cvt_pk_bf16(O[db][qb][4 * i] * il, O[db][qb][4 * i + 1] * il), pg8::cvt_pk_bf16(O[db][qb][4 * i + 2] * il, O[db][qb][4 * i + 3] * il));
    }
    __syncthreads();
}
__device__ __forceinline__ void chunk_rows(int dir, int b, int j, int& row0, int& t0, int& len, int& seqbase) {
    if (j < 4) { const int n = dir ? 3 - j : j; t0 = 64 * n; len = CTXL; seqbase = MLAT + b * CTXL; }
    else { const int n = dir ? 127 - (j - 4) : j - 4; t0 = 64 * n; len = SEQ; seqbase = b * SEQ; }
    row0 = seqbase + t0;
}
struct RgW { const float* conv_w; const float* conv_b; const float* ga_b; const float* gx_b; const float* lam; const bf16_t* gw; };
constexpr int RG_US = 264;
constexpr int RG_LDS_US = 0, RG_LDS_HS = 64 * RG_US * 2;
template <bool FINAL> __device__ __forceinline__ void rg_item(LAS unsigned char* lds, const bf16_t* P, const RgW w, int b, int isctx, int n, float* RS, const float* RE, bf16_t* Y) {
    int tid_ = threadIdx.x; asm volatile("" : "+v"(tid_));
    const int tid = tid_, lane = tid & 63, wid = __builtin_amdgcn_readfirstlane(tid >> 6);
    LAS bf16_t* Us = (LAS bf16_t*)(lds + RG_LDS_US); LAS float* Hs = (LAS float*)(lds + RG_LDS_HS);
    const int t0 = 64 * n, len = isctx ? CTXL : SEQ, seqbase = isctx ? MLAT + b * CTXL : b * SEQ;
    {
        const int t = tid >> 3, cg = tid & 7, tt = t0 + t;
#pragma unroll
        for (int s8 = 0; s8 < 4; ++s8) {
            const int c0 = cg * 32 + s8 * 8;
            float u[8];
            { const f32x4 b0 = *(const f32x4*)(w.conv_b + c0), b1 = *(const f32x4*)(w.conv_b + c0 + 4); u[0] = b0[0]; u[1] = b0[1]; u[2] = b0[2]; u[3] = b0[3]; u[4] = b1[0]; u[5] = b1[1]; u[6] = b1[2]; u[7] = b1[3]; }
#pragma unroll
            for (int j = 0; j < 4; ++j) { const int ts = tt + j - 2;
                if (ts >= 0 && ts < len) {
                    const u32x4 xr = *(const u32x4*)(P + (size_t)(seqbase + ts) * INW + C_RX + c0);
                    const f32x4 w0 = *(const f32x4*)(w.conv_w + j * 256 + c0), w1 = *(const f32x4*)(w.conv_w + j * 256 + c0 + 4);
                    u[0] += w0[0] * __uint_as_float(xr.x << 16); u[1] += w0[1] * __uint_as_float(xr.x & 0xffff0000u);
                    u[2] += w0[2] * __uint_as_float(xr.y << 16); u[3] += w0[3] * __uint_as_float(xr.y & 0xffff0000u);
                    u[4] += w1[0] * __uint_as_float(xr.z << 16); u[5] += w1[1] * __uint_as_float(xr.z & 0xffff0000u);
                    u[6] += w1[2] * __uint_as_float(xr.w << 16); u[7] += w1[3] * __uint_as_float(xr.w & 0xffff0000u);
                } }
            u32x4 o; o.x = pg8::cvt_pk_bf16(u[0], u[1]); o.y = pg8::cvt_pk_bf16(u[2], u[3]); o.z = pg8::cvt_pk_bf16(u[4], u[5]); o.w = pg8::cvt_pk_bf16(u[6], u[7]);
            *(LAS u32x4*)(Us + t * RG_US + c0) = o;
        }
        if (FINAL) { for (int i = tid; i < 64 * 256 / 4; i += NTHREADS) ((LAS f32x4*)Hs)[i] = (f32x4){0.f, 0.f, 0.f, 0.f}; }
    }
    __syncthreads();
    {
        const int n4 = wid & 3, dir = wid >> 2, e = lane & 15, q4 = lane >> 4;
        const int j = isctx ? (dir ? 3 - n : n) : 4 + (dir ? 127 - n : n);
        bf16x8 Bf[2][4][2];
#pragma unroll
        for (int gt = 0; gt < 2; ++gt)
#pragma unroll
            for (int nb = 0; nb < 4; ++nb)
#pragma unroll
                for (int ks = 0; ks < 2; ++ks) Bf[gt][nb][ks] = *(const bf16x8*)(w.gw + ((size_t)((dir * 2 + gt) * 4 + n4) * 64 + nb * 16 + e) * 64 + ks * 32 + q4 * 8);
        float ba[4], bx[4], sp[4], carry[4], carryA[4];
#pragma unroll
        for (int nb = 0; nb < 4; ++nb) { const int c = n4 * 64 + nb * 16 + e; ba[nb] = w.ga_b[dir * 256 + c]; bx[nb] = w.gx_b[dir * 256 + c]; sp[nb] = log1pf(__expf(-w.lam[dir * 256 + c]));
            carry[nb] = FINAL ? RE[((size_t)(dir * 2 + b) * NCHK + j) * 256 + c] : 0.f; carryA[nb] = 1.f; }
#pragma unroll
        for (int mi = 0; mi < 4; ++mi) {
            const int mb = dir ? 3 - mi : mi;
            bf16x8 Af[2];
#pragma unroll
            for (int ks = 0; ks < 2; ++ks) Af[ks] = *(const LAS bf16x8*)(Us + (mb * 16 + e) * RG_US + n4 * 64 + ks * 32 + q4 * 8);
            float av[4][4], uv[4][4], hv[4][4];
#pragma unroll
            for (int nb = 0; nb < 4; ++nb) {
                f32x4 ar = (f32x4){0.f, 0.f, 0.f, 0.f}, ai = (f32x4){0.f, 0.f, 0.f, 0.f};
#pragma unroll
                for (int ks = 0; ks < 2; ++ks) { ar = __builtin_amdgcn_mfma_f32_16x16x32_bf16(Af[ks], Bf[0][nb][ks], ar, 0, 0, 0); ai = __builtin_amdgcn_mfma_f32_16x16x32_bf16(Af[ks], Bf[1][nb][ks], ai, 0, 0, 0); }
#pragma unroll
                for (int r = 0; r < 4; ++r) {
                    const float uval = bf2f(Us[(mb * 16 + q4 * 4 + r) * RG_US + n4 * 64 + nb * 16 + e]);
                    const float rr = pg8::fast_sigmoid(ar[r] + ba[nb]), ii = pg8::fast_sigmoid(ai[r] + bx[nb]);
                    const float la = -8.f * rr * sp[nb]; const float a = __expf(la);
                    av[nb][r] = a; uv[nb][r] = sqrtf(fmaxf(1.f - a * a, 0.f)) * (ii * uval); hv[nb][r] = 0.f;
                }
            }
#pragma unroll
            for (int qi = 0; qi < 4; ++qi) {
                const int qs = dir ? 3 - qi : qi;
#pragma unroll
                for (int nb = 0; nb < 4; ++nb) {
                    float h = carry[nb], A = carryA[nb], hn[4];
#pragma unroll
                    for (int ri = 0; ri < 4; ++ri) { const float a_ = dir ? av[nb][3 - ri] : av[nb][ri], u_ = dir ? uv[nb][3 - ri] : uv[nb][ri]; h = a_ * h + u_; A *= a_; hn[ri] = h; }
                    if (q4 == qs) {
#pragma unroll
                        for (int r = 0; r < 4; ++r) hv[nb][r] = dir ? hn[3 - r] : hn[r]; }
                    carry[nb] = __shfl(h, qs * 16 + e); if (!FINAL) carryA[nb] = __shfl(A, qs * 16 + e);
                }
            }
            if (FINAL) {
#pragma unroll
                for (int nb = 0; nb < 4; ++nb)
#pragma unroll
                    for (int r = 0; r < 4; ++r) (void)__hip_atomic_fetch_add(Hs + (mb * 16 + q4 * 4 + r) * 256 + n4 * 64 + nb * 16 + e, hv[nb][r], __ATOMIC_RELAXED, __HIP_MEMORY_SCOPE_WORKGROUP);
            }
        }
        if (!FINAL && q4 == 0) {
#pragma unroll
            for (int nb = 0; nb < 4; ++nb) { const int c = n4 * 64 + nb * 16 + e; float* o = RS + (((size_t)(dir * 2 + b) * NCHK + j) * 256 + c) * 2; o[0] = carryA[nb]; o[1] = carry[nb]; }
        }
    }
    if (FINAL) {
        __syncthreads();
        const int t = tid >> 3, cg = tid & 7; const size_t row = (size_t)seqbase + t0 + t;
#pragma unroll
        for (int s8 = 0; s8 < 4; ++s8) { const int c0 = cg * 32 + s8 * 8;
            const u32x4 gr = *(const u32x4*)(P + row * INW + C_RG + c0);
            const f32x4 h0 = *(const LAS f32x4*)(Hs + t * 256 + c0), h1 = *(const LAS f32x4*)(Hs + t * 256 + c0 + 4);
            u32x4 o; o.x = pg8::cvt_pk_bf16(h0[0] * __uint_as_float(gr.x << 16), h0[1] * __uint_as_float(gr.x & 0xffff0000u));
            o.y = pg8::cvt_pk_bf16(h0[2] * __uint_as_float(gr.y << 16), h0[3] * __uint_as_float(gr.y & 0xffff0000u));
            o.z = pg8::cvt_pk_bf16(h1[0] * __uint_as_float(gr.z << 16), h1[1] * __uint_as_float(gr.z & 0xffff0000u));
            o.w = pg8::cvt_pk_bf16(h1[2] * __uint_as_float(gr.w << 16), h1[3] * __uint_as_float(gr.w & 0xffff0000u));
            *(u32x4*)(Y + row * DM + 768 + c0) = o; }
    }
    __syncthreads();
}

constexpr int HG_PS = 65;
__device__ __forceinline__ void hg_load_tile(LAS float* dst, int stride, const bf16_t* P, size_t row0, int col0, int rev, int tid) {
    const int tau = tid >> 3, c8 = (tid & 7) * 8, t = rev ? 63 - tau : tau;
    const u32x4 v = *(const u32x4*)(P + (row0 + t) * INW + col0 + c8);
    LAS float* d = dst + tau * stride + c8;
    d[0] = __uint_as_float(v.x << 16); d[1] = __uint_as_float(v.x & 0xffff0000u); d[2] = __uint_as_float(v.y << 16); d[3] = __uint_as_float(v.y & 0xffff0000u);
    d[4] = __uint_as_float(v.z << 16); d[5] = __uint_as_float(v.z & 0xffff0000u); d[6] = __uint_as_float(v.w << 16); d[7] = __uint_as_float(v.w & 0xffff0000u);
}
__device__ __forceinline__ void hg_cumsum(LAS float* G, LAS float* Km, LAS float* seg, int tid) {
    const int k = tid & 63, sg = tid >> 6;
    float loc[8]; float run = 0.f;
#pragma unroll
    for (int i = 0; i < 8; ++i) { const float g = G[(sg * 8 + i) * HG_PS + k]; Km[(sg * 8 + i) * HG_PS + k] = 1.f - __expf(g); run += g; loc[i] = run; }
    seg[sg * 64 + k] = run;
    __syncthreads();
    float pre = 0.f;
#pragma unroll
    for (int s = 0; s < 8; ++s) { const float v = seg[s * 64 + k]; pre += (s < sg) ? v : 0.f; }
#pragma unroll
    for (int i = 0; i < 8; ++i) G[(sg * 8 + i) * HG_PS + k] = pre + loc[i];
    __syncthreads();
}
constexpr int HGL_G = 0, HGL_K = 64 * HG_PS * 4, HGL_V = 2 * 64 * HG_PS * 4, HGL_SEG = HGL_V + 64 * 64 * 4;
__device__ __forceinline__ void hgrn_local_item(LAS unsigned char* lds, const bf16_t* P, int dir, int b, int h, int j, float* Lbuf, float* Dbuf) {
    int tid_ = threadIdx.x; asm volatile("" : "+v"(tid_)); const int tid = tid_;
    LAS float* G = (LAS float*)(lds + HGL_G); LAS float* Km = (LAS float*)(lds + HGL_K); LAS float* Vs = (LAS float*)(lds + HGL_V); LAS float* seg = (LAS float*)(lds + HGL_SEG);
    int row0, t0, len, seqbase; chunk_rows(dir, b, j, row0, t0, len, seqbase);
    hg_load_tile(G, HG_PS, P, (size_t)row0, (dir ? C_HB : C_HF) + h * 64, dir, tid);
    hg_load_tile(Vs, 64, P, (size_t)row0, C_HI + h * 64, dir, tid);
    __syncthreads();
    hg_cumsum(G, Km, seg, tid);
    { const int k = tid & 63, sg = tid >> 6; const float be = G[63 * HG_PS + k];
#pragma unroll
      for (int i = 0; i < 8; ++i) { const int tau = sg * 8 + i; Km[tau * HG_PS + k] *= __expf(be - G[tau * HG_PS + k]); }
      if (sg == 0) Dbuf[((size_t)((dir * 2 + b) * 4 + h) * NCHK + j) * 64 + k] = __expf(be); }
    __syncthreads();
    { const int k = tid >> 3, v0 = (tid & 7) * 8; f32x4 a0 = (f32x4){0.f, 0.f, 0.f, 0.f}, a1 = a0;
#pragma unroll 8
      for (int s = 0; s < 64; ++s) { const float kh = Km[s * HG_PS + k]; a0 += kh * *(const LAS f32x4*)(Vs + s * 64 + v0); a1 += kh * *(const LAS f32x4*)(Vs + s * 64 + v0 + 4); }
      float* o = Lbuf + ((size_t)((dir * 2 + b) * 4 + h) * NCHK + j) * 4096 + k * 64 + v0; *(f32x4*)o = a0; *(f32x4*)(o + 4) = a1; }
    __syncthreads();
}
__device__ __forceinline__ void hgrn_state_scan(int chain, int elem, float* Lbuf, const float* Dbuf) {
    float* lp = Lbuf + (size_t)chain * NCHK * 4096 + elem; const float* dp = Dbuf + (size_t)chain * NCHK * 64 + (elem >> 6);
    float S = 0.f;
    for (int j0 = 0; j0 < NCHK; j0 += 33) {
        float Lv[33], dv[33];
#pragma unroll
        for (int i = 0; i < 33; ++i) { Lv[i] = lp[(size_t)(j0 + i) * 4096]; dv[i] = dp[(size_t)(j0 + i) * 64]; }
#pragma unroll
        for (int i = 0; i < 33; ++i) { lp[(size_t)(j0 + i) * 4096] = S; S = dv[i] * S + Lv[i]; }
    }
}
constexpr int HGO_Q = 0, HGO_B = 64 * HG_PS * 4, HGO_K = 2 * 64 * HG_PS * 4, HGO_A = 3 * 64 * HG_PS * 4, HGO_V = 4 * 64 * HG_PS * 4, HGO_S = HGO_V + 16384, HGO_O = HGO_S + 16384, HGO_SEG = HGO_O + 16384;
__device__ __forceinline__ void hgrn_out_item(LAS unsigned char* lds, const bf16_t* P, const float* hg_norm_l, int b, int h, int isctx, int n, const float* Lbuf, bf16_t* Y) {
    int tid_ = threadIdx.x; asm volatile("" : "+v"(tid_)); const int tid = tid_;
    LAS float* Qs = (LAS float*)(lds + HGO_Q); LAS float* Bc = (LAS float*)(lds + HGO_B); LAS float* Km = (LAS float*)(lds + HGO_K); LAS float* At = (LAS float*)(lds + HGO_A);
    LAS float* Vs = (LAS float*)(lds + HGO_V); LAS float* S0 = (LAS float*)(lds + HGO_S); LAS float* Os = (LAS float*)(lds + HGO_O); LAS float* seg = (LAS float*)(lds + HGO_SEG);
    const size_t row0 = (isctx ? (size_t)MLAT + b * CTXL : (size_t)b * SEQ) + 64 * n;
    for (int dir = 0; dir < 2; ++dir) {
        const int j = isctx ? (dir ? 3 - n : n) : 4 + (dir ? 127 - n : n);
        hg_load_tile(Qs, HG_PS, P, row0, C_HQ + h * 64, dir, tid);
        hg_load_tile(Bc, HG_PS, P, row0, (dir ? C_HB : C_HF) + h * 64, dir, tid);
        hg_load_tile(Vs, 64, P, row0, C_HI + h * 64, dir, tid);
        { const float* sp = Lbuf + ((size_t)((dir * 2 + b) * 4 + h) * NCHK + j) * 4096;
#pragma unroll
          for (int i = 0; i < 2; ++i) *(LAS f32x4*)(S0 + (tid + i * NTHREADS) * 4) = *(const f32x4*)(sp + (tid + i * NTHREADS) * 4); }
        __syncthreads();
        hg_cumsum(Bc, Km, seg, tid);
        { const int tau = tid >> 3, s0 = tid & 7; float acc[8];
#pragma unroll
          for (int i = 0; i < 8; ++i) acc[i] = 0.f;
          for (int k = 0; k < 64; ++k) { const float q = Qs[tau * HG_PS + k], bt = Bc[tau * HG_PS + k];
#pragma unroll
              for (int i = 0; i < 8; ++i) { const int sg = s0 + 8 * i; acc[i] += q * Km[sg * HG_PS + k] * __expf(fminf(bt - Bc[sg * HG_PS + k], 0.f)); } }
#pragma unroll
          for (int i = 0; i < 8; ++i) { const int sg = s0 + 8 * i; At[tau * HG_PS + sg] = sg <= tau ? acc[i] : 0.f; } }
        __syncthreads();
        { const int tau = tid >> 3, v0 = (tid & 7) * 8; f32x4 a0 = (f32x4){0.f, 0.f, 0.f, 0.f}, a1 = a0;
#pragma unroll 4
          for (int k = 0; k < 64; ++k) { const float qe = Qs[tau * HG_PS + k] * __expf(Bc[tau * HG_PS + k]); a0 += qe * *(const LAS f32x4*)(S0 + k * 64 + v0); a1 += qe * *(const LAS f32x4*)(S0 + k * 64 + v0 + 4); }
          for (int s = 0; s <= tau; ++s) { const float a = At[tau * HG_PS + s]; a0 += a * *(const LAS f32x4*)(Vs + s * 64 + v0); a1 += a * *(const LAS f32x4*)(Vs + s * 64 + v0 + 4); }
          const int t = dir ? 63 - tau : tau; LAS float* o = Os + t * 64 + v0;
          if (dir == 0) { *(LAS f32x4*)o = a0; *(LAS f32x4*)(o + 4) = a1; } else { *(LAS f32x4*)o = *(LAS f32x4*)o + a0; *(LAS f32x4*)(o + 4) = *(LAS f32x4*)(o + 4) + a1; } }
        __syncthreads();
    }
    { const int t = tid >> 3, v0 = (tid & 7) * 8; const f32x4 o0 = *(const LAS f32x4*)(Os + t * 64 + v0), o1 = *(const LAS f32x4*)(Os + t * 64 + v0 + 4);
      float ss = o0[0] * o0[0] + o0[1] * o0[1] + o0[2] * o0[2] + o0[3] * o0[3] + o1[0] * o1[0] + o1[1] * o1[1] + o1[2] * o1[2] + o1[3] * o1[3];
      ss += __shfl_xor(ss, 1); ss += __shfl_xor(ss, 2); ss += __shfl_xor(ss, 4);
      const float rs = rsqrtf(ss * (1.f / 64.f) + EPS);
      const f32x4 g0 = *(const f32x4*)(hg_norm_l + h * 64 + v0), g1 = *(const f32x4*)(hg_norm_l + h * 64 + v0 + 4);
      const u32x4 gt = *(const u32x4*)(P + (row0 + t) * INW + C_HG + h * 64 + v0);
      u32x4 w; w.x = pg8::cvt_pk_bf16(o0[0] * rs * g0[0] * __uint_as_float(gt.x << 16), o0[1] * rs * g0[1] * __uint_as_float(gt.x & 0xffff0000u));
      w.y = pg8::cvt_pk_bf16(o0[2] * rs * g0[2] * __uint_as_float(gt.y << 16), o0[3] * rs * g0[3] * __uint_as_float(gt.y & 0xffff0000u));
      w.z = pg8::cvt_pk_bf16(o1[0] * rs * g1[0] * __uint_as_float(gt.z << 16), o1[1] * rs * g1[1] * __uint_as_float(gt.z & 0xffff0000u));
      w.w = pg8::cvt_pk_bf16(o1[2] * rs * g1[2] * __uint_as_float(gt.w << 16), o1[3] * rs * g1[3] * __uint_as_float(gt.w & 0xffff0000u));
      *(u32x4*)(Y + (row0 + t) * DM + 512 + h * 64 + v0) = w; }
    __syncthreads();
}
__device__ __forceinline__ void rg_carry_scan(int gt, const float* RS, float* RE) {
    const int c = gt & 255, db = gt >> 8;
    const float* rs = RS + ((size_t)db * NCHK * 256 + c) * 2; float* re = RE + (size_t)db * NCHK * 256 + c;
    float h = 0.f;
    for (int j0 = 0; j0 < NCHK; j0 += 33) {
        float A[33], Hl[33];
#pragma unroll
        for (int i = 0; i < 33; ++i) { const float2 v = *(const float2*)(rs + (size_t)(j0 + i) * 512); A[i] = v.x; Hl[i] = v.y; }
#pragma unroll
        for (int i = 0; i < 33; ++i) { re[(size_t)(j0 + i) * 256] = h; h = A[i] * h + Hl[i]; }
    }
}
__device__ __forceinline__ void rg_gate_weights_prep(const float* ga_w, const float* gx_w, bf16_t* gw_all, int bid, int G, int tid) {
    const int total = DEPTH * 2 * 2 * 4 * 64 * 64;
    for (int i = bid * NTHREADS + tid; i < total; i += G * NTHREADS) {
        const int d = i & 63, e = (i >> 6) & 63, n4 = (i >> 12) & 3, gt = (i >> 14) & 1, dir = (i >> 15) & 1, l = i >> 16;
        const float* srcw = gt ? gx_w : ga_w;
        gw_all[i] = f2bf(srcw[((((size_t)l * 2 + dir) * 4 + n4) * 64 + d) * 64 + e]);
    }
}

__device__ __forceinline__ void ph_normmod(const float* xlat, const float* xctx, const float* g, const float* mods_l, int i_shift, int i_scale, bf16_t* XN, int nrows) {
    int tid_ = threadIdx.x; asm volatile("" : "+v"(tid_));
    int bid_ = blockIdx.x, G_ = gridDim.x; asm volatile("" : "+s"(bid_), "+s"(G_));
    const int lane = tid_ & 63, gw = bid_ * NWAVES + (tid_ >> 6), ngw = G_ * NWAVES;
    for (int row = gw; row < nrows; row += ngw) {
        const float* xr = row < MLAT ? xlat + (size_t)row * DM : xctx + (size_t)(row - MLAT) * DM;
        const int mi = row < MLAT ? row / SEQ : 2;
        const float* sh = mods_l + (size_t)mi * NMODS * DM + i_shift * DM; const float* sc = mods_l + (size_t)mi * NMODS * DM + i_scale * DM;
        f32x4 v[4]; float ss = 0.f;
#pragma unroll
        for (int j = 0; j < 4; ++j) { v[j] = *(const f32x4*)(xr + 256 * j + 4 * lane); ss += v[j].x * v[j].x + v[j].y * v[j].y + v[j].z * v[j].z + v[j].w * v[j].w; }
        const float rstd = rsqrtf(wave_sum(ss) * (1.f / DM) + EPS);
#pragma unroll
        for (int j = 0; j < 4; ++j) { const int c0 = 256 * j + 4 * lane; const f32x4 gg = *(const f32x4*)(g + c0), s1 = *(const f32x4*)(sc + c0), s0 = *(const f32x4*)(sh + c0);
            const f32x4 o = v[j] * rstd * gg * (s1 + 1.f) + s0;
            *(uint2*)(XN + (size_t)row * DM + c0) = make_uint2(pg8::cvt_pk_bf16(o[0], o[1]), pg8::cvt_pk_bf16(o[2], o[3])); }
    }
}
__device__ __forceinline__ void ph_final_norm(float* x, const float* g) {
    int tid_ = threadIdx.x; asm volatile("" : "+v"(tid_));
    int bid_ = blockIdx.x, G_ = gridDim.x; asm volatile("" : "+s"(bid_), "+s"(G_));
    const int lane = tid_ & 63, gw = bid_ * NWAVES + (tid_ >> 6), ngw = G_ * NWAVES;
    for (int row = gw; row < MLAT; row += ngw) {
        float* xr = x + (size_t)row * DM;
        f32x4 v[4]; float ss = 0.f;
#pragma unroll
        for (int j = 0; j < 4; ++j) { v[j] = *(const f32x4*)(xr + 256 * j + 4 * lane); ss += v[j].x * v[j].x + v[j].y * v[j].y + v[j].z * v[j].z + v[j].w * v[j].w; }
        const float rstd = rsqrtf(wave_sum(ss) * (1.f / DM) + EPS);
#pragma unroll
        for (int j = 0; j < 4; ++j) { const int c0 = 256 * j + 4 * lane; const f32x4 gg = *(const f32x4*)(g + c0); *(f32x4*)(xr + c0) = v[j] * rstd * gg; }
    }
}

typedef const __attribute__((address_space(4))) Params KParams;
__device__ __forceinline__ void run_phase(KParams& p, LAS unsigned char* lds, int ph) {
    unsigned char* ws = p.ws; float* out = p.out;
    float* mods = (float*)(ws + WS_MODS); float* rope = (float*)(ws + WS_ROPE); float* lb = (float*)(ws + WS_LB); float* xctx = (float*)(ws + WS_XCTX);
    bf16_t* XN = (bf16_t*)(ws + WS_XN); bf16_t* Y = XN; bf16_t* H = (bf16_t*)(ws + WS_H); bf16_t* P = H;
    int G = gridDim.x, bid = blockIdx.x, tid = threadIdx.x; asm volatile("" : "+s"(G), "+s"(bid), "+v"(tid));
    if (ph == PH_PRO_A) { rg_gate_weights_prep(p.in[17], p.in[19], (bf16_t*)(ws + WS_GW), bid, G, tid); return; }
    if (ph == PH_PRO_B) { ph_normmod(p.in[0], p.in[2], p.in[6], mods, 0, 1, XN, MTOT); return; }
    const int q = ph - PH_LAYER0, l = q / PH_PER_LAYER, s = q % PH_PER_LAYER;
    const bool wctx = l < DEPTH - 1; const int Mmix = wctx ? MTOT : MLAT;
    unsigned char* wl = ws + WS_W + l * W_L_STRIDE; const float* mods_l = mods + (size_t)l * 3 * NMODS * DM;
    const float* src_lat = l == 0 ? p.in[0] : out; const float* src_ctx = l == 0 ? p.in[2] : xctx;
    switch (s) {
    case S_FFN1_IN: case S_FFN2_IN: {
        const int M = s == S_FFN1_IN ? MTOT : Mmix;
        pg8::Gemm g{XN, (const bf16_t*)(wl + (s == S_FFN1_IN ? W_1IN : W_2IN)), M, 2 * FH, DM}; pg8::StaticOrder S; S.init(M, 2 * FH, G, bid);
        pg8::EpiSwiglu E{H, FH};
        pg8::gemm_phase<pg8::EpiSwiglu, pg8::StaticOrder, true, true>(lds, g, S, E);
    } break;
    case S_FFN1_OUT: case S_OUTPROJ: case S_FFN2_OUT: {
        const int M = s == S_FFN1_OUT ? MTOT : Mmix; const int K = s == S_OUTPROJ ? DM : FH;
        const bf16_t* A = s == S_OUTPROJ ? Y : H; const size_t wo = s == S_FFN1_OUT ? W_1OUT : (s == S_OUTPROJ ? W_OUT : W_2OUT);
        const int ig = s == S_FFN1_OUT ? 2 : (s == S_OUTPROJ ? 5 : 8);
        pg8::Gemm g{A, (const bf16_t*)(wl + wo), M, DM, K}; pg8::StaticOrder S; S.init(M, DM, G, bid);
        pg8::EpiResid E{s == S_FFN1_OUT ? src_lat : out, s == S_FFN1_OUT ? src_ctx : xctx, out, xctx, mods_l + ig * DM, s == S_OUTPROJ ? 1.f : 0.5f};
        pg8::gemm_phase<pg8::EpiResid, pg8::StaticOrder, true, true>(lds, g, S, E);
    } break;
    case S_INPROJ: {
        pg8::Gemm g{XN, (const bf16_t*)(wl + W_IN), MTOT, INW, DM}; pg8::StaticOrder S; S.init(MTOT, INW, G, bid);
        pg8::EpiInproj E{P, rope, lb + l * 512};
        pg8::gemm_phase<pg8::EpiInproj, pg8::StaticOrder, true, true>(lds, g, S, E);
    } break;
    case S_NORM_MIX: ph_normmod(out, xctx, p.in[9] + l * DM, mods_l, 3, 4, XN, MTOT); break;
    case S_NORM_FFN2: ph_normmod(out, xctx, p.in[22] + l * DM, mods_l, 6, 7, XN, Mmix); break;
    case S_NEXT_NORM:
        if (l + 1 < DEPTH) ph_normmod(out, xctx, p.in[6] + (l + 1) * DM, mods_l + 3 * NMODS * DM, 0, 1, XN, MTOT);
        else ph_final_norm(out, p.in[25]);
        break;
    case S_MIX1: {
        { const int nat = wctx ? 264 : 256;
          for (int it = bid; it < nat; it += G) { if (it < 256) attn_unit(lds, P, p.in[12] + l * 8, Y, it >> 7, (it >> 1) & 63, it & 1, false); else { const int c = it - 256; attn_unit(lds, P, p.in[12] + l * 8, Y, c >> 2, (c >> 1) & 1, c & 1, true); } } }
        const RgW w{p.in[15] + l * 1024, p.in[16] + l * 256, p.in[18] + l * 512, p.in[20] + l * 512, p.in[21] + l * 512, (const bf16_t*)(ws + WS_GW) + (size_t)l * 65536};
        for (int it = bid; it < 16 * NCHK; it += G) { const int chain = it / NCHK, j = it % NCHK; hgrn_local_item(lds, P, chain >> 3, (chain >> 2) & 1, chain & 3, j, (float*)(ws + WS_T), (float*)(ws + WS_HD)); }
        for (int it = bid; it < 2 * NCHK; it += G) { const int b = it / NCHK, jj = it % NCHK; rg_item<false>(lds, P, w, b, jj < 4, jj < 4 ? jj : jj - 4, (float*)(ws + WS_RS), nullptr, Y); }
    } break;
    case S_MIX2: {
        const int gt = (bid - (G - 2)) * NTHREADS + tid;
        if (bid >= G - 2) rg_carry_scan(gt, (const float*)(ws + WS_RS), (float*)(ws + WS_RE));
        if (bid < 128) hgrn_state_scan(bid >> 3, (bid & 7) * NTHREADS + tid, (float*)(ws + WS_T), (const float*)(ws + WS_HD));
    } break;
    case S_MIX3: {
        const RgW w{p.in[15] + l * 1024, p.in[16] + l * 256, p.in[18] + l * 512, p.in[20] + l * 512, p.in[21] + l * 512, (const bf16_t*)(ws + WS_GW) + (size_t)l * 65536};
        { const int nhi = wctx ? 8 * NCHK : 8 * 128;
          for (int it = bid; it < nhi; it += G) { int bh, isctx, n; if (wctx) { bh = it / NCHK; const int jj = it % NCHK; isctx = jj < 4; n = isctx ? jj : jj - 4; } else { bh = it >> 7; isctx = 0; n = it & 127; }
              hgrn_out_item(lds, P, p.in[14] + l * 256, bh >> 2, bh & 3, isctx, n, (const float*)(ws + WS_T), Y); } }
        const int nit = wctx ? 2 * NCHK : 2 * 128;
        for (int it = bid; it < nit; it += G) { int b, isctx, n; if (wctx) { b = it / NCHK; const int jj = it % NCHK; isctx = jj < 4; n = isctx ? jj : jj - 4; } else { b = it >> 7; isctx = 0; n = it & 127; }
            rg_item<true>(lds, P, w, b, isctx, n, nullptr, (const float*)(ws + WS_RE), Y); }
    } break;
    default: break;
    }
}

__global__ void __launch_bounds__(NTHREADS, 2) mk(Params p) {
    extern __shared__ __attribute__((aligned(16))) unsigned char lds_raw[];
    LAS unsigned char* lds = (LAS unsigned char*)lds_raw;
    cg::grid_group grid = cg::this_grid();
    for (int ph = p.ph_lo; ph < p.ph_hi; ++ph) {
        KParams* kp = (KParams*)__builtin_amdgcn_kernarg_segment_ptr(); asm volatile("" : "+s"(kp));
        run_phase(*kp, lds, ph);
        if (ph + 1 < p.ph_hi) grid.sync();
    }
}
}

extern "C" void kernel_launch(void* const* d_in, const int* in_sizes, int n_in, void* d_out, int out_size, void* d_ws, size_t ws_size, hipStream_t stream) {
    if (n_in != 26 || out_size != MLAT * DM || ws_size < WS_END) { fprintf(stderr, "kernel_launch: unexpected problem (n_in %d out %d ws %zu)\n", n_in, out_size, ws_size); return; }
    static int grid = 0;
    if (grid == 0) {
        int dev = 0, cus = 0, per_cu = 0;
        hipGetDevice(&dev); hipDeviceGetAttribute(&cus, hipDeviceAttributeMultiprocessorCount, dev);
        hipFuncSetAttribute((const void*)mk, hipFuncAttributeMaxDynamicSharedMemorySize, LDS_BYTES);
        hipOccupancyMaxActiveBlocksPerMultiprocessor(&per_cu, (const void*)mk, NTHREADS, LDS_BYTES);
        if (per_cu < 1) { fprintf(stderr, "kernel_launch: occupancy query says %d blocks per CU\n", per_cu); per_cu = 1; }
        grid = cus;
        (void)hipGetLastError();
    }
    const float* c = (const float*)d_in[1]; const float* c_ctx = (const float*)d_in[3];
    const float* ada_w = (const float*)d_in[4]; const float* ada_b = (const float*)d_in[5];
    const float* ffn1_w_in = (const float*)d_in[7]; const float* ffn1_w_out = (const float*)d_in[8];
    const float* w_in = (const float*)d_in[10]; const float* w_out = (const float*)d_in[11]; const float* attn_sink = (const float*)d_in[12];
    const float* hg_lb_logits = (const float*)d_in[13]; const float* hg_norm = (const float*)d_in[14]; const float* rg_conv_w = (const float*)d_in[15];
    const float* rg_conv_b = (const float*)d_in[16]; const float* rg_ga_w = (const float*)d_in[17]; const float* rg_ga_b = (const float*)d_in[18];
    const float* rg_gx_w = (const float*)d_in[19]; const float* rg_gx_b = (const float*)d_in[20]; const float* rg_lambda = (const float*)d_in[21];
    const float* ffn2_w_in = (const float*)d_in[23]; const float* ffn2_w_out = (const float*)d_in[24];
    unsigned char* ws = (unsigned char*)d_ws;
    float* mods = (float*)(ws + WS_MODS); float* rope = (float*)(ws + WS_ROPE); float* lb = (float*)(ws + WS_LB);
    bf16_t* XN = (bf16_t*)(ws + WS_XN); bf16_t* Y = XN; bf16_t* H = (bf16_t*)(ws + WS_H); bf16_t* P = H;
    float* T0 = (float*)(ws + WS_T); float* T1 = T0 + (size_t)MTOT * 256;
    Params prm{}; for (int i = 0; i < 26; ++i) prm.in[i] = (const float*)d_in[i]; prm.out = (float*)d_out; prm.ws = ws;
    auto run = [&](int lo, int hi) { prm.ph_lo = lo; prm.ph_hi = hi; hipLaunchKernelGGL(mk, dim3(grid), dim3(NTHREADS), LDS_BYTES, stream, prm); };

    k_mods<<<DEPTH * NMODS * DM / 256, 256, 0, stream>>>(c, c_ctx, ada_w, ada_b, mods);
    k_tables<<<8, 256, 0, stream>>>(hg_lb_logits, rope, lb);
    for (int l = 0; l < DEPTH; ++l) {
        unsigned char* wl = ws + WS_W + l * W_L_STRIDE;
        k_transpose<1><<<dim3(2 * FH / 32, DM / 32), 256, 0, stream>>>(ffn1_w_in + (size_t)l * DM * 2 * FH, (bf16_t*)(wl + W_1IN), DM, 2 * FH);
        k_transpose<0><<<dim3(DM / 32, FH / 32), 256, 0, stream>>>(ffn1_w_out + (size_t)l * FH * DM, (bf16_t*)(wl + W_1OUT), FH, DM);
        k_transpose<0><<<dim3(INW / 32, DM / 32), 256, 0, stream>>>(w_in + (size_t)l * DM * INW, (bf16_t*)(wl + W_IN), DM, INW);
        k_transpose<0><<<dim3(DM / 32, DM / 32), 256, 0, stream>>>(w_out + (size_t)l * DM * DM, (bf16_t*)(wl + W_OUT), DM, DM);
        k_transpose<1><<<dim3(2 * FH / 32, DM / 32), 256, 0, stream>>>(ffn2_w_in + (size_t)l * DM * 2 * FH, (bf16_t*)(wl + W_2IN), DM, 2 * FH);
        k_transpose<0><<<dim3(DM / 32, FH / 32), 256, 0, stream>>>(ffn2_w_out + (size_t)l * FH * DM, (bf16_t*)(wl + W_2OUT), FH, DM);
    }
    run(PH_PRO_A, PH_PRO_A + 1);
    run(PH_PRO_B, PH_PRO_B + 1);
    for (int l = 0; l < DEPTH; ++l) {
        const int base = PH_LAYER0 + l * PH_PER_LAYER; const bool wc = l < DEPTH - 1; const int nrows_mix = wc ? MTOT : MLAT;
        for (int s = S_FFN1_IN; s <= S_INPROJ; ++s) run(base + s, base + s + 1);
        run(base + S_MIX1, base + S_MIX1 + 1); run(base + S_MIX2, base + S_MIX2 + 1); run(base + S_MIX3, base + S_MIX3 + 1);
        for (int s = S_OUTPROJ; s <= S_NEXT_NORM; ++s) run(base + s, base + s + 1);
    }
}
```

```cpp
#include <hip/hip_runtime.h>
#include <cstdio>
#include <cstdint>
#include <hip/hip_cooperative_groups.h>
namespace cg = cooperative_groups;

namespace {
constexpr int DM = 1024, BATCH = 2, SEQ = 8192, DEPTH = 2, CTXL = 256, NMODS = 9, FH = 2816;
constexpr int MLAT = BATCH * SEQ, MCTX = BATCH * CTXL, MTOT = MLAT + MCTX;
constexpr int INW = 2560;
constexpr int C_Q = 0, C_K = 512, C_V = 640, C_HQ = 768, C_HF = 1024, C_HB = 1280, C_HI = 1536, C_HG = 1792, C_RX = 2048, C_RG = 2304;
constexpr float EPS = 1e-6f;

typedef unsigned short bf16_t;
typedef short bf16x8 __attribute__((ext_vector_type(8)));
typedef float f32x4 __attribute__((ext_vector_type(4)));
typedef unsigned u32x4 __attribute__((ext_vector_type(4)));
typedef float f32x16 __attribute__((ext_vector_type(16)));
typedef unsigned u32x2 __attribute__((ext_vector_type(2)));

constexpr size_t MiB = 1u << 20;
constexpr size_t WS_CTL = 0;
constexpr size_t WS_MODS = 1 * MiB;
constexpr size_t WS_ROPE = 1 * MiB + 512 * 1024;
constexpr size_t WS_LB = WS_ROPE + 32 * 1024;
constexpr size_t WS_XCTX = 2 * MiB;
constexpr size_t WS_W = 4 * MiB;
constexpr size_t W_L_STRIDE = 40 * MiB;
constexpr size_t W_1IN = 0, W_1OUT = 11 * MiB, W_IN = 16 * MiB + 512 * 1024, W_OUT = 21 * MiB + 512 * 1024, W_2IN = 23 * MiB + 512 * 1024, W_2OUT = 34 * MiB + 512 * 1024;
constexpr size_t WS_XN = 84 * MiB;
constexpr size_t WS_H = 117 * MiB;
constexpr size_t WS_T = 208 * MiB;
constexpr size_t WS_GW = 1 * MiB + 768 * 1024;
constexpr size_t WS_HD = 241 * MiB;
constexpr size_t WS_RS = 242 * MiB;
constexpr size_t WS_RE = 243 * MiB + 512 * 1024;
constexpr size_t WS_END = 245 * MiB;
constexpr int NCHK = 132;

__device__ __forceinline__ float bf2f(bf16_t v) { return __uint_as_float(((unsigned)v) << 16); }
__device__ __forceinline__ bf16_t f2bf(float f) { unsigned u = __float_as_uint(f); return (bf16_t)((u + 0x7fffu + ((u >> 16) & 1u)) >> 16); }
__device__ __forceinline__ float sigmoidf_(float x) { return 1.f / (1.f + __expf(-x)); }
__device__ __forceinline__ float siluf_(float x) { return x / (1.f + __expf(-x)); }
__device__ __forceinline__ float gelu_tanh(float x) { const float u = 0.7978845608028654f * (x + 0.044715f * x * x * x); return 0.5f * x * (1.f + tanhf(u)); }
__device__ __forceinline__ float wave_sum(float v) {
#pragma unroll
    for (int o = 1; o < 64; o <<= 1) v += __shfl_xor(v, o);
    return v;
}

namespace pg8 {
#define PG8_LAS __attribute__((address_space(3)))
typedef unsigned short bf16_t;
typedef short bf16x8 __attribute__((ext_vector_type(8)));
typedef float f32x4 __attribute__((ext_vector_type(4)));
typedef unsigned u32x4 __attribute__((ext_vector_type(4)));
constexpr int BM = 256, BK = 64, HALF = 128, HTB = HALF * BK * 2  , STAGE_BYTES = 8 * HTB, NXCD = 8, WGM = 8;

__host__ __device__ __forceinline__ int lds_byte(int r, int c) { const int st = (r >> 4) * 2 + (c >> 5), rr = r & 15, cc = c & 31, ob = rr * 64 + cc * 2; return st * 1024 + (ob ^ (((ob >> 9) & 1) << 5)); }
__host__ __device__ __forceinline__ void stage_rc(int b, int& R, int& C) { const int st = b / 1024, sb = b % 1024, swz = sb ^ (((sb >> 9) & 1) << 5); R = (st >> 1) * 16 + swz / 64; C = (st & 1) * 32 + (swz % 64) / 2; }
__host__ __device__ __forceinline__ int perm32(int rho) { const int n = rho >> 4, i = rho & 15; return 8 * (i >> 2) + 4 * n + (i & 3); }

struct Unit { int pm, pn; };
struct Gemm { const bf16_t* A; const bf16_t* Bt; int M, N, K; };

struct StaticOrder {
    int nM, nN, nwg, G, c;
    __host__ __device__ void init(int M, int N, int G_, int c_) { nM = M / BM; nN = N / BM; nwg = nM * nN; G = G_; c = c_; }
    __host__ __device__ bool next(int i, Unit& u) const {
        const long L = (long)i * G + c; if (L >= nwg) return false;
        int wgid = (int)L; { const int q = nwg / NXCD, r = nwg % NXCD, xcd = wgid % NXCD, off = wgid / NXCD; wgid = (xcd < r ? xcd * (q + 1) : r * (q + 1) + (xcd - r) * q) + off; }
        const int nig = WGM * nN, gid = wgid / nig, fm = gid * WGM, gsz = (nM - fm) < WGM ? (nM - fm) : WGM;
        u.pm = fm + ((wgid % nig) % gsz); u.pn = (wgid % nig) / gsz; return true;
    }
    __device__ __forceinline__ void a_ready(const Unit&) const {}
    __device__ __forceinline__ void done(const Unit&) const {}
};

template <class Epi, class Sched, bool ALIGN_EPI = false, bool SP2 = false>
__device__ __forceinline__ void gemm_phase(PG8_LAS unsigned char* lds, const Gemm g, const Sched& S, const Epi& E) {
    int tid_ = threadIdx.x; asm volatile("" : "+v"(tid_));
    const int tid = tid_, wid = __builtin_amdgcn_readfirstlane(tid >> 6), lane = tid & 63, wr = wid >> 2, wc = wid & 3, fr = lane & 15, fq = lane >> 4;
    const int K = g.K, nt = K / BK;
    unsigned voffA[2], voffB[2];
#pragma unroll
    for (int i = 0; i < 2; ++i) { int R, C; stage_rc(tid * 16 + i * 8192, R, C); const int Rb = Epi::PERM ? ((R & ~31) + perm32(R & 31)) : R;
        voffA[i] = (unsigned)(R * K + C) * 2u; voffB[i] = (unsigned)(Rb * K + C) * 2u; }
    const size_t kstep = (size_t)(BK * 2);
    const size_t hstep = (size_t)HALF * K * 2;
    const size_t tstep = 2 * hstep;
    const unsigned ldsw = (unsigned)wid * 1024u;
    const int aoff = lds_byte(wr * 64 + fr, fq * 8), boff = lds_byte(wc * 32 + fr, fq * 8);
#define PG8_SA(b, h) (((b) * 2 + (h)) * HTB)
#define PG8_SB(b, h) ((4 + (b) * 2 + (h)) * HTB)
#define PG8_STAGE(bufoff, gbase, voff) do { _Pragma("unroll") for (int _i = 0; _i < 2; ++_i) \
        __builtin_amdgcn_global_load_lds((const unsigned*)((const char*)(gbase) + (voff)[_i]), (PG8_LAS unsigned*)(lds + (bufoff) + ldsw + _i * 8192), 16, 0, 0); } while (0)
#define PG8_LDA(dst, b, h) do { _Pragma("unroll") for (int m = 0; m < 4; ++m) _Pragma("unroll") for (int k = 0; k < 2; ++k) dst[m][k] = *(const PG8_LAS bf16x8*)(lds + PG8_SA(b, h) + aoff + m * 2048 + k * 1024); } while (0)
#define PG8_LDB(dst, b, h) do { _Pragma("unroll") for (int n = 0; n < 2; ++n) _Pragma("unroll") for (int k = 0; k < 2; ++k) dst[n][k] = *(const PG8_LAS bf16x8*)(lds + PG8_SB(b, h) + boff + n * 2048 + k * 1024); } while (0)
#define PG8_MMA(ai, bj, At, Bt) do { __builtin_amdgcn_s_setprio(1); _Pragma("unroll") for (int m = 0; m < 4; ++m) _Pragma("unroll") for (int n = 0; n < 2; ++n) _Pragma("unroll") for (int k = 0; k < 2; ++k) \
        acc[ai][bj][m][n] = __builtin_amdgcn_mfma_f32_16x16x32_bf16(Bt[n][k], At[m][k], acc[ai][bj][m][n], 0, 0, 0); __builtin_amdgcn_s_setprio(0); } while (0)
#define PG8_WAIT_V(n) asm volatile("s_waitcnt vmcnt(" #n ")" ::: "memory")
#define PG8_WAIT_L(n) asm volatile("s_waitcnt lgkmcnt(" #n ")" ::: "memory")
#define PG8_BAR __builtin_amdgcn_s_barrier()
#define PG8_SCHED __builtin_amdgcn_sched_barrier(0)
    Unit cur, nxt; int ui = 0;
    if (!S.next(0, cur)) return;
    f32x4 acc[2][2][4][2];
#pragma unroll
    for (int a = 0; a < 2; ++a)
#pragma unroll
        for (int b = 0; b < 2; ++b)
#pragma unroll
            for (int m = 0; m < 4; ++m)
#pragma unroll
                for (int n = 0; n < 2; ++n) acc[a][b][m][n] = (f32x4){0.f, 0.f, 0.f, 0.f};
    bf16x8 At[4][2], B0[2][2], B1[2][2];
    const char* cA = (const char*)g.A + (size_t)cur.pm * tstep; const char* cB = (const char*)g.Bt + (size_t)cur.pn * tstep;
    S.a_ready(cur);
    if constexpr (SP2) {
        PG8_STAGE(PG8_SB(0, 0), cB, voffB); PG8_STAGE(PG8_SB(0, 1), cB + hstep, voffB); PG8_STAGE(PG8_SA(0, 0), cA, voffA); PG8_STAGE(PG8_SA(0, 1), cA + hstep, voffA);
        if (wr == 1) PG8_BAR;
        PG8_WAIT_V(2); PG8_BAR;
        PG8_STAGE(PG8_SB(1, 0), cB + kstep, voffB); PG8_STAGE(PG8_SA(1, 0), cA + kstep, voffA); PG8_STAGE(PG8_SB(1, 1), cB + hstep + kstep, voffB);
        PG8_WAIT_V(6); PG8_BAR;
    } else {
        PG8_STAGE(PG8_SB(0, 0), cB, voffB); PG8_STAGE(PG8_SA(0, 0), cA, voffA); PG8_STAGE(PG8_SB(0, 1), cB + hstep, voffB); PG8_STAGE(PG8_SA(0, 1), cA + hstep, voffA);
        if (wr == 1) PG8_BAR;
        PG8_WAIT_V(4); PG8_BAR;
        PG8_STAGE(PG8_SB(1, 0), cB + kstep, voffB); PG8_STAGE(PG8_SA(1, 0), cA + kstep, voffA); PG8_STAGE(PG8_SB(1, 1), cB + hstep + kstep, voffB);
        PG8_WAIT_V(6); PG8_BAR;
    }
    for (;;) {
        const bool has_next = S.next(ui + 1, nxt);
        const char* nA = has_next ? (const char*)g.A + (size_t)nxt.pm * tstep : cA; const char* nB = has_next ? (const char*)g.Bt + (size_t)nxt.pn * tstep : cB;
        for (int t = 0; t < nt; t += 2) {
            const bool last = (t == nt - 2);
            const char* a1 = cA + (size_t)(t + 1) * kstep;
            const char* a2 = last ? nA : cA + (size_t)(t + 2) * kstep; const char* b2 = last ? nB : cB + (size_t)(t + 2) * kstep;
            const char* a3 = a2 + kstep; const char* b3 = b2 + kstep;
            if (last && has_next) S.a_ready(nxt);
            if constexpr (SP2) {
            PG8_LDB(B0, 0, 0); PG8_LDB(B1, 0, 1); PG8_SCHED; PG8_LDA(At, 0, 0); PG8_STAGE(PG8_SA(1, 1), a1 + hstep, voffA);
            PG8_WAIT_V(8); PG8_WAIT_L(0); PG8_BAR; PG8_MMA(0, 0, At, B0); PG8_MMA(0, 1, At, B1); PG8_BAR; PG8_SCHED;
            PG8_LDA(At, 0, 1); PG8_STAGE(PG8_SB(0, 0), b2, voffB); PG8_STAGE(PG8_SB(0, 1), b2 + hstep, voffB); PG8_STAGE(PG8_SA(0, 0), a2, voffA);
            PG8_WAIT_V(8); PG8_WAIT_L(0); PG8_BAR; PG8_MMA(1, 0, At, B0); PG8_MMA(1, 1, At, B1); PG8_BAR; PG8_SCHED;
            PG8_LDB(B0, 1, 0); PG8_LDB(B1, 1, 1); PG8_SCHED; PG8_LDA(At, 1, 0); PG8_STAGE(PG8_SA(0, 1), a2 + hstep, voffA);
            PG8_WAIT_V(8); PG8_WAIT_L(0); PG8_BAR; PG8_MMA(0, 0, At, B0); PG8_MMA(0, 1, At, B1); PG8_BAR; PG8_SCHED;
            PG8_LDA(At, 1, 1); PG8_STAGE(PG8_SB(1, 0), b3, voffB); PG8_STAGE(PG8_SB(1, 1), b3 + hstep, voffB); PG8_STAGE(PG8_SA(1, 0), a3, voffA);
            PG8_WAIT_V(8); PG8_WAIT_L(0); PG8_BAR; PG8_MMA(1, 0, At, B0); PG8_MMA(1, 1, At, B1); PG8_BAR; PG8_SCHED;
            } else {
            PG8_LDB(B0, 0, 0); PG8_SCHED; PG8_LDA(At, 0, 0); PG8_STAGE(PG8_SA(1, 1), a1 + hstep, voffA);
            PG8_WAIT_L(8); PG8_BAR; PG8_WAIT_L(0); PG8_MMA(0, 0, At, B0); PG8_BAR; PG8_SCHED;
            PG8_LDB(B1, 0, 1); PG8_STAGE(PG8_SB(0, 0), b2, voffB);
            PG8_BAR; PG8_WAIT_L(0); PG8_MMA(0, 1, At, B1); PG8_BAR;
            PG8_LDA(At, 0, 1); PG8_STAGE(PG8_SA(0, 0), a2, voffA);
            PG8_BAR; PG8_WAIT_L(0); PG8_MMA(1, 0, At, B0); PG8_BAR; PG8_SCHED;
            PG8_STAGE(PG8_SB(0, 1), b2 + hstep, voffB);
            PG8_WAIT_V(6); PG8_BAR; PG8_MMA(1, 1, At, B1); PG8_BAR;
            PG8_LDB(B0, 1, 0); PG8_SCHED; PG8_LDA(At, 1, 0); PG8_STAGE(PG8_SA(0, 1), a2 + hstep, voffA);
            PG8_WAIT_L(8); PG8_BAR; PG8_WAIT_L(0); PG8_MMA(0, 0, At, B0); PG8_BAR; PG8_SCHED;
            PG8_LDB(B1, 1, 1); PG8_STAGE(PG8_SB(1, 0), b3, voffB);
            PG8_BAR; PG8_WAIT_L(0); PG8_MMA(0, 1, At, B1); PG8_BAR;
            PG8_LDA(At, 1, 1); PG8_STAGE(PG8_SA(1, 0), a3, voffA);
            PG8_BAR; PG8_WAIT_L(0); PG8_MMA(1, 0, At, B0); PG8_BAR; PG8_SCHED;
            PG8_STAGE(PG8_SB(1, 1), b3 + hstep, voffB);
            PG8_WAIT_V(6); PG8_BAR; PG8_MMA(1, 1, At, B1); PG8_BAR;
            }
        }
        if constexpr (ALIGN_EPI) { if (wr == 0) PG8_BAR; }
        if constexpr (!Epi::AFTER_DRAIN) { E(acc, cur, wr, wc, fr, fq); S.done(cur); }
        if (!has_next) break;
#pragma unroll
        for (int a = 0; a < 2; ++a)
#pragma unroll
            for (int b = 0; b < 2; ++b)
#pragma unroll
                for (int m = 0; m < 4; ++m)
#pragma unroll
                    for (int n = 0; n < 2; ++n) acc[a][b][m][n] = (f32x4){0.f, 0.f, 0.f, 0.f};
        cur = nxt; cA = nA; cB = nB; ++ui;
        if constexpr (ALIGN_EPI) { if (wr == 1) PG8_BAR; }
    }
    PG8_WAIT_V(0);
    if constexpr (!ALIGN_EPI) { if (wr == 0) PG8_BAR; }
    PG8_BAR;
    if constexpr (Epi::AFTER_DRAIN) { E.fused(acc, cur, wr, wc, fr, fq, lds, wid, lane); S.done(cur); }
#undef PG8_SA
#undef PG8_SB
#undef PG8_STAGE
#undef PG8_LDA
#undef PG8_LDB
#undef PG8_MMA
#undef PG8_WAIT_V
#undef PG8_WAIT_L
#undef PG8_BAR
#undef PG8_SCHED
}
}


namespace pg8 {
__device__ __forceinline__ unsigned cvt_pk_bf16(float lo, float hi) { unsigned r; asm volatile("v_cvt_pk_bf16_f32 %0, %1, %2" : "=v"(r) : "v"(lo), "v"(hi)); return r; }
__device__ __forceinline__ float fast_sigmoid(float x) { return __builtin_amdgcn_rcpf(1.f + __expf(-x)); }
__device__ __forceinline__ float fast_silu(float x) { return x * __builtin_amdgcn_rcpf(1.f + __expf(-x)); }
__device__ __forceinline__ float fast_gelu_tanh(float x) { const float u = 0.7978845608028654f * (x + 0.044715f * x * x * x); const float e = __expf(2.f * u); const float th = 1.f - 2.f * __builtin_amdgcn_rcpf(e + 1.f); return 0.5f * x * (1.f + th); }

struct EpiSwiglu {
    static constexpr bool PERM = true, AFTER_DRAIN = false;
    bf16_t* H; int ldh;
    __device__ __forceinline__ void operator()(const f32x4 (&acc)[2][2][4][2], const Unit& u, int wr, int wc, int fr, int fq) const {
        const int row0 = u.pm * BM + wr * 64 + fr, hc0 = u.pn * HALF + wc * 32 + 8 * fq;
#pragma unroll
        for (int ai = 0; ai < 2; ++ai)
#pragma unroll
            for (int m = 0; m < 4; ++m) {
                bf16_t* rowp = H + (size_t)(row0 + ai * HALF + m * 16) * ldh + hc0;
                const f32x4 a0 = acc[ai][0][m][0], a1 = acc[ai][0][m][1], b0 = acc[ai][1][m][0], b1 = acc[ai][1][m][1];
                float h[8];
#pragma unroll
                for (int j = 0; j < 4; ++j) { h[j] = fast_silu(a0[j]) * b0[j]; h[4 + j] = fast_silu(a1[j]) * b1[j]; }
                u32x4 w; w.x = cvt_pk_bf16(h[0], h[1]); w.y = cvt_pk_bf16(h[2], h[3]); w.z = cvt_pk_bf16(h[4], h[5]); w.w = cvt_pk_bf16(h[6], h[7]);
                *(u32x4*)rowp = w;
            }
    }
};
struct EpiResid {
    static constexpr bool PERM = false, AFTER_DRAIN = false;
    const float* src_lat; const float* src_ctx; float* dst_lat; float* dst_ctx; const float* gate_l; float gsc;
    __device__ __forceinline__ void operator()(const f32x4 (&acc)[2][2][4][2], const Unit& u, int wr, int wc, int fr, int fq) const {
        const bool lat = u.pm < 64; const int mi = lat ? (u.pm >> 5) : 2;
        const int rowl = (lat ? u.pm : u.pm - 64) * BM + wr * 64 + fr, col0 = u.pn * BM + wc * 32 + 4 * fq;
        const float* src = (lat ? src_lat : src_ctx) + (size_t)rowl * 1024 + col0; float* dst = (lat ? dst_lat : dst_ctx) + (size_t)rowl * 1024 + col0;
        const float* gp = gate_l + (size_t)mi * 9216 + col0;
#pragma unroll
        for (int bj = 0; bj < 2; ++bj)
#pragma unroll
            for (int n = 0; n < 2; ++n) { const f32x4 g = *(const f32x4*)(gp + bj * HALF + n * 16) * gsc;
#pragma unroll
                for (int ai = 0; ai < 2; ++ai) {
#pragma unroll
                    for (int m = 0; m < 4; ++m) { const size_t ro = (size_t)(ai * HALF + m * 16) * 1024 + bj * HALF + n * 16;
                        const f32x4 b = *(const f32x4*)(src + ro); *(f32x4*)(dst + ro) = b + g * acc[ai][bj][m][n]; }
                    asm volatile("" ::: "memory"); } }
    }
};
struct EpiInproj {
    static constexpr bool PERM = false, AFTER_DRAIN = false;
    bf16_t* P; const float* rope; const float* lb_l;
    __device__ __forceinline__ void operator()(const f32x4 (&acc)[2][2][4][2], const Unit& u, int wr, int wc, int fr, int fq) const {
        const bool lat = u.pm < 64;
        const int row0 = u.pm * BM + wr * 64 + fr, cw = wc * 32 + 4 * fq;
#pragma unroll
        for (int bj = 0; bj < 2; ++bj) {
            const int seg = u.pn * 2 + bj, colb = seg * HALF + cw;
            f32x4 lbv[2] = {(f32x4){0.f, 0.f, 0.f, 0.f}, (f32x4){0.f, 0.f, 0.f, 0.f}};
            if (seg >= 8 && seg < 12) { const int o = (seg - 8) * HALF + cw; lbv[0] = *(const f32x4*)(lb_l + o); lbv[1] = *(const f32x4*)(lb_l + o + 16); }
#pragma unroll
            for (int ai = 0; ai < 2; ++ai)
#pragma unroll
                for (int m = 0; m < 4; ++m) {
                    const int row = row0 + ai * HALF + m * 16;
                    f32x4 v0 = acc[ai][bj][m][0], v1 = acc[ai][bj][m][1];
                    if (seg < 5) {
                        if (lat) { const int t = row & (SEQ - 1); const int pos = (wc & 1) ? (t & 63) : (t >> 6);
                            const f32x4 cs = *(const f32x4*)(rope + pos * 16 + 4 * fq), sn = *(const f32x4*)(rope + 2048 + pos * 16 + 4 * fq);
                            const f32x4 o0 = v0 * cs - v1 * sn, o1 = v1 * cs + v0 * sn; v0 = o0; v1 = o1; }
                        if (seg < 4) { v0 = v0 * 0.125f; v1 = v1 * 0.125f; }
                    } else if (seg == 6 || seg == 7 || seg == 14 || seg == 15) {
#pragma unroll
                        for (int j = 0; j < 4; ++j) { v0[j] = fast_silu(v0[j]); v1[j] = fast_silu(v1[j]); }
                    } else if (seg >= 8 && seg < 12) {
#pragma unroll
                        for (int j = 0; j < 4; ++j) { v0[j] = __logf(lbv[0][j] + (1.f - lbv[0][j]) * fast_sigmoid(v0[j])); v1[j] = __logf(lbv[1][j] + (1.f - lbv[1][j]) * fast_sigmoid(v1[j])); }
                    } else if (seg >= 18) {
#pragma unroll
                        for (int j = 0; j < 4; ++j) { v0[j] = fast_gelu_tanh(v0[j]); v1[j] = fast_gelu_tanh(v1[j]); }
                    }
                    bf16_t* pp = P + (size_t)row * 2560 + colb;
                    *(uint2*)pp = make_uint2(cvt_pk_bf16(v0[0], v0[1]), cvt_pk_bf16(v0[2], v0[3]));
                    *(uint2*)(pp + 16) = make_uint2(cvt_pk_bf16(v1[0], v1[1]), cvt_pk_bf16(v1[2], v1[3]));
                    asm volatile("" ::: "memory");
                }
        }
    }
};
}
#define LAS __attribute__((address_space(3)))
constexpr int NWAVES = 8, NTHREADS = 512;
constexpr int LDS_BYTES = 147456;
struct Params { const float* in[26]; float* out; unsigned char* ws; int ph_lo, ph_hi; };
typedef const __attribute__((address_space(4))) Params KParams;
constexpr int PH_PRO_A = 0, PH_PRO_B = 1, PH_LAYER0 = 2, PH_PER_LAYER = 12, N_PHASES = PH_LAYER0 + DEPTH * PH_PER_LAYER;
enum { S_FFN1_IN = 0, S_FFN1_OUT = 1, S_NORM_MIX = 2, S_INPROJ = 3, S_MIX1 = 4, S_MIX2 = 5, S_MIX3 = 6, S_OUTPROJ = 7, S_NORM_FFN2 = 8, S_FFN2_IN = 9, S_FFN2_OUT = 10, S_NEXT_NORM = 11 };


constexpr int AT_KS = 72;
constexpr int AT_LDS_K = 0, AT_LDS_V = 64 * AT_KS * 2;
constexpr float LOG2E = 1.4426950408889634f;
__device__ __forceinline__ void attn_unit(LAS unsigned char* lds, const bf16_t* P, const float* sink_l, bf16_t* Y, int b, int qblk, int kvh, bool ctxq) {
    int tid_ = threadIdx.x; asm volatile("" : "+v"(tid_));
    const int tid = tid_, lane = tid & 63, wid = __builtin_amdgcn_readfirstlane(tid >> 6), g = wid & 3, th = wid >> 2, h = kvh * 4 + g, l31 = lane & 31, hi = lane >> 5;
    LAS bf16_t* Ks = (LAS bf16_t*)(lds + AT_LDS_K); LAS bf16_t* Vt = (LAS bf16_t*)(lds + AT_LDS_V);
    const int q0w = qblk * 128 + th * 64;
    const size_t rq0 = (ctxq ? (size_t)MLAT + b * CTXL : (size_t)b * SEQ) + q0w;
    bf16x8 Qf[2][4];
#pragma unroll
    for (int qb = 0; qb < 2; ++qb)
#pragma unroll
        for (int s = 0; s < 4; ++s) Qf[qb][s] = *(const bf16x8*)(P + (rq0 + qb * 32 + l31) * INW + C_Q + h * 64 + s * 16 + hi * 8);
    f32x16 O[2][2];
#pragma unroll
    for (int i = 0; i < 2; ++i)
#pragma unroll
        for (int j = 0; j < 2; ++j)
#pragma unroll
            for (int r = 0; r < 16; ++r) O[i][j][r] = 0.f;
    const float sk = sink_l[h] * LOG2E;
    float m[2] = {sk, sk}, ls[2] = {hi == 0 ? 1.f : 0.f, hi == 0 ? 1.f : 0.f};
    const int jbeg = ctxq ? 6 : 0;
    const int lr = tid >> 3, lc = (tid & 7) * 8;
    u32x4 kreg, vreg; int jn = jbeg;
    auto tile_row0 = [&](int j) -> long { if (j >= 6) return (long)MLAT + b * CTXL + (j - 6) * 64; const int kp0 = qblk * 128 - 128 + 64 * j; return (kp0 < 0 || kp0 >= SEQ) ? -1L : (long)b * SEQ + kp0; };
    while (jn < 10 && tile_row0(jn) < 0) ++jn;
    { const long r0 = tile_row0(jn); kreg = *(const u32x4*)(P + (size_t)(r0 + lr) * INW + C_K + kvh * 64 + lc); vreg = *(const u32x4*)(P + (size_t)(r0 + lr) * INW + C_V + kvh * 64 + lc); }
    while (jn < 10) {
        const int j = jn;
        __syncthreads();
        *(LAS u32x4*)(Ks + lr * AT_KS + lc) = kreg;
        { const unsigned vv[4] = {vreg.x, vreg.y, vreg.z, vreg.w};
#pragma unroll
          for (int i = 0; i < 4; ++i) { Vt[(lc + 2 * i) * AT_KS + lr] = (bf16_t)(vv[i] & 0xffffu); Vt[(lc + 2 * i + 1) * AT_KS + lr] = (bf16_t)(vv[i] >> 16); } }
        __syncthreads();
        ++jn; while (jn < 10 && tile_row0(jn) < 0) ++jn;
        if (jn < 10) { const long r0 = tile_row0(jn); kreg = *(const u32x4*)(P + (size_t)(r0 + lr) * INW + C_K + kvh * 64 + lc); vreg = *(const u32x4*)(P + (size_t)(r0 + lr) * INW + C_V + kvh * 64 + lc); }
        const bool local = j < 6; const int kp0 = qblk * 128 - 128 + 64 * j;
        if (local && (kp0 + 63 < q0w - 128 || kp0 > q0w + 63 + 128)) continue;
        f32x16 St[2][2];
#pragma unroll
        for (int kb = 0; kb < 2; ++kb) {
            bf16x8 Kf[4];
#pragma unroll
            for (int s = 0; s < 4; ++s) Kf[s] = *(const LAS bf16x8*)(Ks + (kb * 32 + l31) * AT_KS + s * 16 + hi * 8);
#pragma unroll
            for (int qb = 0; qb < 2; ++qb) {
                f32x16 a;
#pragma unroll
                for (int r = 0; r < 16; ++r) a[r] = 0.f;
#pragma unroll
                for (int s = 0; s < 4; ++s) a = __builtin_amdgcn_mfma_f32_32x32x16_bf16(Kf[s], Qf[qb][s], a, 0, 0, 0);
                St[kb][qb] = a;
            }
        }
        const bool partial = local && (kp0 < q0w + 63 - 128 || kp0 + 63 > q0w + 128);
#pragma unroll
        for (int qb = 0; qb < 2; ++qb) {
            const int qp = q0w + qb * 32 + l31;
            float tmax = -1e30f;
#pragma unroll
            for (int kb = 0; kb < 2; ++kb)
#pragma unroll
                for (int r = 0; r < 16; ++r) {
                    float s = St[kb][qb][r] * LOG2E;
                    if (partial) { const int kp = kp0 + kb * 32 + (r & 3) + 8 * (r >> 2) + 4 * hi; const int dlt = kp - qp; if (dlt > 128 || dlt < -128) s = -1e30f; }
                    St[kb][qb][r] = s; tmax = fmaxf(tmax, s);
                }
            tmax = fmaxf(tmax, __shfl_xor(tmax, 32));
            const float mn = fmaxf(m[qb], tmax), alpha = __builtin_amdgcn_exp2f(m[qb] - mn);
            m[qb] = mn;
            float psum = 0.f;
#pragma unroll
            for (int kb = 0; kb < 2; ++kb)
#pragma unroll
                for (int r = 0; r < 16; ++r) { const float pv = __builtin_amdgcn_exp2f(St[kb][qb][r] - mn); St[kb][qb][r] = pv; psum += pv; }
            ls[qb] = ls[qb] * alpha + psum;
#pragma unroll
            for (int db = 0; db < 2; ++db)
#pragma unroll
                for (int r = 0; r < 16; ++r) O[db][qb][r] *= alpha;
        }
#pragma unroll
        for (int kb = 0; kb < 2; ++kb)
#pragma unroll
            for (int s2 = 0; s2 < 2; ++s2) {
                bf16x8 Pf[2];
#pragma unroll
                for (int qb = 0; qb < 2; ++qb) { u32x4 w; w.x = pg8::cvt_pk_bf16(St[kb][qb][8 * s2 + 0], St[kb][qb][8 * s2 + 1]); w.y = pg8::cvt_pk_bf16(St[kb][qb][8 * s2 + 2], St[kb][qb][8 * s2 + 3]);
                    w.z = pg8::cvt_pk_bf16(St[kb][qb][8 * s2 + 4], St[kb][qb][8 * s2 + 5]); w.w = pg8::cvt_pk_bf16(St[kb][qb][8 * s2 + 6], St[kb][qb][8 * s2 + 7]); Pf[qb] = __builtin_bit_cast(bf16x8, w); }
#pragma unroll
                for (int db = 0; db < 2; ++db) {
                    const LAS bf16_t* vp = Vt + (db * 32 + l31) * AT_KS + kb * 32 + s2 * 16 + 4 * hi;
                    const u32x2 v0 = *(const LAS u32x2*)vp, v1 = *(const LAS u32x2*)(vp + 8);
                    u32x4 vw; vw.x = v0.x; vw.y = v0.y; vw.z = v1.x; vw.w = v1.y; const bf16x8 Vf = __builtin_bit_cast(bf16x8, vw);
#pragma unroll
                    for (int qb = 0; qb < 2; ++qb) O[db][qb] = __builtin_amdgcn_mfma_f32_32x32x16_bf16(Vf, Pf[qb], O[db][qb], 0, 0, 0);
                }
            }
    }
#pragma unroll
    for (int qb = 0; qb < 2; ++qb) {
        const float lt = ls[qb] + __shfl_xor(ls[qb], 32); const float il = 1.f / lt;
        bf16_t* yr = Y + (rq0 + qb * 32 + l31) * DM + h * 64;
#pragma unroll
        for (int db = 0; db < 2; ++db)
#pragma unroll
            for (int i = 0; i < 4; ++i) *(uint2*)(yr + db * 32 + 8 * i + 4 * hi) = make_uint2(pg8::cvt_pk_bf16(O[db][qb][4 * i] * il, O[db][qb][4 * i + 1] * il), pg8::cvt_pk_bf16(O[db][qb][4 * i + 2] * il, O[db][qb][4 * i + 3] * il));
    }
    __syncthreads();
}
__device__ __forceinline__ void chunk_rows(int dir, int b, int j, int& row0, int& t0, int& len, int& seqbase) {
    if (j < 4) { const int n = dir ? 3 - j : j; t0 = 64 * n; len = CTXL; seqbase = MLAT + b * CTXL; }
    else { const int n = dir ? 127 - (j - 4) : j - 4; t0 = 64 * n; len = SEQ; seqbase = b * SEQ; }
    row0 = seqbase + t0;
}
struct RgW { const float* conv_w; const float* conv_b; const float* ga_b; const float* gx_b; const float* lam; const bf16_t* gw; };
constexpr int RG_US = 264;
constexpr int RG_LDS_US = 0, RG_LDS_HS = 64 * RG_US * 2;
template <bool FINAL> __device__ __forceinline__ void rg_item(LAS unsigned char* lds, const bf16_t* P, const RgW w, int b, int isctx, int n, float* RS, const float* RE, bf16_t* Y) {
    int tid_ = threadIdx.x; asm volatile("" : "+v"(tid_));
    const int tid = tid_, lane = tid & 63, wid = __builtin_amdgcn_readfirstlane(tid >> 6);
    LAS bf16_t* Us = (LAS bf16_t*)(lds + RG_LDS_US); LAS float* Hs = (LAS float*)(lds + RG_LDS_HS);
    const int t0 = 64 * n, len = isctx ? CTXL : SEQ, seqbase = isctx ? MLAT + b * CTXL : b * SEQ;
    {
        const int t = tid >> 3, cg = tid & 7, tt = t0 + t;
#pragma unroll
        for (int s8 = 0; s8 < 4; ++s8) {
            const int c0 = cg * 32 + s8 * 8;
            float u[8];
            { const f32x4 b0 = *(const f32x4*)(w.conv_b + c0), b1 = *(const f32x4*)(w.conv_b + c0 + 4); u[0] = b0[0]; u[1] = b0[1]; u[2] = b0[2]; u[3] = b0[3]; u[4] = b1[0]; u[5] = b1[1]; u[6] = b1[2]; u[7] = b1[3]; }
#pragma unroll
            for (int j = 0; j < 4; ++j) { const int ts = tt + j - 2;
                if (ts >= 0 && ts < len) {
                    const u32x4 xr = *(const u32x4*)(P + (size_t)(seqbase + ts) * INW + C_RX + c0);
                    const f32x4 w0 = *(const f32x4*)(w.conv_w + j * 256 + c0), w1 = *(const f32x4*)(w.conv_w + j * 256 + c0 + 4);
                    u[0] += w0[0] * __uint_as_float(xr.x << 16); u[1] += w0[1] * __uint_as_float(xr.x & 0xffff0000u);
                    u[2] += w0[2] * __uint_as_float(xr.y << 16); u[3] += w0[3] * __uint_as_float(xr.y & 0xffff0000u);
                    u[4] += w1[0] * __uint_as_float(xr.z << 16); u[5] += w1[1] * __uint_as_float(xr.z & 0xffff0000u);
                    u[6] += w1[2] * __uint_as_float(xr.w << 16); u[7] += w1[3] * __uint_as_float(xr.w & 0xffff0000u);
                } }
            u32x4 o; o.x = pg8::cvt_pk_bf16(u[0], u[1]); o.y = pg8::cvt_pk_bf16(u[2], u[3]); o.z = pg8::cvt_pk_bf16(u[4], u[5]); o.w = pg8::cvt_pk_bf16(u[6], u[7]);
            *(LAS u32x4*)(Us + t * RG_US + c0) = o;
        }
        if (FINAL) { for (int i = tid; i < 64 * 256 / 4; i += NTHREADS) ((LAS f32x4*)Hs)[i] = (f32x4){0.f, 0.f, 0.f, 0.f}; }
    }
    __syncthreads();
    {
        const int n4 = wid & 3, dir = wid >> 2, e = lane & 15, q4 = lane >> 4;
        const int j = isctx ? (dir ? 3 - n : n) : 4 + (dir ? 127 - n : n);
        bf16x8 Bf[2][4][2];
#pragma unroll
        for (int gt = 0; gt < 2; ++gt)
#pragma unroll
            for (int nb = 0; nb < 4; ++nb)
#pragma unroll
                for (int ks = 0; ks < 2; ++ks) Bf[gt][nb][ks] = *(const bf16x8*)(w.gw + ((size_t)((dir * 2 + gt) * 4 + n4) * 64 + nb * 16 + e) * 64 + ks * 32 + q4 * 8);
        float ba[4], bx[4], sp[4], carry[4], carryA[4];
#pragma unroll
        for (int nb = 0; nb < 4; ++nb) { const int c = n4 * 64 + nb * 16 + e; ba[nb] = w.ga_b[dir * 256 + c]; bx[nb] = w.gx_b[dir * 256 + c]; sp[nb] = log1pf(__expf(-w.lam[dir * 256 + c]));
            carry[nb] = FINAL ? RE[((size_t)(dir * 2 + b) * NCHK + j) * 256 + c] : 0.f; carryA[nb] = 1.f; }
#pragma unroll
        for (int mi = 0; mi < 4; ++mi) {
            const int mb = dir ? 3 - mi : mi;
            bf16x8 Af[2];
#pragma unroll
            for (int ks = 0; ks < 2; ++ks) Af[ks] = *(const LAS bf16x8*)(Us + (mb * 16 + e) * RG_US + n4 * 64 + ks * 32 + q4 * 8);
            float av[4][4], uv[4][4], hv[4][4];
#pragma unroll
            for (int nb = 0; nb < 4; ++nb) {
                f32x4 ar = (f32x4){0.f, 0.f, 0.f, 0.f}, ai = (f32x4){0.f, 0.f, 0.f, 0.f};
#pragma unroll
                for (int ks = 0; ks < 2; ++ks) { ar = __builtin_amdgcn_mfma_f32_16x16x32_bf16(Af[ks], Bf[0][nb][ks], ar, 0, 0, 0); ai = __builtin_amdgcn_mfma_f32_16x16x32_bf16(Af[ks], Bf[1][nb][ks], ai, 0, 0, 0); }
#pragma unroll
                for (int r = 0; r < 4; ++r) {
                    const float uval = bf2f(Us[(mb * 16 + q4 * 4 + r) * RG_US + n4 * 64 + nb * 16 + e]);
                    const float rr = pg8::fast_sigmoid(ar[r] + ba[nb]), ii = pg8::fast_sigmoid(ai[r] + bx[nb]);
                    const float la = -8.f * rr * sp[nb]; const float a = __expf(la);
                    av[nb][r] = a; uv[nb][r] = sqrtf(fmaxf(1.f - a * a, 0.f)) * (ii * uval); hv[nb][r] = 0.f;
                }
            }
#pragma unroll
            for (int qi = 0; qi < 4; ++qi) {
                const int qs = dir ? 3 - qi : qi;
#pragma unroll
                for (int nb = 0; nb < 4; ++nb) {
                    float h = carry[nb], A = carryA[nb], hn[4];
#pragma unroll
                    for (int ri = 0; ri < 4; ++ri) { const float a_ = dir ? av[nb][3 - ri] : av[nb][ri], u_ = dir ? uv[nb][3 - ri] : uv[nb][ri]; h = a_ * h + u_; A *= a_; hn[ri] = h; }
                    if (q4 == qs) {
#pragma unroll
                        for (int r = 0; r < 4; ++r) hv[nb][r] = dir ? hn[3 - r] : hn[r]; }
                    carry[nb] = __shfl(h, qs * 16 + e); if (!FINAL) carryA[nb] = __shfl(A, qs * 16 + e);
                }
            }
            if (FINAL) {
#pragma unroll
                for (int nb = 0; nb < 4; ++nb)
#pragma unroll
                    for (int r = 0; r < 4; ++r) (void)__hip_atomic_fetch_add(Hs + (mb * 16 + q4 * 4 + r) * 256 + n4 * 64 + nb * 16 + e, hv[nb][r], __ATOMIC_RELAXED, __HIP_MEMORY_SCOPE_WORKGROUP);
            }
        }
        if (!FINAL && q4 == 0) {
#pragma unroll
            for (int nb = 0; nb < 4; ++nb) { const int c = n4 * 64 + nb * 16 + e; float* o = RS + (((size_t)(dir * 2 + b) * NCHK + j) * 256 + c) * 2; o[0] = carryA[nb]; o[1] = carry[nb]; }
        }
    }
    if (FINAL) {
        __syncthreads();
        const int t = tid >> 3, cg = tid & 7; const size_t row = (size_t)seqbase + t0 + t;
#pragma unroll
        for (int s8 = 0; s8 < 4; ++s8) { const int c0 = cg * 32 + s8 * 8;
            const u32x4 gr = *(const u32x4*)(P + row * INW + C_RG + c0);
            const f32x4 h0 = *(const LAS f32x4*)(Hs + t * 256 + c0), h1 = *(const LAS f32x4*)(Hs + t * 256 + c0 + 4);
            u32x4 o; o.x = pg8::cvt_pk_bf16(h0[0] * __uint_as_float(gr.x << 16), h0[1] * __uint_as_float(gr.x & 0xffff0000u));
            o.y = pg8::cvt_pk_bf16(h0[2] * __uint_as_float(gr.y << 16), h0[3] * __uint_as_float(gr.y & 0xffff0000u));
            o.z = pg8::cvt_pk_bf16(h1[0] * __uint_as_float(gr.z << 16), h1[1] * __uint_as_float(gr.z & 0xffff0000u));
            o.w = pg8::cvt_pk_bf16(h1[2] * __uint_as_float(gr.w << 16), h1[3] * __uint_as_float(gr.w & 0xffff0000u));
            *(u32x4*)(Y + row * DM + 768 + c0) = o; }
    }
    __syncthreads();
}

constexpr int HG_PS = 65;
__device__ __forceinline__ void hg_load_tile(LAS float* dst, int stride, const bf16_t* P, size_t row0, int col0, int rev, int tid) {
    const int tau = tid >> 3, c8 = (tid & 7) * 8, t = rev ? 63 - tau : tau;
    const u32x4 v = *(const u32x4*)(P + (row0 + t) * INW + col0 + c8);
    LAS float* d = dst + tau * stride + c8;
    d[0] = __uint_as_float(v.x << 16); d[1] = __uint_as_float(v.x & 0xffff0000u); d[2] = __uint_as_float(v.y << 16); d[3] = __uint_as_float(v.y & 0xffff0000u);
    d[4] = __uint_as_float(v.z << 16); d[5] = __uint_as_float(v.z & 0xffff0000u); d[6] = __uint_as_float(v.w << 16); d[7] = __uint_as_float(v.w & 0xffff0000u);
}
__device__ __forceinline__ void hg_cumsum(LAS float* G, LAS float* Km, LAS float* seg, int tid) {
    const int k = tid & 63, sg = tid >> 6;
    float loc[8]; float run = 0.f;
#pragma unroll
    for (int i = 0; i < 8; ++i) { const float g = G[(sg * 8 + i) * HG_PS + k]; Km[(sg * 8 + i) * HG_PS + k] = 1.f - __expf(g); run += g; loc[i] = run; }
    seg[sg * 64 + k] = run;
    __syncthreads();
    float pre = 0.f;
#pragma unroll
    for (int s = 0; s < 8; ++s) { const float v = seg[s * 64 + k]; pre += (s < sg) ? v : 0.f; }
#pragma unroll
    for (int i = 0; i < 8; ++i) G[(sg * 8 + i) * HG_PS + k] = pre + loc[i];
    __syncthreads();
}
constexpr int HGL_G = 0, HGL_K = 64 * HG_PS * 4, HGL_V = 2 * 64 * HG_PS * 4, HGL_SEG = HGL_V + 64 * 64 * 4;
__device__ __forceinline__ void hgrn_local_item(LAS unsigned char* lds, const bf16_t* P, int dir, int b, int h, int j, float* Lbuf, float* Dbuf) {
    int tid_ = threadIdx.x; asm volatile("" : "+v"(tid_)); const int tid = tid_;
    LAS float* G = (LAS float*)(lds + HGL_G); LAS float* Km = (LAS float*)(lds + HGL_K); LAS float* Vs = (LAS float*)(lds + HGL_V); LAS float* seg = (LAS float*)(lds + HGL_SEG);
    int row0, t0, len, seqbase; chunk_rows(dir, b, j, row0, t0, len, seqbase);
    hg_load_tile(G, HG_PS, P, (size_t)row0, (dir ? C_HB : C_HF) + h * 64, dir, tid);
    hg_load_tile(Vs, 64, P, (size_t)row0, C_HI + h * 64, dir, tid);
    __syncthreads();
    hg_cumsum(G, Km, seg, tid);
    { const int k = tid & 63, sg = tid >> 6; const float be = G[63 * HG_PS + k];
#pragma unroll
      for (int i = 0; i < 8; ++i) { const int tau = sg * 8 + i; Km[tau * HG_PS + k] *= __expf(be - G[tau * HG_PS + k]); }
      if (sg == 0) Dbuf[((size_t)((dir * 2 + b) * 4 + h) * NCHK + j) * 64 + k] = __expf(be); }
    __syncthreads();
    { const int k = tid >> 3, v0 = (tid & 7) * 8; f32x4 a0 = (f32x4){0.f, 0.f, 0.f, 0.f}, a1 = a0;
#pragma unroll 8
      for (int s = 0; s < 64; ++s) { const float kh = Km[s * HG_PS + k]; a0 += kh * *(const LAS f32x4*)(Vs + s * 64 + v0); a1 += kh * *(const LAS f32x4*)(Vs + s * 64 + v0 + 4); }
      float* o = Lbuf + ((size_t)((dir * 2 + b) * 4 + h) * NCHK + j) * 4096 + k * 64 + v0; *(f32x4*)o = a0; *(f32x4*)(o + 4) = a1; }
    __syncthreads();
}
__device__ __forceinline__ void hgrn_state_scan(int chain, int elem, float* Lbuf, const float* Dbuf) {
    float* lp = Lbuf + (size_t)chain * NCHK * 4096 + elem; const float* dp = Dbuf + (size_t)chain * NCHK * 64 + (elem >> 6);
    float S = 0.f;
    for (int j0 = 0; j0 < NCHK; j0 += 33) {
        float Lv[33], dv[33];
#pragma unroll
        for (int i = 0; i < 33; ++i) { Lv[i] = lp[(size_t)(j0 + i) * 4096]; dv[i] = dp[(size_t)(j0 + i) * 64]; }
#pragma unroll
        for (int i = 0; i < 33; ++i) { lp[(size_t)(j0 + i) * 4096] = S; S = dv[i] * S + Lv[i]; }
    }
}
constexpr int HGO_Q = 0, HGO_B = 64 * HG_PS * 4, HGO_K = 2 * 64 * HG_PS * 4, HGO_A = 3 * 64 * HG_PS * 4, HGO_V = 4 * 64 * HG_PS * 4, HGO_S = HGO_V + 16384, HGO_O = HGO_S + 16384, HGO_SEG = HGO_O + 16384;
__device__ __forceinline__ void hgrn_out_item(LAS unsigned char* lds, const bf16_t* P, const float* hg_norm_l, int b, int h, int isctx, int n, const float* Lbuf, bf16_t* Y) {
    int tid_ = threadIdx.x; asm volatile("" : "+v"(tid_)); const int tid = tid_;
    LAS float* Qs = (LAS float*)(lds + HGO_Q); LAS float* Bc = (LAS float*)(lds + HGO_B); LAS float* Km = (LAS float*)(lds + HGO_K); LAS float* At = (LAS float*)(lds + HGO_A);
    LAS float* Vs = (LAS float*)(lds + HGO_V); LAS float* S0 = (LAS float*)(lds + HGO_S); LAS float* Os = (LAS float*)(lds + HGO_O); LAS float* seg = (LAS float*)(lds + HGO_SEG);
    const size_t row0 = (isctx ? (size_t)MLAT + b * CTXL : (size_t)b * SEQ) + 64 * n;
    for (int dir = 0; dir < 2; ++dir) {
        const int j = isctx ? (dir ? 3 - n : n) : 4 + (dir ? 127 - n : n);
        hg_load_tile(Qs, HG_PS, P, row0, C_HQ + h * 64, dir, tid);
        hg_load_tile(Bc, HG_PS, P, row0, (dir ? C_HB : C_HF) + h * 64, dir, tid);
        hg_load_tile(Vs, 64, P, row0, C_HI + h * 64, dir, tid);
        { const float* sp = Lbuf + ((size_t)((dir * 2 + b) * 4 + h) * NCHK + j) * 4096;
#pragma unroll
          for (int i = 0; i < 2; ++i) *(LAS f32x4*)(S0 + (tid + i * NTHREADS) * 4) = *(const f32x4*)(sp + (tid + i * NTHREADS) * 4); }
        __syncthreads();
        hg_cumsum(Bc, Km, seg, tid);
        { const int tau = tid >> 3, s0 = tid & 7; float acc[8];
#pragma unroll
          for (int i = 0; i < 8; ++i) acc[i] = 0.f;
          for (int k = 0; k < 64; ++k) { const float q = Qs[tau * HG_PS + k], bt = Bc[tau * HG_PS + k];
#pragma unroll
              for (int i = 0; i < 8; ++i) { const int sg = s0 + 8 * i; acc[i] += q * Km[sg * HG_PS + k] * __expf(fminf(bt - Bc[sg * HG_PS + k], 0.f)); } }
#pragma unroll
          for (int i = 0; i < 8; ++i) { const int sg = s0 + 8 * i; At[tau * HG_PS + sg] = sg <= tau ? acc[i] : 0.f; } }
        __syncthreads();
        { const int tau = tid >> 3, v0 = (tid & 7) * 8; f32x4 a0 = (f32x4){0.f, 0.f, 0.f, 0.f}, a1 = a0;
#pragma unroll 4
          for (int k = 0; k < 64; ++k) { const float qe = Qs[tau * HG_PS + k] * __expf(Bc[tau * HG_PS + k]); a0 += qe * *(const LAS f32x4*)(S0 + k * 64 + v0); a1 += qe * *(const LAS f32x4*)(S0 + k * 64 + v0 + 4); }
          for (int s = 0; s <= tau; ++s) { const float a = At[tau * HG_PS + s]; a0 += a * *(const LAS f32x4*)(Vs + s * 64 + v0); a1 += a * *(const LAS f32x4*)(Vs + s * 64 + v0 + 4); }
          const int t = dir ? 63 - tau : tau; LAS float* o = Os + t * 64 + v0;
          if (dir == 0) { *(LAS f32x4*)o = a0; *(LAS f32x4*)(o + 4) = a1; } else { *(LAS f32x4*)o = *(LAS f32x4*)o + a0; *(LAS f32x4*)(o + 4) = *(LAS f32x4*)(o + 4) + a1; } }
        __syncthreads();
    }
    { const int t = tid >> 3, v0 = (tid & 7) * 8; const f32x4 o0 = *(const LAS f32x4*)(Os + t * 64 + v0), o1 = *(const LAS f32x4*)(Os + t * 64 + v0 + 4);
      float ss = o0[0] * o0[0] + o0[1] * o0[1] + o0[2] * o0[2] + o0[3] * o0[3] + o1[0] * o1[0] + o1[1] * o1[1] + o1[2] * o1[2] + o1[3] * o1[3];
      ss += __shfl_xor(ss, 1); ss += __shfl_xor(ss, 2); ss += __shfl_xor(ss, 4);
      const float rs = rsqrtf(ss * (1.f / 64.f) + EPS);
      const f32x4 g0 = *(const f32x4*)(hg_norm_l + h * 64 + v0), g1 = *(const f32x4*)(hg_norm_l + h * 64 + v0 + 4);
      const u32x4 gt = *(const u32x4*)(P + (row0 + t) * INW + C_HG + h * 64 + v0);
      u32x4 w; w.x = pg8::cvt_pk_bf16(o0[0] * rs * g0[0] * __uint_as_float(gt.x << 16), o0[1] * rs * g0[1] * __uint_as_float(gt.x & 0xffff0000u));
      w.y = pg8::cvt_pk_bf16(o0[2] * rs * g0[2] * __uint_as_float(gt.y << 16), o0[3] * rs * g0[3] * __uint_as_float(gt.y & 0xffff0000u));
      w.z = pg8::cvt_pk_bf16(o1[0] * rs * g1[0] * __uint_as_float(gt.z << 16), o1[1] * rs * g1[1] * __uint_as_float(gt.z & 0xffff0000u));
      w.w = pg8::cvt_pk_bf16(o1[2] * rs * g1[2] * __uint_as_float(gt.w << 16), o1[3] * rs * g1[3] * __uint_as_float(gt.w & 0xffff0000u));
      *(u32x4*)(Y + (row0 + t) * DM + 512 + h * 64 + v0) = w; }
    __syncthreads();
}
__device__ __forceinline__ void rg_carry_scan(int gt, const float* RS, float* RE) {
    const int c = gt & 255, db = gt >> 8;
    const float* rs = RS + ((size_t)db * NCHK * 256 + c) * 2; float* re = RE + (size_t)db * NCHK * 256 + c;
    float h = 0.f;
    for (int j0 = 0; j0 < NCHK; j0 += 33) {
        float A[33], Hl[33];
#pragma unroll
        for (int i = 0; i < 33; ++i) { const float2 v = *(const float2*)(rs + (size_t)(j0 + i) * 512); A[i] = v.x; Hl[i] = v.y; }
#pragma unroll
        for (int i = 0; i < 33; ++i) { re[(size_t)(j0 + i) * 256] = h; h = A[i] * h + Hl[i]; }
    }
}
__device__ __forceinline__ void rg_gate_weights_prep(const float* ga_w, const float* gx_w, bf16_t* gw_all, int bid, int G, int tid) {
    const int total = DEPTH * 2 * 2 * 4 * 64 * 64;
    for (int i = bid * NTHREADS + tid; i < total; i += G * NTHREADS) {
        const int d = i & 63, e = (i >> 6) & 63, n4 = (i >> 12) & 3, gt = (i >> 14) & 1, dir = (i >> 15) & 1, l = i >> 16;
        const float* srcw = gt ? gx_w : ga_w;
        gw_all[i] = f2bf(srcw[((((size_t)l * 2 + dir) * 4 + n4) * 64 + d) * 64 + e]);
    }
}

__device__ __forceinline__ void ph_normmod(const float* xlat, const float* xctx, const float* g, const float* mods_l, int i_shift, int i_scale, bf16_t* XN, int nrows) {
    int tid_ = threadIdx.x; asm volatile("" : "+v"(tid_));
    int bid_ = blockIdx.x, G_ = gridDim.x; asm volatile("" : "+s"(bid_), "+s"(G_));
    const int lane = tid_ & 63, gw = bid_ * NWAVES + (tid_ >> 6), ngw = G_ * NWAVES;
    for (int row = gw; row < nrows; row += ngw) {
        const float* xr = row < MLAT ? xlat + (size_t)row * DM : xctx + (size_t)(row - MLAT) * DM;
        const int mi = row < MLAT ? row / SEQ : 2;
        const float* sh = mods_l + (size_t)mi * NMODS * DM + i_shift * DM; const float* sc = mods_l + (size_t)mi * NMODS * DM + i_scale * DM;
        f32x4 v[4]; float ss = 0.f;
#pragma unroll
        for (int j = 0; j < 4; ++j) { v[j] = *(const f32x4*)(xr + 256 * j + 4 * lane); ss += v[j].x * v[j].x + v[j].y * v[j].y + v[j].z * v[j].z + v[j].w * v[j].w; }
        const float rstd = rsqrtf(wave_sum(ss) * (1.f / DM) + EPS);
#pragma unroll
        for (int j = 0; j < 4; ++j) { const int c0 = 256 * j + 4 * lane; const f32x4 gg = *(const f32x4*)(g + c0), s1 = *(const f32x4*)(sc + c0), s0 = *(const f32x4*)(sh + c0);
            const f32x4 o = v[j] * rstd * gg * (s1 + 1.f) + s0;
            *(uint2*)(XN + (size_t)row * DM + c0) = make_uint2(pg8::cvt_pk_bf16(o[0], o[1]), pg8::cvt_pk_bf16(o[2], o[3])); }
    }
}
__device__ __forceinline__ void ph_final_norm(float* x, const float* g) {
    int tid_ = threadIdx.x; asm volatile("" : "+v"(tid_));
    int bid_ = blockIdx.x, G_ = gridDim.x; asm volatile("" : "+s"(bid_), "+s"(G_));
    const int lane = tid_ & 63, gw = bid_ * NWAVES + (tid_ >> 6), ngw = G_ * NWAVES;
    for (int row = gw; row < MLAT; row += ngw) {
        float* xr = x + (size_t)row * DM;
        f32x4 v[4]; float ss = 0.f;
#pragma unroll
        for (int j = 0; j < 4; ++j) { v[j] = *(const f32x4*)(xr + 256 * j + 4 * lane); ss += v[j].x * v[j].x + v[j].y * v[j].y + v[j].z * v[j].z + v[j].w * v[j].w; }
        const float rstd = rsqrtf(wave_sum(ss) * (1.f / DM) + EPS);
#pragma unroll
        for (int j = 0; j < 4; ++j) { const int c0 = 256 * j + 4 * lane; const f32x4 gg = *(const f32x4*)(g + c0); *(f32x4*)(xr + c0) = v[j] * rstd * gg; }
    }
}


__device__ __forceinline__ void pro_transpose_item(const float* W, int K, int N, bf16_t* WT, bool swi, LAS float* scr, int item, int lane) {
    const int nblk = N / 32, kb = item / nblk, nb = item % nblk, k0 = 64 * kb, n0 = 32 * nb;
    int nd0 = n0; if (swi) { const int half = n0 >= FH, nn = half ? n0 - FH : n0; nd0 = 256 * (nn / 128) + 128 * half + (nn % 128); }
#pragma unroll 8
    for (int i = 0; i < 32; ++i) { const int kk = 2 * i + (lane >> 5); scr[kk * 33 + (lane & 31)] = W[(size_t)(k0 + kk) * N + n0 + (lane & 31)]; }
    asm volatile("s_waitcnt lgkmcnt(0)" ::: "memory");
    const int c = lane & 7;
#pragma unroll
    for (int j = 0; j < 4; ++j) { const int n = (lane >> 3) + 8 * j; const LAS float* s = scr + (8 * c) * 33 + n;
        u32x4 o; o.x = pg8::cvt_pk_bf16(s[0 * 33], s[1 * 33]); o.y = pg8::cvt_pk_bf16(s[2 * 33], s[3 * 33]); o.z = pg8::cvt_pk_bf16(s[4 * 33], s[5 * 33]); o.w = pg8::cvt_pk_bf16(s[6 * 33], s[7 * 33]);
        *(u32x4*)(WT + (size_t)(nd0 + n) * K + k0 + 8 * c) = o; }
    asm volatile("s_waitcnt lgkmcnt(0)" ::: "memory");
}
__device__ __forceinline__ void ph_prologue_a(KParams& p, LAS unsigned char* lds, int bid, int G, int tid) {
    unsigned char* ws = p.ws; const int lane = tid & 63, wid = __builtin_amdgcn_readfirstlane(tid >> 6);
    {
        LAS float* sc = (LAS float*)lds;
        LAS float* part = (LAS float*)(lds + 12288);
        if (bid < 288) {
            for (int i = tid; i < 3 * DM; i += NTHREADS) { const int mi = i >> 10, k = i & 1023; const float v = mi < 2 ? p.in[1][mi * DM + k] : p.in[3][k]; sc[i] = siluf_(v); }
            __syncthreads();
            for (int u = bid; u < 288; u += G) {
                const int l = u / 144, n0 = (u % 144) * 64;
                const float* wp = p.in[4] + (size_t)l * DM * NMODS * DM + (size_t)(wid * 128) * (NMODS * DM) + n0 + lane;
                float a0 = 0.f, a1 = 0.f, a2 = 0.f;
#pragma unroll 16
                for (int k = 0; k < 128; ++k) { const float wv = wp[(size_t)k * (NMODS * DM)]; const int kk = wid * 128 + k; a0 += sc[kk] * wv; a1 += sc[1024 + kk] * wv; a2 += sc[2048 + kk] * wv; }
                part[(wid * 3 + 0) * 64 + lane] = a0; part[(wid * 3 + 1) * 64 + lane] = a1; part[(wid * 3 + 2) * 64 + lane] = a2;
                __syncthreads();
                if (tid < 192) { const int mi = tid >> 6, c = tid & 63; float s = p.in[5][l * NMODS * DM + n0 + c];
#pragma unroll
                    for (int w8 = 0; w8 < 8; ++w8) s += part[(w8 * 3 + mi) * 64 + c];
                    ((float*)(ws + WS_MODS))[((size_t)l * 3 + mi) * NMODS * DM + n0 + c] = s; }
                __syncthreads();
            }
        }
    }
    if (bid == G - 1) {
        float* rope = (float*)(ws + WS_ROPE); float* lb = (float*)(ws + WS_LB);
        for (int i = tid; i < 2048; i += NTHREADS) { const int pos = i >> 4, f = i & 15; const float inv = powf(10000.f, -(float)f / 16.f); const float ang = (float)pos * inv; rope[i] = cosf(ang); rope[2048 + i] = sinf(ang); }
        if (tid < 512) { const float l0 = p.in[13][tid], l1 = p.in[13][512 + tid]; const float mx = fmaxf(l0, l1); const float e0 = expf(l0 - mx), e1 = expf(l1 - mx); lb[tid] = 0.f; lb[512 + tid] = e1 / (e0 + e1); }
    }
    rg_gate_weights_prep(p.in[17], p.in[19], (bf16_t*)(ws + WS_GW), bid, G, tid);
    {
        __syncthreads();
        LAS float* scr = (LAS float*)(lds + wid * 8448);
        constexpr int I_1IN = (DM / 64) * (2 * FH / 32), I_1OUT = (FH / 64) * (DM / 32), I_IN = (DM / 64) * (INW / 32), I_OUT = (DM / 64) * (DM / 32);
        constexpr int I_LAYER = 2 * I_1IN + 2 * I_1OUT + I_IN + I_OUT;
        const int gw = bid * NWAVES + wid, ngw = G * NWAVES;
        for (int it = gw; it < DEPTH * I_LAYER; it += ngw) {
            const int l = it / I_LAYER; int r = it % I_LAYER; unsigned char* wl = ws + WS_W + l * W_L_STRIDE;
            if (r < I_1IN) { pro_transpose_item(p.in[7] + (size_t)l * DM * 2 * FH, DM, 2 * FH, (bf16_t*)(wl + W_1IN), true, scr, r, lane); continue; } r -= I_1IN;
            if (r < I_1IN) { pro_transpose_item(p.in[23] + (size_t)l * DM * 2 * FH, DM, 2 * FH, (bf16_t*)(wl + W_2IN), true, scr, r, lane); continue; } r -= I_1IN;
            if (r < I_1OUT) { pro_transpose_item(p.in[8] + (size_t)l * FH * DM, FH, DM, (bf16_t*)(wl + W_1OUT), false, scr, r, lane); continue; } r -= I_1OUT;
            if (r < I_1OUT) { pro_transpose_item(p.in[24] + (size_t)l * FH * DM, FH, DM, (bf16_t*)(wl + W_2OUT), false, scr, r, lane); continue; } r -= I_1OUT;
            if (r < I_IN) { pro_transpose_item(p.in[10] + (size_t)l * DM * INW, DM, INW, (bf16_t*)(wl + W_IN), false, scr, r, lane); continue; } r -= I_IN;
            pro_transpose_item(p.in[11] + (size_t)l * DM * DM, DM, DM, (bf16_t*)(wl + W_OUT), false, scr, r, lane);
        }
        __syncthreads();
    }
}
__device__ __forceinline__ void run_phase(KParams& p, LAS unsigned char* lds, int ph) {
    unsigned char* ws = p.ws; float* out = p.out;
    float* mods = (float*)(ws + WS_MODS); float* rope = (float*)(ws + WS_ROPE); float* lb = (float*)(ws + WS_LB); float* xctx = (float*)(ws + WS_XCTX);
    bf16_t* XN = (bf16_t*)(ws + WS_XN); bf16_t* Y = XN; bf16_t* H = (bf16_t*)(ws + WS_H); bf16_t* P = H;
    int G = gridDim.x, bid = blockIdx.x, tid = threadIdx.x; asm volatile("" : "+s"(G), "+s"(bid), "+v"(tid));
    if (ph == PH_PRO_A) { ph_prologue_a(p, lds, bid, G, tid); return; }
    if (ph == PH_PRO_B) { ph_normmod(p.in[0], p.in[2], p.in[6], mods, 0, 1, XN, MTOT); return; }
    const int q = ph - PH_LAYER0, l = q / PH_PER_LAYER, s = q % PH_PER_LAYER;
    const bool wctx = l < DEPTH - 1; const int Mmix = wctx ? MTOT : MLAT;
    unsigned char* wl = ws + WS_W + l * W_L_STRIDE; const float* mods_l = mods + (size_t)l * 3 * NMODS * DM;
    const float* src_lat = l == 0 ? p.in[0] : out; const float* src_ctx = l == 0 ? p.in[2] : xctx;
    switch (s) {
    case S_FFN1_IN: case S_FFN2_IN: {
        const int M = s == S_FFN1_IN ? MTOT : Mmix;
        pg8::Gemm g{XN, (const bf16_t*)(wl + (s == S_FFN1_IN ? W_1IN : W_2IN)), M, 2 * FH, DM}; pg8::StaticOrder S; S.init(M, 2 * FH, G, bid);
        pg8::EpiSwiglu E{H, FH};
        pg8::gemm_phase<pg8::EpiSwiglu, pg8::StaticOrder, true, true>(lds, g, S, E);
    } break;
    case S_FFN1_OUT: case S_OUTPROJ: case S_FFN2_OUT: {
        const int M = s == S_FFN1_OUT ? MTOT : Mmix; const int K = s == S_OUTPROJ ? DM : FH;
        const bf16_t* A = s == S_OUTPROJ ? Y : H; const size_t wo = s == S_FFN1_OUT ? W_1OUT : (s == S_OUTPROJ ? W_OUT : W_2OUT);
        const int ig = s == S_FFN1_OUT ? 2 : (s == S_OUTPROJ ? 5 : 8);
        pg8::Gemm g{A, (const bf16_t*)(wl + wo), M, DM, K}; pg8::StaticOrder S; S.init(M, DM, G, bid);
        pg8::EpiResid E{s == S_FFN1_OUT ? src_lat : out, s == S_FFN1_OUT ? src_ctx : xctx, out, xctx, mods_l + ig * DM, s == S_OUTPROJ ? 1.f : 0.5f};
        pg8::gemm_phase<pg8::EpiResid, pg8::StaticOrder, true, true>(lds, g, S, E);
    } break;
    case S_INPROJ: {
        pg8::Gemm g{XN, (const bf16_t*)(wl + W_IN), MTOT, INW, DM}; pg8::StaticOrder S; S.init(MTOT, INW, G, bid);
        pg8::EpiInproj E{P, rope, lb + l * 512};
        pg8::gemm_phase<pg8::EpiInproj, pg8::StaticOrder, true, true>(lds, g, S, E);
    } break;
    case S_NORM_MIX: ph_normmod(out, xctx, p.in[9] + l * DM, mods_l, 3, 4, XN, MTOT); break;
    case S_NORM_FFN2: ph_normmod(out, xctx, p.in[22] + l * DM, mods_l, 6, 7, XN, Mmix); break;
    case S_NEXT_NORM:
        if (l + 1 < DEPTH) ph_normmod(out, xctx, p.in[6] + (l + 1) * DM, mods_l + 3 * NMODS * DM, 0, 1, XN, MTOT);
        else ph_final_norm(out, p.in[25]);
        break;
    case S_MIX1: {
        { const int nat = wctx ? 264 : 256;
          for (int it = bid; it < nat; it += G) { if (it < 256) attn_unit(lds, P, p.in[12] + l * 8, Y, it >> 7, (it >> 1) & 63, it & 1, false); else { const int c = it - 256; attn_unit(lds, P, p.in[12] + l * 8, Y, c >> 2, (c >> 1) & 1, c & 1, true); } } }
        const RgW w{p.in[15] + l * 1024, p.in[16] + l * 256, p.in[18] + l * 512, p.in[20] + l * 512, p.in[21] + l * 512, (const bf16_t*)(ws + WS_GW) + (size_t)l * 65536};
        for (int it = bid; it < 16 * NCHK; it += G) { const int chain = it / NCHK, j = it % NCHK; hgrn_local_item(lds, P, chain >> 3, (chain >> 2) & 1, chain & 3, j, (float*)(ws + WS_T), (float*)(ws + WS_HD)); }
        for (int it = bid; it < 2 * NCHK; it += G) { const int b = it / NCHK, jj = it % NCHK; rg_item<false>(lds, P, w, b, jj < 4, jj < 4 ? jj : jj - 4, (float*)(ws + WS_RS), nullptr, Y); }
    } break;
    case S_MIX2: {
        const int gt = (bid - (G - 2)) * NTHREADS + tid;
        if (bid >= G - 2) rg_carry_scan(gt, (const float*)(ws + WS_RS), (float*)(ws + WS_RE));
        if (bid < 128) hgrn_state_scan(bid >> 3, (bid & 7) * NTHREADS + tid, (float*)(ws + WS_T), (const float*)(ws + WS_HD));
    } break;
    case S_MIX3: {
        const RgW w{p.in[15] + l * 1024, p.in[16] + l * 256, p.in[18] + l * 512, p.in[20] + l * 512, p.in[21] + l * 512, (const bf16_t*)(ws + WS_GW) + (size_t)l * 65536};
        { const int nhi = wctx ? 8 * NCHK : 8 * 128;
          for (int it = bid; it < nhi; it += G) { int bh, isctx, n; if (wctx) { bh = it / NCHK; const int jj = it % NCHK; isctx = jj < 4; n = isctx ? jj : jj - 4; } else { bh = it >> 7; isctx = 0; n = it & 127; }
              hgrn_out_item(lds, P, p.in[14] + l * 256, bh >> 2, bh & 3, isctx, n, (const float*)(ws + WS_T), Y); } }
        const int nit = wctx ? 2 * NCHK : 2 * 128;
        for (int it = bid; it < nit; it += G) { int b, isctx, n; if (wctx) { b = it / NCHK; const int jj = it % NCHK; isctx = jj < 4; n = isctx ? jj : jj - 4; } else { b = it >> 7; isctx = 0; n = it & 127; }
            rg_item<true>(lds, P, w, b, isctx, n, nullptr, (const float*)(ws + WS_RE), Y); }
    } break;
    default: break;
    }
}

__global__ void __launch_bounds__(NTHREADS, 2) mk(Params p) {
    extern __shared__ __attribute__((aligned(16))) unsigned char lds_raw[];
    LAS unsigned char* lds = (LAS unsigned char*)lds_raw;
    cg::grid_group grid = cg::this_grid();
    for (int ph = p.ph_lo; ph < p.ph_hi; ++ph) {
        KParams* kp = (KParams*)__builtin_amdgcn_kernarg_segment_ptr(); asm volatile("" : "+s"(kp));
        run_phase(*kp, lds, ph);
        if (ph + 1 < p.ph_hi) grid.sync();
    }
}
}

extern "C" void kernel_launch(void* const* d_in, const int* in_sizes, int n_in, void* d_out, int out_size, void* d_ws, size_t ws_size, hipStream_t stream) {
    if (n_in != 26 || out_size != MLAT * DM || ws_size < WS_END) { fprintf(stderr, "kernel_launch: unexpected problem (n_in %d out %d ws %zu)\n", n_in, out_size, ws_size); return; }
    static int grid = 0;
    if (grid == 0) {
        int dev = 0, cus = 0, per_cu = 0;
        hipGetDevice(&dev); hipDeviceGetAttribute(&cus, hipDeviceAttributeMultiprocessorCount, dev);
        hipFuncSetAttribute((const void*)mk, hipFuncAttributeMaxDynamicSharedMemorySize, LDS_BYTES);
        hipOccupancyMaxActiveBlocksPerMultiprocessor(&per_cu, (const void*)mk, NTHREADS, LDS_BYTES);
        if (per_cu < 1) { fprintf(stderr, "kernel_launch: occupancy query says %d blocks per CU\n", per_cu); per_cu = 1; }
        grid = cus * (per_cu < 1 ? 1 : 1);
        (void)hipGetLastError();
    }
    unsigned char* ws = (unsigned char*)d_ws;
    Params prm{}; for (int i = 0; i < 26; ++i) prm.in[i] = (const float*)d_in[i]; prm.out = (float*)d_out; prm.ws = ws;
    prm.ph_lo = 0; prm.ph_hi = N_PHASES;
    void* args[] = {&prm};
    const hipError_t le = hipLaunchCooperativeKernel((const void*)mk, dim3(grid), dim3(NTHREADS), args, LDS_BYTES, stream);
    if (le != hipSuccess) fprintf(stderr, "kernel_launch: cooperative launch failed: %s (grid %d)\n", hipGetErrorString(le), grid);
}
```

```cpp
#include <hip/hip_runtime.h>
#include <cstdio>
#include <cstdint>
#include <hip/hip_cooperative_groups.h>
namespace cg = cooperative_groups;

namespace {
constexpr int DM = 1024, BATCH = 2, SEQ = 8192, DEPTH = 2, CTXL = 256, NMODS = 9, FH = 2816;
constexpr int MLAT = BATCH * SEQ, MCTX = BATCH * CTXL, MTOT = MLAT + MCTX;
constexpr int INW = 2560;
constexpr int C_Q = 0, C_K = 512, C_V = 640, C_HQ = 768, C_HF = 1024, C_HB = 1280, C_HI = 1536, C_HG = 1792, C_RX = 2048, C_RG = 2304;
constexpr float EPS = 1e-6f;

typedef unsigned short bf16_t;
typedef short bf16x8 __attribute__((ext_vector_type(8)));
typedef float f32x4 __attribute__((ext_vector_type(4)));
typedef unsigned u32x4 __attribute__((ext_vector_type(4)));
typedef float f32x16 __attribute__((ext_vector_type(16)));
typedef unsigned u32x2 __attribute__((ext_vector_type(2)));

constexpr size_t MiB = 1u << 20;
constexpr size_t WS_CTL = 0;
constexpr size_t WS_MODS = 1 * MiB;
constexpr size_t WS_ROPE = 1 * MiB + 512 * 1024;
constexpr size_t WS_LB = WS_ROPE + 32 * 1024;
constexpr size_t WS_XCTX = 2 * MiB;
constexpr size_t WS_W = 4 * MiB;
constexpr size_t W_L_STRIDE = 40 * MiB;
constexpr size_t W_1IN = 0, W_1OUT = 11 * MiB, W_IN = 16 * MiB + 512 * 1024, W_OUT = 21 * MiB + 512 * 1024, W_2IN = 23 * MiB + 512 * 1024, W_2OUT = 34 * MiB + 512 * 1024;
constexpr size_t WS_XN = 84 * MiB;
constexpr size_t WS_H = 117 * MiB;
constexpr size_t WS_T = 208 * MiB;
constexpr size_t WS_GW = 1 * MiB + 768 * 1024;
constexpr size_t WS_HD = 241 * MiB;
constexpr size_t WS_RS = 242 * MiB;
constexpr size_t WS_RE = 243 * MiB + 512 * 1024;
constexpr size_t WS_END = 245 * MiB;
constexpr int NCHK = 132;

__device__ __forceinline__ float bf2f(bf16_t v) { return __uint_as_float(((unsigned)v) << 16); }
__device__ __forceinline__ bf16_t f2bf(float f) { unsigned u = __float_as_uint(f); return (bf16_t)((u + 0x7fffu + ((u >> 16) & 1u)) >> 16); }
__device__ __forceinline__ float sigmoidf_(float x) { return 1.f / (1.f + __expf(-x)); }
__device__ __forceinline__ float siluf_(float x) { return x / (1.f + __expf(-x)); }
__device__ __forceinline__ float gelu_tanh(float x) { const float u = 0.7978845608028654f * (x + 0.044715f * x * x * x); return 0.5f * x * (1.f + tanhf(u)); }
__device__ __forceinline__ float wave_sum(float v) {
#pragma unroll
    for (int o = 1; o < 64; o <<= 1) v += __shfl_xor(v, o);
    return v;
}

namespace pg8 {
#define PG8_LAS __attribute__((address_space(3)))
typedef unsigned short bf16_t;
typedef short bf16x8 __attribute__((ext_vector_type(8)));
typedef float f32x4 __attribute__((ext_vector_type(4)));
typedef unsigned u32x4 __attribute__((ext_vector_type(4)));
constexpr int BM = 256, BK = 64, HALF = 128, HTB = HALF * BK * 2  , STAGE_BYTES = 8 * HTB, NXCD = 8, WGM = 8;

__host__ __device__ __forceinline__ int lds_byte(int r, int c) { const int st = (r >> 4) * 2 + (c >> 5), rr = r & 15, cc = c & 31, ob = rr * 64 + cc * 2; return st * 1024 + (ob ^ (((ob >> 9) & 1) << 5)); }
__host__ __device__ __forceinline__ void stage_rc(int b, int& R, int& C) { const int st = b / 1024, sb = b % 1024, swz = sb ^ (((sb >> 9) & 1) << 5); R = (st >> 1) * 16 + swz / 64; C = (st & 1) * 32 + (swz % 64) / 2; }
__host__ __device__ __forceinline__ int perm32(int rho) { const int n = rho >> 4, i = rho & 15; return 8 * (i >> 2) + 4 * n + (i & 3); }

struct Unit { int pm, pn; };
struct Gemm { const bf16_t* A; const bf16_t* Bt; int M, N, K; };

struct StaticOrder {
    int nM, nN, nwg, G, c;
    __host__ __device__ void init(int M, int N, int G_, int c_) { nM = M / BM; nN = N / BM; nwg = nM * nN; G = G_; c = c_; }
    __host__ __device__ bool next(int i, Unit& u) const {
        const long L = (long)i * G + c; if (L >= nwg) return false;
        int wgid = (int)L; { const int q = nwg / NXCD, r = nwg % NXCD, xcd = wgid % NXCD, off = wgid / NXCD; wgid = (xcd < r ? xcd * (q + 1) : r * (q + 1) + (xcd - r) * q) + off; }
        const int nig = WGM * nN, gid = wgid / nig, fm = gid * WGM, gsz = (nM - fm) < WGM ? (nM - fm) : WGM;
        u.pm = fm + ((wgid % nig) % gsz); u.pn = (wgid % nig) / gsz; return true;
    }
    __device__ __forceinline__ void a_ready(const Unit&) const {}
    __device__ __forceinline__ void done(const Unit&) const {}
};

template <class Epi, class Sched, bool ALIGN_EPI = false, bool SP2 = false>
__device__ __forceinline__ void gemm_phase(PG8_LAS unsigned char* lds, const Gemm g, const Sched& S, const Epi& E) {
    int tid_ = threadIdx.x; asm volatile("" : "+v"(tid_));
    const int tid = tid_, wid = __builtin_amdgcn_readfirstlane(tid >> 6), lane = tid & 63, wr = wid >> 2, wc = wid & 3, fr = lane & 15, fq = lane >> 4;
    const int K = g.K, nt = K / BK;
    unsigned voffA[2], voffB[2];
#pragma unroll
    for (int i = 0; i < 2; ++i) { int R, C; stage_rc(tid * 16 + i * 8192, R, C); const int Rb = Epi::PERM ? ((R & ~31) + perm32(R & 31)) : R;
        voffA[i] = (unsigned)(R * K + C) * 2u; voffB[i] = (unsigned)(Rb * K + C) * 2u; }
    const size_t kstep = (size_t)(BK * 2);
    const size_t hstep = (size_t)HALF * K * 2;
    const size_t tstep = 2 * hstep;
    const unsigned ldsw = (unsigned)wid * 1024u;
    const int aoff = lds_byte(wr * 64 + fr, fq * 8), boff = lds_byte(wc * 32 + fr, fq * 8);
#define PG8_SA(b, h) (((b) * 2 + (h)) * HTB)
#define PG8_SB(b, h) ((4 + (b) * 2 + (h)) * HTB)
#define PG8_STAGE(bufoff, gbase, voff) do { _Pragma("unroll") for (int _i = 0; _i < 2; ++_i) \
        __builtin_amdgcn_global_load_lds((const unsigned*)((const char*)(gbase) + (voff)[_i]), (PG8_LAS unsigned*)(lds + (bufoff) + ldsw + _i * 8192), 16, 0, 0); } while (0)
#define PG8_LDA(dst, b, h) do { _Pragma("unroll") for (int m = 0; m < 4; ++m) _Pragma("unroll") for (int k = 0; k < 2; ++k) dst[m][k] = *(const PG8_LAS bf16x8*)(lds + PG8_SA(b, h) + aoff + m * 2048 + k * 1024); } while (0)
#define PG8_LDB(dst, b, h) do { _Pragma("unroll") for (int n = 0; n < 2; ++n) _Pragma("unroll") for (int k = 0; k < 2; ++k) dst[n][k] = *(const PG8_LAS bf16x8*)(lds + PG8_SB(b, h) + boff + n * 2048 + k * 1024); } while (0)
#define PG8_MMA(ai, bj, At, Bt) do { __builtin_amdgcn_s_setprio(1); _Pragma("unroll") for (int m = 0; m < 4; ++m) _Pragma("unroll") for (int n = 0; n < 2; ++n) _Pragma("unroll") for (int k = 0; k < 2; ++k) \
        acc[ai][bj][m][n] = __builtin_amdgcn_mfma_f32_16x16x32_bf16(Bt[n][k], At[m][k], acc[ai][bj][m][n], 0, 0, 0); __builtin_amdgcn_s_setprio(0); } while (0)
#define PG8_WAIT_V(n) asm volatile("s_waitcnt vmcnt(" #n ")" ::: "memory")
#define PG8_WAIT_L(n) asm volatile("s_waitcnt lgkmcnt(" #n ")" ::: "memory")
#define PG8_BAR __builtin_amdgcn_s_barrier()
#define PG8_SCHED __builtin_amdgcn_sched_barrier(0)
    Unit cur, nxt; int ui = 0;
    if (!S.next(0, cur)) return;
    f32x4 acc[2][2][4][2];
#pragma unroll
    for (int a = 0; a < 2; ++a)
#pragma unroll
        for (int b = 0; b < 2; ++b)
#pragma unroll
            for (int m = 0; m < 4; ++m)
#pragma unroll
                for (int n = 0; n < 2; ++n) acc[a][b][m][n] = (f32x4){0.f, 0.f, 0.f, 0.f};
    bf16x8 At[4][2], B0[2][2], B1[2][2];
    const char* cA = (const char*)g.A + (size_t)cur.pm * tstep; const char* cB = (const char*)g.Bt + (size_t)cur.pn * tstep;
    S.a_ready(cur);
    if constexpr (SP2) {
        PG8_STAGE(PG8_SB(0, 0), cB, voffB); PG8_STAGE(PG8_SB(0, 1), cB + hstep, voffB); PG8_STAGE(PG8_SA(0, 0), cA, voffA); PG8_STAGE(PG8_SA(0, 1), cA + hstep, voffA);
        if (wr == 1) PG8_BAR;
        PG8_WAIT_V(2); PG8_BAR;
        PG8_STAGE(PG8_SB(1, 0), cB + kstep, voffB); PG8_STAGE(PG8_SA(1, 0), cA + kstep, voffA); PG8_STAGE(PG8_SB(1, 1), cB + hstep + kstep, voffB);
        PG8_WAIT_V(6); PG8_BAR;
    } else {
        PG8_STAGE(PG8_SB(0, 0), cB, voffB); PG8_STAGE(PG8_SA(0, 0), cA, voffA); PG8_STAGE(PG8_SB(0, 1), cB + hstep, voffB); PG8_STAGE(PG8_SA(0, 1), cA + hstep, voffA);
        if (wr == 1) PG8_BAR;
        PG8_WAIT_V(4); PG8_BAR;
        PG8_STAGE(PG8_SB(1, 0), cB + kstep, voffB); PG8_STAGE(PG8_SA(1, 0), cA + kstep, voffA); PG8_STAGE(PG8_SB(1, 1), cB + hstep + kstep, voffB);
        PG8_WAIT_V(6); PG8_BAR;
    }
    for (;;) {
        const bool has_next = S.next(ui + 1, nxt);
        const char* nA = has_next ? (const char*)g.A + (size_t)nxt.pm * tstep : cA; const char* nB = has_next ? (const char*)g.Bt + (size_t)nxt.pn * tstep : cB;
        for (int t = 0; t < nt; t += 2) {
            const bool last = (t == nt - 2);
            const char* a1 = cA + (size_t)(t + 1) * kstep;
            const char* a2 = last ? nA : cA + (size_t)(t + 2) * kstep; const char* b2 = last ? nB : cB + (size_t)(t + 2) * kstep;
            const char* a3 = a2 + kstep; const char* b3 = b2 + kstep;
            if (last && has_next) S.a_ready(nxt);
            if constexpr (SP2) {
            PG8_LDB(B0, 0, 0); PG8_LDB(B1, 0, 1); PG8_SCHED; PG8_LDA(At, 0, 0); PG8_STAGE(PG8_SA(1, 1), a1 + hstep, voffA);
            PG8_WAIT_V(8); PG8_WAIT_L(0); PG8_BAR; PG8_MMA(0, 0, At, B0); PG8_MMA(0, 1, At, B1); PG8_BAR; PG8_SCHED;
            PG8_LDA(At, 0, 1); PG8_STAGE(PG8_SB(0, 0), b2, voffB); PG8_STAGE(PG8_SB(0, 1), b2 + hstep, voffB); PG8_STAGE(PG8_SA(0, 0), a2, voffA);
            PG8_WAIT_V(8); PG8_WAIT_L(0); PG8_BAR; PG8_MMA(1, 0, At, B0); PG8_MMA(1, 1, At, B1); PG8_BAR; PG8_SCHED;
            PG8_LDB(B0, 1, 0); PG8_LDB(B1, 1, 1); PG8_SCHED; PG8_LDA(At, 1, 0); PG8_STAGE(PG8_SA(0, 1), a2 + hstep, voffA);
            PG8_WAIT_V(8); PG8_WAIT_L(0); PG8_BAR; PG8_MMA(0, 0, At, B0); PG8_MMA(0, 1, At, B1); PG8_BAR; PG8_SCHED;
            PG8_LDA(At, 1, 1); PG8_STAGE(PG8_SB(1, 0), b3, voffB); PG8_STAGE(PG8_SB(1, 1), b3 + hstep, voffB); PG8_STAGE(PG8_SA(1, 0), a3, voffA);
            PG8_WAIT_V(8); PG8_WAIT_L(0); PG8_BAR; PG8_MMA(1, 0, At, B0); PG8_MMA(1, 1, At, B1); PG8_BAR; PG8_SCHED;
            } else {
            PG8_LDB(B0, 0, 0); PG8_SCHED; PG8_LDA(At, 0, 0); PG8_STAGE(PG8_SA(1, 1), a1 + hstep, voffA);
            PG8_WAIT_L(8); PG8_BAR; PG8_WAIT_L(0); PG8_MMA(0, 0, At, B0); PG8_BAR; PG8_SCHED;
            PG8_LDB(B1, 0, 1); PG8_STAGE(PG8_SB(0, 0), b2, voffB);
            PG8_BAR; PG8_WAIT_L(0); PG8_MMA(0, 1, At, B1); PG8_BAR;
            PG8_LDA(At, 0, 1); PG8_STAGE(PG8_SA(0, 0), a2, voffA);
            PG8_BAR; PG8_WAIT_L(0); PG8_MMA(1, 0, At, B0); PG8_BAR; PG8_SCHED;
            PG8_STAGE(PG8_SB(0, 1), b2 + hstep, voffB);
            PG8_WAIT_V(6); PG8_BAR; PG8_MMA(1, 1, At, B1); PG8_BAR;
            PG8_LDB(B0, 1, 0); PG8_SCHED; PG8_LDA(At, 1, 0); PG8_STAGE(PG8_SA(0, 1), a2 + hstep, voffA);
            PG8_WAIT_L(8); PG8_BAR; PG8_WAIT_L(0); PG8_MMA(0, 0, At, B0); PG8_BAR; PG8_SCHED;
            PG8_LDB(B1, 1, 1); PG8_STAGE(PG8_SB(1, 0), b3, voffB);
            PG8_BAR; PG8_WAIT_L(0); PG8_MMA(0, 1, At, B1); PG8_BAR;
            PG8_LDA(At, 1, 1); PG8_STAGE(PG8_SA(1, 0), a3, voffA);
            PG8_BAR; PG8_WAIT_L(0); PG8_MMA(1, 0, At, B0); PG8_BAR; PG8_SCHED;
            PG8_STAGE(PG8_SB(1, 1), b3 + hstep, voffB);
            PG8_WAIT_V(6); PG8_BAR; PG8_MMA(1, 1, At, B1); PG8_BAR;
            }
        }
        if constexpr (ALIGN_EPI) { if (wr == 0) PG8_BAR; }
        if constexpr (!Epi::AFTER_DRAIN) { E(acc, cur, wr, wc, fr, fq); S.done(cur); }
        if (!has_next) break;
#pragma unroll
        for (int a = 0; a < 2; ++a)
#pragma unroll
            for (int b = 0; b < 2; ++b)
#pragma unroll
                for (int m = 0; m < 4; ++m)
#pragma unroll
                    for (int n = 0; n < 2; ++n) acc[a][b][m][n] = (f32x4){0.f, 0.f, 0.f, 0.f};
        cur = nxt; cA = nA; cB = nB; ++ui;
        if constexpr (ALIGN_EPI) { if (wr == 1) PG8_BAR; }
    }
    PG8_WAIT_V(0);
    if constexpr (!ALIGN_EPI) { if (wr == 0) PG8_BAR; }
    PG8_BAR;
    if constexpr (Epi::AFTER_DRAIN) { E.fused(acc, cur, wr, wc, fr, fq, lds, wid, lane); S.done(cur); }
#undef PG8_SA
#undef PG8_SB
#undef PG8_STAGE
#undef PG8_LDA
#undef PG8_LDB
#undef PG8_MMA
#undef PG8_WAIT_V
#undef PG8_WAIT_L
#undef PG8_BAR
#undef PG8_SCHED
}
}


namespace pg8 {
__device__ __forceinline__ unsigned cvt_pk_bf16(float lo, float hi) { unsigned r; asm volatile("v_cvt_pk_bf16_f32 %0, %1, %2" : "=v"(r) : "v"(lo), "v"(hi)); return r; }
__device__ __forceinline__ float fast_sigmoid(float x) { return __builtin_amdgcn_rcpf(1.f + __expf(-x)); }
__device__ __forceinline__ float fast_silu(float x) { return x * __builtin_amdgcn_rcpf(1.f + __expf(-x)); }
__device__ __forceinline__ float fast_gelu_tanh(float x) { const float u = 0.7978845608028654f * (x + 0.044715f * x * x * x); const float e = __expf(2.f * u); const float th = 1.f - 2.f * __builtin_amdgcn_rcpf(e + 1.f); return 0.5f * x * (1.f + th); }

struct EpiSwiglu {
    static constexpr bool PERM = true, AFTER_DRAIN = false;
    bf16_t* H; int ldh;
    __device__ __forceinline__ void operator()(const f32x4 (&acc)[2][2][4][2], const Unit& u, int wr, int wc, int fr, int fq) const {
        const int row0 = u.pm * BM + wr * 64 + fr, hc0 = u.pn * HALF + wc * 32 + 8 * fq;
#pragma unroll
        for (int ai = 0; ai < 2; ++ai)
#pragma unroll
            for (int m = 0; m < 4; ++m) {
                bf16_t* rowp = H + (size_t)(row0 + ai * HALF + m * 16) * ldh + hc0;
                const f32x4 a0 = acc[ai][0][m][0], a1 = acc[ai][0][m][1], b0 = acc[ai][1][m][0], b1 = acc[ai][1][m][1];
                float h[8];
#pragma unroll
                for (int j = 0; j < 4; ++j) { h[j] = fast_silu(a0[j]) * b0[j]; h[4 + j] = fast_silu(a1[j]) * b1[j]; }
                u32x4 w; w.x = cvt_pk_bf16(h[0], h[1]); w.y = cvt_pk_bf16(h[2], h[3]); w.z = cvt_pk_bf16(h[4], h[5]); w.w = cvt_pk_bf16(h[6], h[7]);
                *(u32x4*)rowp = w;
            }
    }
};
struct EpiResid {
    static constexpr bool PERM = false, AFTER_DRAIN = false;
    const float* src_lat; const float* src_ctx; float* dst_lat; float* dst_ctx; const float* gate_l; float gsc;
    __device__ __forceinline__ void operator()(const f32x4 (&acc)[2][2][4][2], const Unit& u, int wr, int wc, int fr, int fq) const {
        const bool lat = u.pm < 64; const int mi = lat ? (u.pm >> 5) : 2;
        const int rowl = (lat ? u.pm : u.pm - 64) * BM + wr * 64 + fr, col0 = u.pn * BM + wc * 32 + 4 * fq;
        const float* src = (lat ? src_lat : src_ctx) + (size_t)rowl * 1024 + col0; float* dst = (lat ? dst_lat : dst_ctx) + (size_t)rowl * 1024 + col0;
        const float* gp = gate_l + (size_t)mi * 9216 + col0;
#pragma unroll
        for (int bj = 0; bj < 2; ++bj)
#pragma unroll
            for (int n = 0; n < 2; ++n) { const f32x4 g = *(const f32x4*)(gp + bj * HALF + n * 16) * gsc;
#pragma unroll
                for (int ai = 0; ai < 2; ++ai) {
#pragma unroll
                    for (int m = 0; m < 4; ++m) { const size_t ro = (size_t)(ai * HALF + m * 16) * 1024 + bj * HALF + n * 16;
                        const f32x4 b = *(const f32x4*)(src + ro); *(f32x4*)(dst + ro) = b + g * acc[ai][bj][m][n]; }
                    asm volatile("" ::: "memory"); } }
    }
};
struct EpiInproj {
    static constexpr bool PERM = false, AFTER_DRAIN = false;
    bf16_t* P; const float* rope; const float* lb_l;
    __device__ __forceinline__ void operator()(const f32x4 (&acc)[2][2][4][2], const Unit& u, int wr, int wc, int fr, int fq) const {
        const bool lat = u.pm < 64;
        const int row0 = u.pm * BM + wr * 64 + fr, cw = wc * 32 + 4 * fq;
#pragma unroll
        for (int bj = 0; bj < 2; ++bj) {
            const int seg = u.pn * 2 + bj, colb = seg * HALF + cw;
            f32x4 lbv[2] = {(f32x4){0.f, 0.f, 0.f, 0.f}, (f32x4){0.f, 0.f, 0.f, 0.f}};
            if (seg >= 8 && seg < 12) { const int o = (seg - 8) * HALF + cw; lbv[0] = *(const f32x4*)(lb_l + o); lbv[1] = *(const f32x4*)(lb_l + o + 16); }
#pragma unroll
            for (int ai = 0; ai < 2; ++ai)
#pragma unroll
                for (int m = 0; m < 4; ++m) {
                    const int row = row0 + ai * HALF + m * 16;
                    f32x4 v0 = acc[ai][bj][m][0], v1 = acc[ai][bj][m][1];
                    if (seg < 5) {
                        if (lat) { const int t = row & (SEQ - 1); const int pos = (wc & 1) ? (t & 63) : (t >> 6);
                            const f32x4 cs = *(const f32x4*)(rope + pos * 16 + 4 * fq), sn = *(const f32x4*)(rope + 2048 + pos * 16 + 4 * fq);
                            const f32x4 o0 = v0 * cs - v1 * sn, o1 = v1 * cs + v0 * sn; v0 = o0; v1 = o1; }
                        if (seg < 4) { v0 = v0 * 0.125f; v1 = v1 * 0.125f; }
                    } else if (seg == 6 || seg == 7 || seg == 14 || seg == 15) {
#pragma unroll
                        for (int j = 0; j < 4; ++j) { v0[j] = fast_silu(v0[j]); v1[j] = fast_silu(v1[j]); }
                    } else if (seg >= 8 && seg < 12) {
#pragma unroll
                        for (int j = 0; j < 4; ++j) { v0[j] = __logf(lbv[0][j] + (1.f - lbv[0][j]) * fast_sigmoid(v0[j])); v1[j] = __logf(lbv[1][j] + (1.f - lbv[1][j]) * fast_sigmoid(v1[j])); }
                    } else if (seg >= 18) {
#pragma unroll
                        for (int j = 0; j < 4; ++j) { v0[j] = fast_gelu_tanh(v0[j]); v1[j] = fast_gelu_tanh(v1[j]); }
                    }
                    bf16_t* pp = P + (size_t)row * 2560 + colb;
                    *(uint2*)pp = make_uint2(cvt_pk_bf16(v0[0], v0[1]), cvt_pk_bf16(v0[2], v0[3]));
                    *(uint2*)(pp + 16) = make_uint2(cvt_pk_bf16(v1[0], v1[1]), cvt_pk_bf16(v1[2], v1[3]));
                    asm volatile("" ::: "memory");
                }
        }
    }
};
}
#define LAS __attribute__((address_space(3)))
constexpr int NWAVES = 8, NTHREADS = 512;
constexpr int LDS_BYTES = 147456;
constexpr int LDS_XB = LDS_BYTES - 64;
constexpr size_t CTL_ZERO_BYTES = 64 * 1024;
struct Params { const float* in[26]; float* out; unsigned char* ws; int ph_lo, ph_hi; };
typedef const __attribute__((address_space(4))) Params KParams;
constexpr int PH_PRO_A = 0, PH_PRO_B = 1, PH_LAYER0 = 2, PH_PER_LAYER = 12, N_PHASES = PH_LAYER0 + DEPTH * PH_PER_LAYER;
enum { S_FFN1_IN = 0, S_FFN1_OUT = 1, S_NORM_MIX = 2, S_INPROJ = 3, S_MIX1 = 4, S_MIX2 = 5, S_MIX3 = 6, S_OUTPROJ = 7, S_NORM_FFN2 = 8, S_FFN2_IN = 9, S_FFN2_OUT = 10, S_NEXT_NORM = 11 };


constexpr int AT_KS = 72;
constexpr int AT_LDS_K = 0, AT_LDS_V = 64 * AT_KS * 2;
constexpr float LOG2E = 1.4426950408889634f;
__device__ __forceinline__ void attn_unit(LAS unsigned char* lds, const bf16_t* P, const float* sink_l, bf16_t* Y, int b, int qblk, int kvh, bool ctxq) {
    int tid_ = threadIdx.x; asm volatile("" : "+v"(tid_));
    const int tid = tid_, lane = tid & 63, wid = __builtin_amdgcn_readfirstlane(tid >> 6), g = wid & 3, th = wid >> 2, h = kvh * 4 + g, l31 = lane & 31, hi = lane >> 5;
    LAS bf16_t* Ks = (LAS bf16_t*)(lds + AT_LDS_K); LAS bf16_t* Vt = (LAS bf16_t*)(lds + AT_LDS_V);
    const int q0w = qblk * 128 + th * 64;
    const size_t rq0 = (ctxq ? (size_t)MLAT + b * CTXL : (size_t)b * SEQ) + q0w;
    bf16x8 Qf[2][4];
#pragma unroll
    for (int qb = 0; qb < 2; ++qb)
#pragma unroll
        for (int s = 0; s < 4; ++s) Qf[qb][s] = *(const bf16x8*)(P + (rq0 + qb * 32 + l31) * INW + C_Q + h * 64 + s * 16 + hi * 8);
    f32x16 O[2][2];
#pragma unroll
    for (int i = 0; i < 2; ++i)
#pragma unroll
        for (int j = 0; j < 2; ++j)
#pragma unroll
            for (int r = 0; r < 16; ++r) O[i][j][r] = 0.f;
    const float sk = sink_l[h] * LOG2E;
    float m[2] = {sk, sk}, ls[2] = {hi == 0 ? 1.f : 0.f, hi == 0 ? 1.f : 0.f};
    const int jbeg = ctxq ? 6 : 0;
    const int lr = tid >> 3, lc = (tid & 7) * 8;
    u32x4 kreg, vreg; int jn = jbeg;
    auto tile_row0 = [&](int j) -> long { if (j >= 6) return (long)MLAT + b * CTXL + (j - 6) * 64; const int kp0 = qblk * 128 - 128 + 64 * j; return (kp0 < 0 || kp0 >= SEQ) ? -1L : (long)b * SEQ + kp0; };
    while (jn < 10 && tile_row0(jn) < 0) ++jn;
    { const long r0 = tile_row0(jn); kreg = *(const u32x4*)(P + (size_t)(r0 + lr) * INW + C_K + kvh * 64 + lc); vreg = *(const u32x4*)(P + (size_t)(r0 + lr) * INW + C_V + kvh * 64 + lc); }
    while (jn < 10) {
        const int j = jn;
        __syncthreads();
        *(LAS u32x4*)(Ks + lr * AT_KS + lc) = kreg;
        { const unsigned vv[4] = {vreg.x, vreg.y, vreg.z, vreg.w};
#pragma unroll
          for (int i = 0; i < 4; ++i) { Vt[(lc + 2 * i) * AT_KS + lr] = (bf16_t)(vv[i] & 0xffffu); Vt[(lc + 2 * i + 1) * AT_KS + lr] = (bf16_t)(vv[i] >> 16); } }
        __syncthreads();
        ++jn; while (jn < 10 && tile_row0(jn) < 0) ++jn;
        if (jn < 10) { const long r0 = tile_row0(jn); kreg = *(const u32x4*)(P + (size_t)(r0 + lr) * INW + C_K + kvh * 64 + lc); vreg = *(const u32x4*)(P + (size_t)(r0 + lr) * INW + C_V + kvh * 64 + lc); }
        const bool local = j < 6; const int kp0 = qblk * 128 - 128 + 64 * j;
        if (local && (kp0 + 63 < q0w - 128 || kp0 > q0w + 63 + 128)) continue;
        f32x16 St[2][2];
#pragma unroll
        for (int kb = 0; kb < 2; ++kb) {
            bf16x8 Kf[4];
#pragma unroll
            for (int s = 0; s < 4; ++s) Kf[s] = *(const LAS bf16x8*)(Ks + (kb * 32 + l31) * AT_KS + s * 16 + hi * 8);
#pragma unroll
            for (int qb = 0; qb < 2; ++qb) {
                f32x16 a;
#pragma unroll
                for (int r = 0; r < 16; ++r) a[r] = 0.f;
#pragma unroll
                for (int s = 0; s < 4; ++s) a = __builtin_amdgcn_mfma_f32_32x32x16_bf16(Kf[s], Qf[qb][s], a, 0, 0, 0);
                St[kb][qb] = a;
            }
        }
        const bool partial = local && (kp0 < q0w + 63 - 128 || kp0 + 63 > q0w + 128);
#pragma unroll
        for (int qb = 0; qb < 2; ++qb) {
            const int qp = q0w + qb * 32 + l31;
            float tmax = -1e30f;
#pragma unroll
            for (int kb = 0; kb < 2; ++kb)
#pragma unroll
                for (int r = 0; r < 16; ++r) {
                    float s = St[kb][qb][r] * LOG2E;
                    if (partial) { const int kp = kp0 + kb * 32 + (r & 3) + 8 * (r >> 2) + 4 * hi; const int dlt = kp - qp; if (dlt > 128 || dlt < -128) s = -1e30f; }
                    St[kb][qb][r] = s; tmax = fmaxf(tmax, s);
                }
            tmax = fmaxf(tmax, __shfl_xor(tmax, 32));
            const float mn = fmaxf(m[qb], tmax), alpha = __builtin_amdgcn_exp2f(m[qb] - mn);
            m[qb] = mn;
            float psum = 0.f;
#pragma unroll
            for (int kb = 0; kb < 2; ++kb)
#pragma unroll
                for (int r = 0; r < 16; ++r) { const float pv = __builtin_amdgcn_exp2f(St[kb][qb][r] - mn); St[kb][qb][r] = pv; psum += pv; }
            ls[qb] = ls[qb] * alpha + psum;
#pragma unroll
            for (int db = 0; db < 2; ++db)
#pragma unroll
                for (int r = 0; r < 16; ++r) O[db][qb][r] *= alpha;
        }
#pragma unroll
        for (int kb = 0; kb < 2; ++kb)
#pragma unroll
            for (int s2 = 0; s2 < 2; ++s2) {
                bf16x8 Pf[2];
#pragma unroll
                for (int qb = 0; qb < 2; ++qb) { u32x4 w; w.x = pg8::cvt_pk_bf16(St[kb][qb][8 * s2 + 0], St[kb][qb][8 * s2 + 1]); w.y = pg8::cvt_pk_bf16(St[kb][qb][8 * s2 + 2], St[kb][qb][8 * s2 + 3]);
                    w.z = pg8::cvt_pk_bf16(St[kb][qb][8 * s2 + 4], St[kb][qb][8 * s2 + 5]); w.w = pg8::cvt_pk_bf16(St[kb][qb][8 * s2 + 6], St[kb][qb][8 * s2 + 7]); Pf[qb] = __builtin_bit_cast(bf16x8, w); }
#pragma unroll
                for (int db = 0; db < 2; ++db) {
                    const LAS bf16_t* vp = Vt + (db * 32 + l31) * AT_KS + kb * 32 + s2 * 16 + 4 * hi;
                    const u32x2 v0 = *(const LAS u32x2*)vp, v1 = *(const LAS u32x2*)(vp + 8);
                    u32x4 vw; vw.x = v0.x; vw.y = v0.y; vw.z = v1.x; vw.w = v1.y; const bf16x8 Vf = __builtin_bit_cast(bf16x8, vw);
#pragma unroll
                    for (int qb = 0; qb < 2; ++qb) O[db][qb] = __builtin_amdgcn_mfma_f32_32x32x16_bf16(Vf, Pf[qb], O[db][qb], 0, 0, 0);
                }
            }
    }
#pragma unroll
    for (int qb = 0; qb < 2; ++qb) {
        const float lt = ls[qb] + __shfl_xor(ls[qb], 32); const float il = 1.f / lt;
        bf16_t* yr = Y + (rq0 + qb * 32 + l31) * DM + h * 64;
#pragma unroll
        for (int db = 0; db < 2; ++db)
#pragma unroll
            for (int i = 0; i < 4; ++i) *(uint2*)(yr + db * 32 + 8 * i + 4 * hi) = make_uint2(pg8::cvt_pk_bf16(O[db][qb][4 * i] * il, O[db][qb][4 * i + 1] * il), pg8::cvt_pk_bf16(O[db][qb][4 * i + 2] * il, O[db][qb][4 * i + 3] * il));
    }
    __syncthreads();
}
__device__ __forceinline__ void chunk_rows(int dir, int b, int j, int& row0, int& t0, int& len, int& seqbase) {
    if (j < 4) { const int n = dir ? 3 - j : j; t0 = 64 * n; len = CTXL; seqbase = MLAT + b * CTXL; }
    else { const int n = dir ? 127 - (j - 4) : j - 4; t0 = 64 * n; len = SEQ; seqbase = b * SEQ; }
    row0 = seqbase + t0;
}
struct RgW { const float* conv_w; const float* conv_b; const float* ga_b; const float* gx_b; const float* lam; const bf16_t* gw; };
constexpr int RG_US = 264;
constexpr int RG_LDS_US = 0, RG_LDS_HS = 64 * RG_US * 2;
template <bool FINAL> __device__ __forceinline__ void rg_item(LAS unsigned char* lds, const bf16_t* P, const RgW w, int b, int isctx, int n, float* RS, const float* RE, bf16_t* Y) {
    int tid_ = threadIdx.x; asm volatile("" : "+v"(tid_));
    const int tid = tid_, lane = tid & 63, wid = __builtin_amdgcn_readfirstlane(tid >> 6);
    LAS bf16_t* Us = (LAS bf16_t*)(lds + RG_LDS_US); LAS float* Hs = (LAS float*)(lds + RG_LDS_HS);
    const int t0 = 64 * n, len = isctx ? CTXL : SEQ, seqbase = isctx ? MLAT + b * CTXL : b * SEQ;
    {
        const int t = tid >> 3, cg = tid & 7, tt = t0 + t;
#pragma unroll
        for (int s8 = 0; s8 < 4; ++s8) {
            const int c0 = cg * 32 + s8 * 8;
            float u[8];
            { const f32x4 b0 = *(const f32x4*)(w.conv_b + c0), b1 = *(const f32x4*)(w.conv_b + c0 + 4); u[0] = b0[0]; u[1] = b0[1]; u[2] = b0[2]; u[3] = b0[3]; u[4] = b1[0]; u[5] = b1[1]; u[6] = b1[2]; u[7] = b1[3]; }
#pragma unroll
            for (int j = 0; j < 4; ++j) { const int ts = tt + j - 2;
                if (ts >= 0 && ts < len) {
                    const u32x4 xr = *(const u32x4*)(P + (size_t)(seqbase + ts) * INW + C_RX + c0);
                    const f32x4 w0 = *(const f32x4*)(w.conv_w + j * 256 + c0), w1 = *(const f32x4*)(w.conv_w + j * 256 + c0 + 4);
                    u[0] += w0[0] * __uint_as_float(xr.x << 16); u[1] += w0[1] * __uint_as_float(xr.x & 0xffff0000u);
                    u[2] += w0[2] * __uint_as_float(xr.y << 16); u[3] += w0[3] * __uint_as_float(xr.y & 0xffff0000u);
                    u[4] += w1[0] * __uint_as_float(xr.z << 16); u[5] += w1[1] * __uint_as_float(xr.z & 0xffff0000u);
                    u[6] += w1[2] * __uint_as_float(xr.w << 16); u[7] += w1[3] * __uint_as_float(xr.w & 0xffff0000u);
                } }
            u32x4 o; o.x = pg8::cvt_pk_bf16(u[0], u[1]); o.y = pg8::cvt_pk_bf16(u[2], u[3]); o.z = pg8::cvt_pk_bf16(u[4], u[5]); o.w = pg8::cvt_pk_bf16(u[6], u[7]);
            *(LAS u32x4*)(Us + t * RG_US + c0) = o;
        }
        if (FINAL) { for (int i = tid; i < 64 * 256 / 4; i += NTHREADS) ((LAS f32x4*)Hs)[i] = (f32x4){0.f, 0.f, 0.f, 0.f}; }
    }
    __syncthreads();
    {
        const int n4 = wid & 3, dir = wid >> 2, e = lane & 15, q4 = lane >> 4;
        const int j = isctx ? (dir ? 3 - n : n) : 4 + (dir ? 127 - n : n);
        bf16x8 Bf[2][4][2];
#pragma unroll
        for (int gt = 0; gt < 2; ++gt)
#pragma unroll
            for (int nb = 0; nb < 4; ++nb)
#pragma unroll
                for (int ks = 0; ks < 2; ++ks) Bf[gt][nb][ks] = *(const bf16x8*)(w.gw + ((size_t)((dir * 2 + gt) * 4 + n4) * 64 + nb * 16 + e) * 64 + ks * 32 + q4 * 8);
        float ba[4], bx[4], sp[4], carry[4], carryA[4];
#pragma unroll
        for (int nb = 0; nb < 4; ++nb) { const int c = n4 * 64 + nb * 16 + e; ba[nb] = w.ga_b[dir * 256 + c]; bx[nb] = w.gx_b[dir * 256 + c]; sp[nb] = log1pf(__expf(-w.lam[dir * 256 + c]));
            carry[nb] = FINAL ? RE[((size_t)(dir * 2 + b) * NCHK + j) * 256 + c] : 0.f; carryA[nb] = 1.f; }
#pragma unroll
        for (int mi = 0; mi < 4; ++mi) {
            const int mb = dir ? 3 - mi : mi;
            bf16x8 Af[2];
#pragma unroll
            for (int ks = 0; ks < 2; ++ks) Af[ks] = *(const LAS bf16x8*)(Us + (mb * 16 + e) * RG_US + n4 * 64 + ks * 32 + q4 * 8);
            float av[4][4], uv[4][4], hv[4][4];
#pragma unroll
            for (int nb = 0; nb < 4; ++nb) {
                f32x4 ar = (f32x4){0.f, 0.f, 0.f, 0.f}, ai = (f32x4){0.f, 0.f, 0.f, 0.f};
#pragma unroll
                for (int ks = 0; ks < 2; ++ks) { ar = __builtin_amdgcn_mfma_f32_16x16x32_bf16(Af[ks], Bf[0][nb][ks], ar, 0, 0, 0); ai = __builtin_amdgcn_mfma_f32_16x16x32_bf16(Af[ks], Bf[1][nb][ks], ai, 0, 0, 0); }
#pragma unroll
                for (int r = 0; r < 4; ++r) {
                    const float uval = bf2f(Us[(mb * 16 + q4 * 4 + r) * RG_US + n4 * 64 + nb * 16 + e]);
                    const float rr = pg8::fast_sigmoid(ar[r] + ba[nb]), ii = pg8::fast_sigmoid(ai[r] + bx[nb]);
                    const float la = -8.f * rr * sp[nb]; const float a = __expf(la);
                    av[nb][r] = a; uv[nb][r] = sqrtf(fmaxf(1.f - a * a, 0.f)) * (ii * uval); hv[nb][r] = 0.f;
                }
            }
#pragma unroll
            for (int qi = 0; qi < 4; ++qi) {
                const int qs = dir ? 3 - qi : qi;
#pragma unroll
                for (int nb = 0; nb < 4; ++nb) {
                    float h = carry[nb], A = carryA[nb], hn[4];
#pragma unroll
                    for (int ri = 0; ri < 4; ++ri) { const float a_ = dir ? av[nb][3 - ri] : av[nb][ri], u_ = dir ? uv[nb][3 - ri] : uv[nb][ri]; h = a_ * h + u_; A *= a_; hn[ri] = h; }
                    if (q4 == qs) {
#pragma unroll
                        for (int r = 0; r < 4; ++r) hv[nb][r] = dir ? hn[3 - r] : hn[r]; }
                    carry[nb] = __shfl(h, qs * 16 + e); if (!FINAL) carryA[nb] = __shfl(A, qs * 16 + e);
                }
            }
            if (FINAL) {
#pragma unroll
                for (int nb = 0; nb < 4; ++nb)
#pragma unroll
                    for (int r = 0; r < 4; ++r) (void)__hip_atomic_fetch_add(Hs + (mb * 16 + q4 * 4 + r) * 256 + n4 * 64 + nb * 16 + e, hv[nb][r], __ATOMIC_RELAXED, __HIP_MEMORY_SCOPE_WORKGROUP);
            }
        }
        if (!FINAL && q4 == 0) {
#pragma unroll
            for (int nb = 0; nb < 4; ++nb) { const int c = n4 * 64 + nb * 16 + e; float* o = RS + (((size_t)(dir * 2 + b) * NCHK + j) * 256 + c) * 2; o[0] = carryA[nb]; o[1] = carry[nb]; }
        }
    }
    if (FINAL) {
        __syncthreads();
        const int t = tid >> 3, cg = tid & 7; const size_t row = (size_t)seqbase + t0 + t;
#pragma unroll
        for (int s8 = 0; s8 < 4; ++s8) { const int c0 = cg * 32 + s8 * 8;
            const u32x4 gr = *(const u32x4*)(P + row * INW + C_RG + c0);
            const f32x4 h0 = *(const LAS f32x4*)(Hs + t * 256 + c0), h1 = *(const LAS f32x4*)(Hs + t * 256 + c0 + 4);
            u32x4 o; o.x = pg8::cvt_pk_bf16(h0[0] * __uint_as_float(gr.x << 16), h0[1] * __uint_as_float(gr.x & 0xffff0000u));
            o.y = pg8::cvt_pk_bf16(h0[2] * __uint_as_float(gr.y << 16), h0[3] * __uint_as_float(gr.y & 0xffff0000u));
            o.z = pg8::cvt_pk_bf16(h1[0] * __uint_as_float(gr.z << 16), h1[1] * __uint_as_float(gr.z & 0xffff0000u));
            o.w = pg8::cvt_pk_bf16(h1[2] * __uint_as_float(gr.w << 16), h1[3] * __uint_as_float(gr.w & 0xffff0000u));
            *(u32x4*)(Y + row * DM + 768 + c0) = o; }
    }
    __syncthreads();
}

constexpr int HG_PS = 65;
__device__ __forceinline__ void hg_load_tile(LAS float* dst, int stride, const bf16_t* P, size_t row0, int col0, int rev, int tid) {
    const int tau = tid >> 3, c8 = (tid & 7) * 8, t = rev ? 63 - tau : tau;
    const u32x4 v = *(const u32x4*)(P + (row0 + t) * INW + col0 + c8);
    LAS float* d = dst + tau * stride + c8;
    d[0] = __uint_as_float(v.x << 16); d[1] = __uint_as_float(v.x & 0xffff0000u); d[2] = __uint_as_float(v.y << 16); d[3] = __uint_as_float(v.y & 0xffff0000u);
    d[4] = __uint_as_float(v.z << 16); d[5] = __uint_as_float(v.z & 0xffff0000u); d[6] = __uint_as_float(v.w << 16); d[7] = __uint_as_float(v.w & 0xffff0000u);
}
__device__ __forceinline__ void hg_cumsum(LAS float* G, LAS float* Km, LAS float* seg, int tid) {
    const int k = tid & 63, sg = tid >> 6;
    float loc[8]; float run = 0.f;
#pragma unroll
    for (int i = 0; i < 8; ++i) { const float g = G[(sg * 8 + i) * HG_PS + k]; Km[(sg * 8 + i) * HG_PS + k] = 1.f - __expf(g); run += g; loc[i] = run; }
    seg[sg * 64 + k] = run;
    __syncthreads();
    float pre = 0.f;
#pragma unroll
    for (int s = 0; s < 8; ++s) { const float v = seg[s * 64 + k]; pre += (s < sg) ? v : 0.f; }
#pragma unroll
    for (int i = 0; i < 8; ++i) G[(sg * 8 + i) * HG_PS + k] = pre + loc[i];
    __syncthreads();
}
constexpr int HGL_G = 0, HGL_K = 64 * HG_PS * 4, HGL_V = 2 * 64 * HG_PS * 4, HGL_SEG = HGL_V + 64 * 64 * 4;
__device__ __forceinline__ void hgrn_local_item(LAS unsigned char* lds, const bf16_t* P, int dir, int b, int h, int j, float* Lbuf, float* Dbuf) {
    int tid_ = threadIdx.x; asm volatile("" : "+v"(tid_)); const int tid = tid_;
    LAS float* G = (LAS float*)(lds + HGL_G); LAS float* Km = (LAS float*)(lds + HGL_K); LAS float* Vs = (LAS float*)(lds + HGL_V); LAS float* seg = (LAS float*)(lds + HGL_SEG);
    int row0, t0, len, seqbase; chunk_rows(dir, b, j, row0, t0, len, seqbase);
    hg_load_tile(G, HG_PS, P, (size_t)row0, (dir ? C_HB : C_HF) + h * 64, dir, tid);
    hg_load_tile(Vs, 64, P, (size_t)row0, C_HI + h * 64, dir, tid);
    __syncthreads();
    hg_cumsum(G, Km, seg, tid);
    { const int k = tid & 63, sg = tid >> 6; const float be = G[63 * HG_PS + k];
#pragma unroll
      for (int i = 0; i < 8; ++i) { const int tau = sg * 8 + i; Km[tau * HG_PS + k] *= __expf(be - G[tau * HG_PS + k]); }
      if (sg == 0) Dbuf[((size_t)((dir * 2 + b) * 4 + h) * NCHK + j) * 64 + k] = __expf(be); }
    __syncthreads();
    { const int k = tid >> 3, v0 = (tid & 7) * 8; f32x4 a0 = (f32x4){0.f, 0.f, 0.f, 0.f}, a1 = a0;
#pragma unroll 8
      for (int s = 0; s < 64; ++s) { const float kh = Km[s * HG_PS + k]; a0 += kh * *(const LAS f32x4*)(Vs + s * 64 + v0); a1 += kh * *(const LAS f32x4*)(Vs + s * 64 + v0 + 4); }
      float* o = Lbuf + ((size_t)((dir * 2 + b) * 4 + h) * NCHK + j) * 4096 + k * 64 + v0; *(f32x4*)o = a0; *(f32x4*)(o + 4) = a1; }
    __syncthreads();
}
__device__ __forceinline__ void hgrn_state_scan(int chain, int elem, float* Lbuf, const float* Dbuf) {
    float* lp = Lbuf + (size_t)chain * NCHK * 4096 + elem; const float* dp = Dbuf + (size_t)chain * NCHK * 64 + (elem >> 6);
    float S = 0.f;
    for (int j0 = 0; j0 < NCHK; j0 += 33) {
        float Lv[33], dv[33];
#pragma unroll
        for (int i = 0; i < 33; ++i) { Lv[i] = lp[(size_t)(j0 + i) * 4096]; dv[i] = dp[(size_t)(j0 + i) * 64]; }
#pragma unroll
        for (int i = 0; i < 33; ++i) { lp[(size_t)(j0 + i) * 4096] = S; S = dv[i] * S + Lv[i]; }
    }
}
constexpr int HGO_Q = 0, HGO_B = 64 * HG_PS * 4, HGO_K = 2 * 64 * HG_PS * 4, HGO_A = 3 * 64 * HG_PS * 4, HGO_V = 4 * 64 * HG_PS * 4, HGO_S = HGO_V + 16384, HGO_O = HGO_S + 16384, HGO_SEG = HGO_O + 16384;
__device__ __forceinline__ void hgrn_out_item(LAS unsigned char* lds, const bf16_t* P, const float* hg_norm_l, int b, int h, int isctx, int n, const float* Lbuf, bf16_t* Y) {
    int tid_ = threadIdx.x; asm volatile("" : "+v"(tid_)); const int tid = tid_;
    LAS float* Qs = (LAS float*)(lds + HGO_Q); LAS float* Bc = (LAS float*)(lds + HGO_B); LAS float* Km = (LAS float*)(lds + HGO_K); LAS float* At = (LAS float*)(lds + HGO_A);
    LAS float* Vs = (LAS float*)(lds + HGO_V); LAS float* S0 = (LAS float*)(lds + HGO_S); LAS float* Os = (LAS float*)(lds + HGO_O); LAS float* seg = (LAS float*)(lds + HGO_SEG);
    const size_t row0 = (isctx ? (size_t)MLAT + b * CTXL : (size_t)b * SEQ) + 64 * n;
    for (int dir = 0; dir < 2; ++dir) {
        const int j = isctx ? (dir ? 3 - n : n) : 4 + (dir ? 127 - n : n);
        hg_load_tile(Qs, HG_PS, P, row0, C_HQ + h * 64, dir, tid);
        hg_load_tile(Bc, HG_PS, P, row0, (dir ? C_HB : C_HF) + h * 64, dir, tid);
        hg_load_tile(Vs, 64, P, row0, C_HI + h * 64, dir, tid);
        { const float* sp = Lbuf + ((size_t)((dir * 2 + b) * 4 + h) * NCHK + j) * 4096;
#pragma unroll
          for (int i = 0; i < 2; ++i) *(LAS f32x4*)(S0 + (tid + i * NTHREADS) * 4) = *(const f32x4*)(sp + (tid + i * NTHREADS) * 4); }
        __syncthreads();
        hg_cumsum(Bc, Km, seg, tid);
        { const int tau = tid >> 3, s0 = tid & 7; float acc[8];
#pragma unroll
          for (int i = 0; i < 8; ++i) acc[i] = 0.f;
          for (int k = 0; k < 64; ++k) { const float q = Qs[tau * HG_PS + k], bt = Bc[tau * HG_PS + k];
#pragma unroll
              for (int i = 0; i < 8; ++i) { const int sg = s0 + 8 * i; acc[i] += q * Km[sg * HG_PS + k] * __expf(fminf(bt - Bc[sg * HG_PS + k], 0.f)); } }
#pragma unroll
          for (int i = 0; i < 8; ++i) { const int sg = s0 + 8 * i; At[tau * HG_PS + sg] = sg <= tau ? acc[i] : 0.f; } }
        __syncthreads();
        { const int tau = tid >> 3, v0 = (tid & 7) * 8; f32x4 a0 = (f32x4){0.f, 0.f, 0.f, 0.f}, a1 = a0;
#pragma unroll 4
          for (int k = 0; k < 64; ++k) { const float qe = Qs[tau * HG_PS + k] * __expf(Bc[tau * HG_PS + k]); a0 += qe * *(const LAS f32x4*)(S0 + k * 64 + v0); a1 += qe * *(const LAS f32x4*)(S0 + k * 64 + v0 + 4); }
          for (int s = 0; s <= tau; ++s) { const float a = At[tau * HG_PS + s]; a0 += a * *(const LAS f32x4*)(Vs + s * 64 + v0); a1 += a * *(const LAS f32x4*)(Vs + s * 64 + v0 + 4); }
          const int t = dir ? 63 - tau : tau; LAS float* o = Os + t * 64 + v0;
          if (dir == 0) { *(LAS f32x4*)o = a0; *(LAS f32x4*)(o + 4) = a1; } else { *(LAS f32x4*)o = *(LAS f32x4*)o + a0; *(LAS f32x4*)(o + 4) = *(LAS f32x4*)(o + 4) + a1; } }
        __syncthreads();
    }
    { const int t = tid >> 3, v0 = (tid & 7) * 8; const f32x4 o0 = *(const LAS f32x4*)(Os + t * 64 + v0), o1 = *(const LAS f32x4*)(Os + t * 64 + v0 + 4);
      float ss = o0[0] * o0[0] + o0[1] * o0[1] + o0[2] * o0[2] + o0[3] * o0[3] + o1[0] * o1[0] + o1[1] * o1[1] + o1[2] * o1[2] + o1[3] * o1[3];
      ss += __shfl_xor(ss, 1); ss += __shfl_xor(ss, 2); ss += __shfl_xor(ss, 4);
      const float rs = rsqrtf(ss * (1.f / 64.f) + EPS);
      const f32x4 g0 = *(const f32x4*)(hg_norm_l + h * 64 + v0), g1 = *(const f32x4*)(hg_norm_l + h * 64 + v0 + 4);
      const u32x4 gt = *(const u32x4*)(P + (row0 + t) * INW + C_HG + h * 64 + v0);
      u32x4 w; w.x = pg8::cvt_pk_bf16(o0[0] * rs * g0[0] * __uint_as_float(gt.x << 16), o0[1] * rs * g0[1] * __uint_as_float(gt.x & 0xffff0000u));
      w.y = pg8::cvt_pk_bf16(o0[2] * rs * g0[2] * __uint_as_float(gt.y << 16), o0[3] * rs * g0[3] * __uint_as_float(gt.y & 0xffff0000u));
      w.z = pg8::cvt_pk_bf16(o1[0] * rs * g1[0] * __uint_as_float(gt.z << 16), o1[1] * rs * g1[1] * __uint_as_float(gt.z & 0xffff0000u));
      w.w = pg8::cvt_pk_bf16(o1[2] * rs * g1[2] * __uint_as_float(gt.w << 16), o1[3] * rs * g1[3] * __uint_as_float(gt.w & 0xffff0000u));
      *(u32x4*)(Y + (row0 + t) * DM + 512 + h * 64 + v0) = w; }
    __syncthreads();
}
__device__ __forceinline__ void rg_carry_scan(int gt, const float* RS, float* RE) {
    const int c = gt & 255, db = gt >> 8;
    const float* rs = RS + ((size_t)db * NCHK * 256 + c) * 2; float* re = RE + (size_t)db * NCHK * 256 + c;
    float h = 0.f;
    for (int j0 = 0; j0 < NCHK; j0 += 33) {
        float A[33], Hl[33];
#pragma unroll
        for (int i = 0; i < 33; ++i) { const float2 v = *(const float2*)(rs + (size_t)(j0 + i) * 512); A[i] = v.x; Hl[i] = v.y; }
#pragma unroll
        for (int i = 0; i < 33; ++i) { re[(size_t)(j0 + i) * 256] = h; h = A[i] * h + Hl[i]; }
    }
}
__device__ __forceinline__ void rg_gate_weights_prep(const float* ga_w, const float* gx_w, bf16_t* gw_all, int bid, int G, int tid) {
    const int total = DEPTH * 2 * 2 * 4 * 64 * 64;
    for (int i = bid * NTHREADS + tid; i < total; i += G * NTHREADS) {
        const int d = i & 63, e = (i >> 6) & 63, n4 = (i >> 12) & 3, gt = (i >> 14) & 1, dir = (i >> 15) & 1, l = i >> 16;
        const float* srcw = gt ? gx_w : ga_w;
        gw_all[i] = f2bf(srcw[((((size_t)l * 2 + dir) * 4 + n4) * 64 + d) * 64 + e]);
    }
}

#define XB_TMO      128
#define XB_XCNT(j)  (256  + 64 * (j))
#define XB_XSUB(j)  (1280 + 64 * (j))
#define XB_XGEN(j)  (2304 + 64 * (j))
#define XB_TOP      3328
#define XB_TOPGEN   3392
#define XCD_BAR_WORDS 3456
#define XB_SPIN_CAP (1u << 18)

__device__ __forceinline__ unsigned xb_ld(unsigned* p)              { return __hip_atomic_load(p, __ATOMIC_RELAXED, __HIP_MEMORY_SCOPE_AGENT); }
__device__ __forceinline__ unsigned xb_add(unsigned* p, unsigned v) { return __hip_atomic_fetch_add(p, v, __ATOMIC_RELAXED, __HIP_MEMORY_SCOPE_AGENT); }
__device__ __forceinline__ unsigned xb_xcc_id() { return (unsigned)__builtin_amdgcn_s_getreg((3 << 11) | 20) & 0xFu; }
#define XB_SPIN(cond, bar) do { unsigned _sp = 0; while (cond) { __builtin_amdgcn_s_sleep(1); \
    if ((++_sp & 255u) == 0u) { if (xb_ld(&(bar)[XB_TMO])) break; if (_sp > XB_SPIN_CAP) { atomicAdd(&(bar)[XB_TMO], 1u); break; } } } } while (0)

struct XcdBarrier {
    unsigned* bar; unsigned x;
    volatile LAS unsigned* st;
};

__device__ __forceinline__ XcdBarrier xcd_barrier_post(unsigned* bar, volatile LAS unsigned* st) {
    XcdBarrier b; b.bar = bar; b.x = xb_xcc_id(); b.st = st;
    if (threadIdx.x == 0) (void)xb_add(&bar[XB_XCNT(b.x)], 1u);
    return b;
}
__device__ __forceinline__ void xcd_barrier_complete(unsigned* bar, unsigned x, unsigned& nloc, unsigned& nx) {
    const unsigned G = gridDim.x * gridDim.y * gridDim.z;
    unsigned sum, cnt, mine, sp = 0u;
    for (;;) {
        sum = 0u; cnt = 0u; mine = 0u;
#pragma unroll
        for (unsigned j = 0; j < 16; ++j) { const unsigned c = xb_ld(&bar[XB_XCNT(j)]); sum += c; cnt += (c > 0u) ? 1u : 0u; mine = (j == x) ? c : mine; }
        if (sum == G) break;
        __builtin_amdgcn_s_sleep(1);
        if ((++sp & 255u) == 0u) { if (xb_ld(&bar[XB_TMO])) break; if (sp > XB_SPIN_CAP) { atomicAdd(&bar[XB_TMO], 1u); break; } }
    }
    nloc = mine > 0u ? mine : 1u; nx = cnt > 0u ? cnt : 1u;
}

__device__ __forceinline__ void xcd_barrier(const XcdBarrier& b) {
    asm volatile("s_waitcnt vmcnt(0)" ::: "memory");
    __syncthreads();
    if (threadIdx.x == 0) {
        unsigned* bar = b.bar;
        __builtin_amdgcn_s_waitcnt(0);
        unsigned nloc = b.st[0], nx = b.st[1];
        if (nloc == 0u) { xcd_barrier_complete(bar, b.x, nloc, nx); b.st[0] = nloc; b.st[1] = nx; }
        const unsigned old = xb_add(&bar[XB_XSUB(b.x)], 1u);
        const unsigned gen = old / nloc;
        if (old + 1u == (gen + 1u) * nloc) {
            __builtin_amdgcn_fence(__ATOMIC_RELEASE, "agent");
            asm volatile("s_waitcnt vmcnt(0)" ::: "memory");
            const unsigned og = xb_add(&bar[XB_TOP], 1u);
            const unsigned tg = og / nx;
            if (og + 1u == (tg + 1u) * nx) xb_add(&bar[XB_TOPGEN], 1u);
            else XB_SPIN(xb_ld(&bar[XB_TOPGEN]) == tg, bar);
            __builtin_amdgcn_fence(__ATOMIC_ACQUIRE, "agent");
            xb_add(&bar[XB_XGEN(b.x)], 1u);
            asm volatile("s_waitcnt vmcnt(0)" ::: "memory");
        } else {
            XB_SPIN(xb_ld(&bar[XB_XGEN(b.x)]) == gen, bar);
            __builtin_amdgcn_fence(__ATOMIC_ACQUIRE, "agent");
            asm volatile("s_waitcnt vmcnt(0)" ::: "memory");
        }
    }
    __syncthreads();
}

__device__ __forceinline__ void ph_normmod(const float* xlat, const float* xctx, const float* g, const float* mods_l, int i_shift, int i_scale, bf16_t* XN, int nrows) {
    int tid_ = threadIdx.x; asm volatile("" : "+v"(tid_));
    int bid_ = blockIdx.x, G_ = gridDim.x; asm volatile("" : "+s"(bid_), "+s"(G_));
    const int lane = tid_ & 63, gw = bid_ * NWAVES + (tid_ >> 6), ngw = G_ * NWAVES;
    for (int row = gw; row < nrows; row += ngw) {
        const float* xr = row < MLAT ? xlat + (size_t)row * DM : xctx + (size_t)(row - MLAT) * DM;
        const int mi = row < MLAT ? row / SEQ : 2;
        const float* sh = mods_l + (size_t)mi * NMODS * DM + i_shift * DM; const float* sc = mods_l + (size_t)mi * NMODS * DM + i_scale * DM;
        f32x4 v[4]; float ss = 0.f;
#pragma unroll
        for (int j = 0; j < 4; ++j) { v[j] = *(const f32x4*)(xr + 256 * j + 4 * lane); ss += v[j].x * v[j].x + v[j].y * v[j].y + v[j].z * v[j].z + v[j].w * v[j].w; }
        const float rstd = rsqrtf(wave_sum(ss) * (1.f / DM) + EPS);
#pragma unroll
        for (int j = 0; j < 4; ++j) { const int c0 = 256 * j + 4 * lane; const f32x4 gg = *(const f32x4*)(g + c0), s1 = *(const f32x4*)(sc + c0), s0 = *(const f32x4*)(sh + c0);
            const f32x4 o = v[j] * rstd * gg * (s1 + 1.f) + s0;
            *(uint2*)(XN + (size_t)row * DM + c0) = make_uint2(pg8::cvt_pk_bf16(o[0], o[1]), pg8::cvt_pk_bf16(o[2], o[3])); }
    }
}
__device__ __forceinline__ void ph_final_norm(float* x, const float* g) {
    int tid_ = threadIdx.x; asm volatile("" : "+v"(tid_));
    int bid_ = blockIdx.x, G_ = gridDim.x; asm volatile("" : "+s"(bid_), "+s"(G_));
    const int lane = tid_ & 63, gw = bid_ * NWAVES + (tid_ >> 6), ngw = G_ * NWAVES;
    for (int row = gw; row < MLAT; row += ngw) {
        float* xr = x + (size_t)row * DM;
        f32x4 v[4]; float ss = 0.f;
#pragma unroll
        for (int j = 0; j < 4; ++j) { v[j] = *(const f32x4*)(xr + 256 * j + 4 * lane); ss += v[j].x * v[j].x + v[j].y * v[j].y + v[j].z * v[j].z + v[j].w * v[j].w; }
        const float rstd = rsqrtf(wave_sum(ss) * (1.f / DM) + EPS);
#pragma unroll
        for (int j = 0; j < 4; ++j) { const int c0 = 256 * j + 4 * lane; const f32x4 gg = *(const f32x4*)(g + c0); *(f32x4*)(xr + c0) = v[j] * rstd * gg; }
    }
}


__device__ __forceinline__ void pro_transpose_item(const float* W, int K, int N, bf16_t* WT, bool swi, LAS float* scr, int item, int lane) {
    const int nblk = N / 32, kb = item / nblk, nb = item % nblk, k0 = 64 * kb, n0 = 32 * nb;
    int nd0 = n0; if (swi) { const int half = n0 >= FH, nn = half ? n0 - FH : n0; nd0 = 256 * (nn / 128) + 128 * half + (nn % 128); }
#pragma unroll 8
    for (int i = 0; i < 32; ++i) { const int kk = 2 * i + (lane >> 5); scr[kk * 33 + (lane & 31)] = W[(size_t)(k0 + kk) * N + n0 + (lane & 31)]; }
    asm volatile("s_waitcnt lgkmcnt(0)" ::: "memory");
    const int c = lane & 7;
#pragma unroll
    for (int j = 0; j < 4; ++j) { const int n = (lane >> 3) + 8 * j; const LAS float* s = scr + (8 * c) * 33 + n;
        u32x4 o; o.x = pg8::cvt_pk_bf16(s[0 * 33], s[1 * 33]); o.y = pg8::cvt_pk_bf16(s[2 * 33], s[3 * 33]); o.z = pg8::cvt_pk_bf16(s[4 * 33], s[5 * 33]); o.w = pg8::cvt_pk_bf16(s[6 * 33], s[7 * 33]);
        *(u32x4*)(WT + (size_t)(nd0 + n) * K + k0 + 8 * c) = o; }
    asm volatile("s_waitcnt lgkmcnt(0)" ::: "memory");
}
__device__ __forceinline__ void ph_prologue_a(KParams& p, LAS unsigned char* lds, int bid, int G, int tid) {
    unsigned char* ws = p.ws; const int lane = tid & 63, wid = __builtin_amdgcn_readfirstlane(tid >> 6);
    {
        LAS float* sc = (LAS float*)lds;
        LAS float* part = (LAS float*)(lds + 12288);
        if (bid < 288) {
            for (int i = tid; i < 3 * DM; i += NTHREADS) { const int mi = i >> 10, k = i & 1023; const float v = mi < 2 ? p.in[1][mi * DM + k] : p.in[3][k]; sc[i] = siluf_(v); }
            __syncthreads();
            for (int u = bid; u < 288; u += G) {
                const int l = u / 144, n0 = (u % 144) * 64;
                const float* wp = p.in[4] + (size_t)l * DM * NMODS * DM + (size_t)(wid * 128) * (NMODS * DM) + n0 + lane;
                float a0 = 0.f, a1 = 0.f, a2 = 0.f;
#pragma unroll 16
                for (int k = 0; k < 128; ++k) { const float wv = wp[(size_t)k * (NMODS * DM)]; const int kk = wid * 128 + k; a0 += sc[kk] * wv; a1 += sc[1024 + kk] * wv; a2 += sc[2048 + kk] * wv; }
                part[(wid * 3 + 0) * 64 + lane] = a0; part[(wid * 3 + 1) * 64 + lane] = a1; part[(wid * 3 + 2) * 64 + lane] = a2;
                __syncthreads();
                if (tid < 192) { const int mi = tid >> 6, c = tid & 63; float s = p.in[5][l * NMODS * DM + n0 + c];
#pragma unroll
                    for (int w8 = 0; w8 < 8; ++w8) s += part[(w8 * 3 + mi) * 64 + c];
                    ((float*)(ws + WS_MODS))[((size_t)l * 3 + mi) * NMODS * DM + n0 + c] = s; }
                __syncthreads();
            }
        }
    }
    if (bid == G - 1) {
        float* rope = (float*)(ws + WS_ROPE); float* lb = (float*)(ws + WS_LB);
        for (int i = tid; i < 2048; i += NTHREADS) { const int pos = i >> 4, f = i & 15; const float inv = powf(10000.f, -(float)f / 16.f); const float ang = (float)pos * inv; rope[i] = cosf(ang); rope[2048 + i] = sinf(ang); }
        if (tid < 512) { const float l0 = p.in[13][tid], l1 = p.in[13][512 + tid]; const float mx = fmaxf(l0, l1); const float e0 = expf(l0 - mx), e1 = expf(l1 - mx); lb[tid] = 0.f; lb[512 + tid] = e1 / (e0 + e1); }
    }
    rg_gate_weights_prep(p.in[17], p.in[19], (bf16_t*)(ws + WS_GW), bid, G, tid);
    {
        __syncthreads();
        LAS float* scr = (LAS float*)(lds + wid * 8448);
        constexpr int I_1IN = (DM / 64) * (2 * FH / 32), I_1OUT = (FH / 64) * (DM / 32), I_IN = (DM / 64) * (INW / 32), I_OUT = (DM / 64) * (DM / 32);
        constexpr int I_LAYER = 2 * I_1IN + 2 * I_1OUT + I_IN + I_OUT;
        const int gw = bid * NWAVES + wid, ngw = G * NWAVES;
        for (int it = gw; it < DEPTH * I_LAYER; it += ngw) {
            const int l = it / I_LAYER; int r = it % I_LAYER; unsigned char* wl = ws + WS_W + l * W_L_STRIDE;
            if (r < I_1IN) { pro_transpose_item(p.in[7] + (size_t)l * DM * 2 * FH, DM, 2 * FH, (bf16_t*)(wl + W_1IN), true, scr, r, lane); continue; } r -= I_1IN;
            if (r < I_1IN) { pro_transpose_item(p.in[23] + (size_t)l * DM * 2 * FH, DM, 2 * FH, (bf16_t*)(wl + W_2IN), true, scr, r, lane); continue; } r -= I_1IN;
            if (r < I_1OUT) { pro_transpose_item(p.in[8] + (size_t)l * FH * DM, FH, DM, (bf16_t*)(wl + W_1OUT), false, scr, r, lane); continue; } r -= I_1OUT;
            if (r < I_1OUT) { pro_transpose_item(p.in[24] + (size_t)l * FH * DM, FH, DM, (bf16_t*)(wl + W_2OUT), false, scr, r, lane); continue; } r -= I_1OUT;
            if (r < I_IN) { pro_transpose_item(p.in[10] + (size_t)l * DM * INW, DM, INW, (bf16_t*)(wl + W_IN), false, scr, r, lane); continue; } r -= I_IN;
            pro_transpose_item(p.in[11] + (size_t)l * DM * DM, DM, DM, (bf16_t*)(wl + W_OUT), false, scr, r, lane);
        }
        __syncthreads();
    }
}
__device__ __forceinline__ void run_phase(KParams& p, LAS unsigned char* lds, int ph) {
    unsigned char* ws = p.ws; float* out = p.out;
    float* mods = (float*)(ws + WS_MODS); float* rope = (float*)(ws + WS_ROPE); float* lb = (float*)(ws + WS_LB); float* xctx = (float*)(ws + WS_XCTX);
    bf16_t* XN = (bf16_t*)(ws + WS_XN); bf16_t* Y = XN; bf16_t* H = (bf16_t*)(ws + WS_H); bf16_t* P = H;
    int G = gridDim.x, bid = blockIdx.x, tid = threadIdx.x; asm volatile("" : "+s"(G), "+s"(bid), "+v"(tid));
    if (ph == PH_PRO_A) { ph_prologue_a(p, lds, bid, G, tid); return; }
    if (ph == PH_PRO_B) { ph_normmod(p.in[0], p.in[2], p.in[6], mods, 0, 1, XN, MTOT); return; }
    const int q = ph - PH_LAYER0, l = q / PH_PER_LAYER, s = q % PH_PER_LAYER;
    const bool wctx = l < DEPTH - 1; const int Mmix = wctx ? MTOT : MLAT;
    unsigned char* wl = ws + WS_W + l * W_L_STRIDE; const float* mods_l = mods + (size_t)l * 3 * NMODS * DM;
    const float* src_lat = l == 0 ? p.in[0] : out; const float* src_ctx = l == 0 ? p.in[2] : xctx;
    switch (s) {
    case S_FFN1_IN: case S_FFN2_IN: {
        const int M = s == S_FFN1_IN ? MTOT : Mmix;
        pg8::Gemm g{XN, (const bf16_t*)(wl + (s == S_FFN1_IN ? W_1IN : W_2IN)), M, 2 * FH, DM}; pg8::StaticOrder S; S.init(M, 2 * FH, G, bid);
        pg8::EpiSwiglu E{H, FH};
        pg8::gemm_phase<pg8::EpiSwiglu, pg8::StaticOrder, true, true>(lds, g, S, E);
    } break;
    case S_FFN1_OUT: case S_OUTPROJ: case S_FFN2_OUT: {
        const int M = s == S_FFN1_OUT ? MTOT : Mmix; const int K = s == S_OUTPROJ ? DM : FH;
        const bf16_t* A = s == S_OUTPROJ ? Y : H; const size_t wo = s == S_FFN1_OUT ? W_1OUT : (s == S_OUTPROJ ? W_OUT : W_2OUT);
        const int ig = s == S_FFN1_OUT ? 2 : (s == S_OUTPROJ ? 5 : 8);
        pg8::Gemm g{A, (const bf16_t*)(wl + wo), M, DM, K}; pg8::StaticOrder S; S.init(M, DM, G, bid);
        pg8::EpiResid E{s == S_FFN1_OUT ? src_lat : out, s == S_FFN1_OUT ? src_ctx : xctx, out, xctx, mods_l + ig * DM, s == S_OUTPROJ ? 1.f : 0.5f};
        pg8::gemm_phase<pg8::EpiResid, pg8::StaticOrder, true, true>(lds, g, S, E);
    } break;
    case S_INPROJ: {
        pg8::Gemm g{XN, (const bf16_t*)(wl + W_IN), MTOT, INW, DM}; pg8::StaticOrder S; S.init(MTOT, INW, G, bid);
        pg8::EpiInproj E{P, rope, lb + l * 512};
        pg8::gemm_phase<pg8::EpiInproj, pg8::StaticOrder, true, true>(lds, g, S, E);
    } break;
    case S_NORM_MIX: ph_normmod(out, xctx, p.in[9] + l * DM, mods_l, 3, 4, XN, MTOT); break;
    case S_NORM_FFN2: ph_normmod(out, xctx, p.in[22] + l * DM, mods_l, 6, 7, XN, Mmix); break;
    case S_NEXT_NORM:
        if (l + 1 < DEPTH) ph_normmod(out, xctx, p.in[6] + (l + 1) * DM, mods_l + 3 * NMODS * DM, 0, 1, XN, MTOT);
        else ph_final_norm(out, p.in[25]);
        break;
    case S_MIX1: {
        { const int nat = wctx ? 264 : 256;
          for (int it = bid; it < nat; it += G) { if (it < 256) attn_unit(lds, P, p.in[12] + l * 8, Y, it >> 7, (it >> 1) & 63, it & 1, false); else { const int c = it - 256; attn_unit(lds, P, p.in[12] + l * 8, Y, c >> 2, (c >> 1) & 1, c & 1, true); } } }
        const RgW w{p.in[15] + l * 1024, p.in[16] + l * 256, p.in[18] + l * 512, p.in[20] + l * 512, p.in[21] + l * 512, (const bf16_t*)(ws + WS_GW) + (size_t)l * 65536};
        for (int it = bid; it < 16 * NCHK; it += G) { const int chain = it / NCHK, j = it % NCHK; hgrn_local_item(lds, P, chain >> 3, (chain >> 2) & 1, chain & 3, j, (float*)(ws + WS_T), (float*)(ws + WS_HD)); }
        for (int it = bid; it < 2 * NCHK; it += G) { const int b = it / NCHK, jj = it % NCHK; rg_item<false>(lds, P, w, b, jj < 4, jj < 4 ? jj : jj - 4, (float*)(ws + WS_RS), nullptr, Y); }
    } break;
    case S_MIX2: {
        const int gt = (bid - (G - 2)) * NTHREADS + tid;
        if (bid >= G - 2) rg_carry_scan(gt, (const float*)(ws + WS_RS), (float*)(ws + WS_RE));
        if (bid < 128) hgrn_state_scan(bid >> 3, (bid & 7) * NTHREADS + tid, (float*)(ws + WS_T), (const float*)(ws + WS_HD));
    } break;
    case S_MIX3: {
        const RgW w{p.in[15] + l * 1024, p.in[16] + l * 256, p.in[18] + l * 512, p.in[20] + l * 512, p.in[21] + l * 512, (const bf16_t*)(ws + WS_GW) + (size_t)l * 65536};
        { const int nhi = wctx ? 8 * NCHK : 8 * 128;
          for (int it = bid; it < nhi; it += G) { int bh, isctx, n; if (wctx) { bh = it / NCHK; const int jj = it % NCHK; isctx = jj < 4; n = isctx ? jj : jj - 4; } else { bh = it >> 7; isctx = 0; n = it & 127; }
              hgrn_out_item(lds, P, p.in[14] + l * 256, bh >> 2, bh & 3, isctx, n, (const float*)(ws + WS_T), Y); } }
        const int nit = wctx ? 2 * NCHK : 2 * 128;
        for (int it = bid; it < nit; it += G) { int b, isctx, n; if (wctx) { b = it / NCHK; const int jj = it % NCHK; isctx = jj < 4; n = isctx ? jj : jj - 4; } else { b = it >> 7; isctx = 0; n = it & 127; }
            rg_item<true>(lds, P, w, b, isctx, n, nullptr, (const float*)(ws + WS_RE), Y); }
    } break;
    default: break;
    }
}

__global__ void __launch_bounds__(NTHREADS, 2) mk(Params p) {
    extern __shared__ __attribute__((aligned(16))) unsigned char lds_raw[];
    LAS unsigned char* lds = (LAS unsigned char*)lds_raw;
    cg::grid_group grid = cg::this_grid();
    volatile LAS unsigned* xst = (volatile LAS unsigned*)(lds + LDS_XB);
    if (threadIdx.x < 16) xst[threadIdx.x] = 0u;
    __syncthreads();
    XcdBarrier bar = xcd_barrier_post((unsigned*)(p.ws + WS_CTL), xst);
    for (int ph = p.ph_lo; ph < p.ph_hi; ++ph) {
        KParams* kp = (KParams*)__builtin_amdgcn_kernarg_segment_ptr(); asm volatile("" : "+s"(kp));
        run_phase(*kp, lds, ph);
        if (ph + 1 < p.ph_hi) { if (ph == p.ph_lo) grid.sync(); else xcd_barrier(bar); }
    }
}
}

extern "C" void kernel_launch(void* const* d_in, const int* in_sizes, int n_in, void* d_out, int out_size, void* d_ws, size_t ws_size, hipStream_t stream) {
    if (n_in != 26 || out_size != MLAT * DM || ws_size < WS_END) { fprintf(stderr, "kernel_launch: unexpected problem (n_in %d out %d ws %zu)\n", n_in, out_size, ws_size); return; }
    static int grid = 0;
    if (grid == 0) {
        int dev = 0, cus = 0, per_cu = 0;
        hipGetDevice(&dev); hipDeviceGetAttribute(&cus, hipDeviceAttributeMultiprocessorCount, dev);
        hipFuncSetAttribute((const void*)mk, hipFuncAttributeMaxDynamicSharedMemorySize, LDS_BYTES);
        hipOccupancyMaxActiveBlocksPerMultiprocessor(&per_cu, (const void*)mk, NTHREADS, LDS_BYTES);
        if (per_cu < 1) { fprintf(stderr, "kernel_launch: occupancy query says %d blocks per CU\n", per_cu); per_cu = 1; }
        grid = cus * (per_cu < 1 ? 1 : 1);
        (void)hipGetLastError();
    }
    unsigned char* ws = (unsigned char*)d_ws;
    Params prm{}; for (int i = 0; i < 26; ++i) prm.in[i] = (const float*)d_in[i]; prm.out = (float*)d_out; prm.ws = ws;
    prm.ph_lo = 0; prm.ph_hi = N_PHASES;
    if (hipMemsetAsync(ws + WS_CTL, 0, CTL_ZERO_BYTES, stream) != hipSuccess) { fprintf(stderr, "kernel_launch: memset failed\n"); return; }
    void* args[] = {&prm};
    const hipError_t le = hipLaunchCooperativeKernel((const void*)mk, dim3(grid), dim3(NTHREADS), args, LDS_BYTES, stream);
    if (le != hipSuccess) fprintf(stderr, "kernel_launch: cooperative launch failed: %s (grid %d)\n", hipGetErrorString(le), grid);
}
```

```cpp
#include <hip/hip_runtime.h>
#include <cstdio>
#include <cstdint>
#include <hip/hip_cooperative_groups.h>
namespace cg = cooperative_groups;

namespace {
constexpr int DM = 1024, BATCH = 2, SEQ = 8192, DEPTH = 2, CTXL = 256, NMODS = 9, FH = 2816;
constexpr int MLAT = BATCH * SEQ, MCTX = BATCH * CTXL, MTOT = MLAT + MCTX;
constexpr int INW = 2560;
constexpr int C_Q = 0, C_K = 512, C_V = 640, C_HQ = 768, C_HF = 1024, C_HB = 1280, C_HI = 1536, C_HG = 1792, C_RX = 2048, C_RG = 2304;
constexpr float EPS = 1e-6f;

typedef unsigned short bf16_t;
typedef short bf16x8 __attribute__((ext_vector_type(8)));
typedef float f32x4 __attribute__((ext_vector_type(4)));
typedef unsigned u32x4 __attribute__((ext_vector_type(4)));
typedef float f32x16 __attribute__((ext_vector_type(16)));
typedef unsigned u32x2 __attribute__((ext_vector_type(2)));

constexpr size_t MiB = 1u << 20;
constexpr size_t WS_CTL = 0;
constexpr size_t WS_MODS = 1 * MiB;
constexpr size_t WS_ROPE = 1 * MiB + 512 * 1024;
constexpr size_t WS_LB = WS_ROPE + 32 * 1024;
constexpr size_t WS_XCTX = 2 * MiB;
constexpr size_t WS_W = 4 * MiB;
constexpr size_t W_L_STRIDE = 40 * MiB;
constexpr size_t W_1IN = 0, W_1OUT = 11 * MiB, W_IN = 16 * MiB + 512 * 1024, W_OUT = 21 * MiB + 512 * 1024, W_2IN = 23 * MiB + 512 * 1024, W_2OUT = 34 * MiB + 512 * 1024;
constexpr size_t WS_XN = 84 * MiB;
constexpr size_t WS_H = 117 * MiB;
constexpr size_t WS_T = 208 * MiB;
constexpr size_t WS_GW = 1 * MiB + 768 * 1024;
constexpr size_t WS_HD = 241 * MiB;
constexpr size_t WS_RS = 242 * MiB;
constexpr size_t WS_RE = 243 * MiB + 512 * 1024;
constexpr size_t WS_END = 245 * MiB;
constexpr int NCHK = 132;

__device__ __forceinline__ float bf2f(bf16_t v) { return __uint_as_float(((unsigned)v) << 16); }
__device__ __forceinline__ bf16_t f2bf(float f) { unsigned u = __float_as_uint(f); return (bf16_t)((u + 0x7fffu + ((u >> 16) & 1u)) >> 16); }
__device__ __forceinline__ float sigmoidf_(float x) { return 1.f / (1.f + __expf(-x)); }
__device__ __forceinline__ float siluf_(float x) { return x / (1.f + __expf(-x)); }
__device__ __forceinline__ float gelu_tanh(float x) { const float u = 0.7978845608028654f * (x + 0.044715f * x * x * x); return 0.5f * x * (1.f + tanhf(u)); }
__device__ __forceinline__ float wave_sum(float v) {
#pragma unroll
    for (int o = 1; o < 64; o <<= 1) v += __shfl_xor(v, o);
    return v;
}

namespace pg8 {
#define PG8_LAS __attribute__((address_space(3)))
typedef unsigned short bf16_t;
typedef short bf16x8 __attribute__((ext_vector_type(8)));
typedef float f32x4 __attribute__((ext_vector_type(4)));
typedef unsigned u32x4 __attribute__((ext_vector_type(4)));
constexpr int BM = 256, BK = 64, HALF = 128, HTB = HALF * BK * 2  , STAGE_BYTES = 8 * HTB, NXCD = 8, WGM = 8;

__host__ __device__ __forceinline__ int lds_byte(int r, int c) { const int st = (r >> 4) * 2 + (c >> 5), rr = r & 15, cc = c & 31, ob = rr * 64 + cc * 2; return st * 1024 + (ob ^ (((ob >> 9) & 1) << 5)); }
__host__ __device__ __forceinline__ void stage_rc(int b, int& R, int& C) { const int st = b / 1024, sb = b % 1024, swz = sb ^ (((sb >> 9) & 1) << 5); R = (st >> 1) * 16 + swz / 64; C = (st & 1) * 32 + (swz % 64) / 2; }
__host__ __device__ __forceinline__ int perm32(int rho) { const int n = rho >> 4, i = rho & 15; return 8 * (i >> 2) + 4 * n + (i & 3); }

struct Unit { int pm, pn; };
struct Gemm { const bf16_t* A; const bf16_t* Bt; int M, N, K; };

struct StaticOrder {
    int nM, nN, nwg, G, c;
    __host__ __device__ void init(int M, int N, int G_, int c_) { nM = M / BM; nN = N / BM; nwg = nM * nN; G = G_; c = c_; }
    __host__ __device__ bool next(int i, Unit& u) const {
        const long L = (long)i * G + c; if (L >= nwg) return false;
        int wgid = (int)L; { const int q = nwg / NXCD, r = nwg % NXCD, xcd = wgid % NXCD, off = wgid / NXCD; wgid = (xcd < r ? xcd * (q + 1) : r * (q + 1) + (xcd - r) * q) + off; }
        const int nig = WGM * nN, gid = wgid / nig, fm = gid * WGM, gsz = (nM - fm) < WGM ? (nM - fm) : WGM;
        u.pm = fm + ((wgid % nig) % gsz); u.pn = (wgid % nig) / gsz; return true;
    }
    __device__ __forceinline__ void a_ready(const Unit&) const {}
    __device__ __forceinline__ void done(const Unit&) const {}
};

template <class Epi, class Sched, bool ALIGN_EPI = false, bool SP2 = false>
__device__ __forceinline__ void gemm_phase(PG8_LAS unsigned char* lds, const Gemm g, const Sched& S, const Epi& E) {
    int tid_ = threadIdx.x; asm volatile("" : "+v"(tid_));
    const int tid = tid_, wid = __builtin_amdgcn_readfirstlane(tid >> 6), lane = tid & 63, wr = wid >> 2, wc = wid & 3, fr = lane & 15, fq = lane >> 4;
    const int K = g.K, nt = K / BK;
    unsigned voffA[2], voffB[2];
#pragma unroll
    for (int i = 0; i < 2; ++i) { int R, C; stage_rc(tid * 16 + i * 8192, R, C); const int Rb = Epi::PERM ? ((R & ~31) + perm32(R & 31)) : R;
        voffA[i] = (unsigned)(R * K + C) * 2u; voffB[i] = (unsigned)(Rb * K + C) * 2u; }
    const size_t kstep = (size_t)(BK * 2);
    const size_t hstep = (size_t)HALF * K * 2;
    const size_t tstep = 2 * hstep;
    const unsigned ldsw = (unsigned)wid * 1024u;
    const int aoff = lds_byte(wr * 64 + fr, fq * 8), boff = lds_byte(wc * 32 + fr, fq * 8);
#define PG8_SA(b, h) (((b) * 2 + (h)) * HTB)
#define PG8_SB(b, h) ((4 + (b) * 2 + (h)) * HTB)
#define PG8_STAGE(bufoff, gbase, voff) do { _Pragma("unroll") for (int _i = 0; _i < 2; ++_i) \
        __builtin_amdgcn_global_load_lds((const unsigned*)((const char*)(gbase) + (voff)[_i]), (PG8_LAS unsigned*)(lds + (bufoff) + ldsw + _i * 8192), 16, 0, 0); } while (0)
#define PG8_LDA(dst, b, h) do { _Pragma("unroll") for (int m = 0; m < 4; ++m) _Pragma("unroll") for (int k = 0; k < 2; ++k) dst[m][k] = *(const PG8_LAS bf16x8*)(lds + PG8_SA(b, h) + aoff + m * 2048 + k * 1024); } while (0)
#define PG8_LDB(dst, b, h) do { _Pragma("unroll") for (int n = 0; n < 2; ++n) _Pragma("unroll") for (int k = 0; k < 2; ++k) dst[n][k] = *(const PG8_LAS bf16x8*)(lds + PG8_SB(b, h) + boff + n * 2048 + k * 1024); } while (0)
#define PG8_MMA(ai, bj, At, Bt) do { __builtin_amdgcn_s_setprio(1); _Pragma("unroll") for (int m = 0; m < 4; ++m) _Pragma("unroll") for (int n = 0; n < 2; ++n) _Pragma("unroll") for (int k = 0; k < 2; ++k) \
        acc[ai][bj][m][n] = __builtin_amdgcn_mfma_f32_16x16x32_bf16(Bt[n][k], At[m][k], acc[ai][bj][m][n], 0, 0, 0); __builtin_amdgcn_s_setprio(0); } while (0)
#define PG8_WAIT_V(n) asm volatile("s_waitcnt vmcnt(" #n ")" ::: "memory")
#define PG8_WAIT_L(n) asm volatile("s_waitcnt lgkmcnt(" #n ")" ::: "memory")
#define PG8_BAR __builtin_amdgcn_s_barrier()
#define PG8_SCHED __builtin_amdgcn_sched_barrier(0)
    Unit cur, nxt; int ui = 0;
    if (!S.next(0, cur)) return;
    f32x4 acc[2][2][4][2];
#pragma unroll
    for (int a = 0; a < 2; ++a)
#pragma unroll
        for (int b = 0; b < 2; ++b)
#pragma unroll
            for (int m = 0; m < 4; ++m)
#pragma unroll
                for (int n = 0; n < 2; ++n) acc[a][b][m][n] = (f32x4){0.f, 0.f, 0.f, 0.f};
    bf16x8 At[4][2], B0[2][2], B1[2][2];
    const char* cA = (const char*)g.A + (size_t)cur.pm * tstep; const char* cB = (const char*)g.Bt + (size_t)cur.pn * tstep;
    S.a_ready(cur);
    if constexpr (SP2) {
        PG8_STAGE(PG8_SB(0, 0), cB, voffB); PG8_STAGE(PG8_SB(0, 1), cB + hstep, voffB); PG8_STAGE(PG8_SA(0, 0), cA, voffA); PG8_STAGE(PG8_SA(0, 1), cA + hstep, voffA);
        if (wr == 1) PG8_BAR;
        PG8_WAIT_V(2); PG8_BAR;
        PG8_STAGE(PG8_SB(1, 0), cB + kstep, voffB); PG8_STAGE(PG8_SA(1, 0), cA + kstep, voffA); PG8_STAGE(PG8_SB(1, 1), cB + hstep + kstep, voffB);
        PG8_WAIT_V(6); PG8_BAR;
    } else {
        PG8_STAGE(PG8_SB(0, 0), cB, voffB); PG8_STAGE(PG8_SA(0, 0), cA, voffA); PG8_STAGE(PG8_SB(0, 1), cB + hstep, voffB); PG8_STAGE(PG8_SA(0, 1), cA + hstep, voffA);
        if (wr == 1) PG8_BAR;
        PG8_WAIT_V(4); PG8_BAR;
        PG8_STAGE(PG8_SB(1, 0), cB + kstep, voffB); PG8_STAGE(PG8_SA(1, 0), cA + kstep, voffA); PG8_STAGE(PG8_SB(1, 1), cB + hstep + kstep, voffB);
        PG8_WAIT_V(6); PG8_BAR;
    }
    for (;;) {
        const bool has_next = S.next(ui + 1, nxt);
        const char* nA = has_next ? (const char*)g.A + (size_t)nxt.pm * tstep : cA; const char* nB = has_next ? (const char*)g.Bt + (size_t)nxt.pn * tstep : cB;
        for (int t = 0; t < nt; t += 2) {
            const bool last = (t == nt - 2);
            const char* a1 = cA + (size_t)(t + 1) * kstep;
            const char* a2 = last ? nA : cA + (size_t)(t + 2) * kstep; const char* b2 = last ? nB : cB + (size_t)(t + 2) * kstep;
            const char* a3 = a2 + kstep; const char* b3 = b2 + kstep;
            if (last && has_next) S.a_ready(nxt);
            if constexpr (SP2) {
            PG8_LDB(B0, 0, 0); PG8_LDB(B1, 0, 1); PG8_SCHED; PG8_LDA(At, 0, 0); PG8_STAGE(PG8_SA(1, 1), a1 + hstep, voffA);
            PG8_WAIT_V(8); PG8_WAIT_L(0); PG8_BAR; PG8_MMA(0, 0, At, B0); PG8_MMA(0, 1, At, B1); PG8_BAR; PG8_SCHED;
            PG8_LDA(At, 0, 1); PG8_STAGE(PG8_SB(0, 0), b2, voffB); PG8_STAGE(PG8_SB(0, 1), b2 + hstep, voffB); PG8_STAGE(PG8_SA(0, 0), a2, voffA);
            PG8_WAIT_V(8); PG8_WAIT_L(0); PG8_BAR; PG8_MMA(1, 0, At, B0); PG8_MMA(1, 1, At, B1); PG8_BAR; PG8_SCHED;
            PG8_LDB(B0, 1, 0); PG8_LDB(B1, 1, 1); PG8_SCHED; PG8_LDA(At, 1, 0); PG8_STAGE(PG8_SA(0, 1), a2 + hstep, voffA);
            PG8_WAIT_V(8); PG8_WAIT_L(0); PG8_BAR; PG8_MMA(0, 0, At, B0); PG8_MMA(0, 1, At, B1); PG8_BAR; PG8_SCHED;
            PG8_LDA(At, 1, 1); PG8_STAGE(PG8_SB(1, 0), b3, voffB); PG8_STAGE(PG8_SB(1, 1), b3 + hstep, voffB); PG8_STAGE(PG8_SA(1, 0), a3, voffA);
            PG8_WAIT_V(8); PG8_WAIT_L(0); PG8_BAR; PG8_MMA(1, 0, At, B0); PG8_MMA(1, 1, At, B1); PG8_BAR; PG8_SCHED;
            } else {
            PG8_LDB(B0, 0, 0); PG8_SCHED; PG8_LDA(At, 0, 0); PG8_STAGE(PG8_SA(1, 1), a1 + hstep, voffA);
            PG8_WAIT_L(8); PG8_BAR; PG8_WAIT_L(0); PG8_MMA(0, 0, At, B0); PG8_BAR; PG8_SCHED;
            PG8_LDB(B1, 0, 1); PG8_STAGE(PG8_SB(0, 0), b2, voffB);
            PG8_BAR; PG8_WAIT_L(0); PG8_MMA(0, 1, At, B1); PG8_BAR;
            PG8_LDA(At, 0, 1); PG8_STAGE(PG8_SA(0, 0), a2, voffA);
            PG8_BAR; PG8_WAIT_L(0); PG8_MMA(1, 0, At, B0); PG8_BAR; PG8_SCHED;
            PG8_STAGE(PG8_SB(0, 1), b2 + hstep, voffB);
            PG8_WAIT_V(6); PG8_BAR; PG8_MMA(1, 1, At, B1); PG8_BAR;
            PG8_LDB(B0, 1, 0); PG8_SCHED; PG8_LDA(At, 1, 0); PG8_STAGE(PG8_SA(0, 1), a2 + hstep, voffA);
            PG8_WAIT_L(8); PG8_BAR; PG8_WAIT_L(0); PG8_MMA(0, 0, At, B0); PG8_BAR; PG8_SCHED;
            PG8_LDB(B1, 1, 1); PG8_STAGE(PG8_SB(1, 0), b3, voffB);
            PG8_BAR; PG8_WAIT_L(0); PG8_MMA(0, 1, At, B1); PG8_BAR;
            PG8_LDA(At, 1, 1); PG8_STAGE(PG8_SA(1, 0), a3, voffA);
            PG8_BAR; PG8_WAIT_L(0); PG8_MMA(1, 0, At, B0); PG8_BAR; PG8_SCHED;
            PG8_STAGE(PG8_SB(1, 1), b3 + hstep, voffB);
            PG8_WAIT_V(6); PG8_BAR; PG8_MMA(1, 1, At, B1); PG8_BAR;
            }
        }
        if constexpr (ALIGN_EPI) { if (wr == 0) PG8_BAR; }
        if constexpr (!Epi::AFTER_DRAIN) { E(acc, cur, wr, wc, fr, fq); S.done(cur); }
        if (!has_next) break;
#pragma unroll
        for (int a = 0; a < 2; ++a)
#pragma unroll
            for (int b = 0; b < 2; ++b)
#pragma unroll
                for (int m = 0; m < 4; ++m)
#pragma unroll
                    for (int n = 0; n < 2; ++n) acc[a][b][m][n] = (f32x4){0.f, 0.f, 0.f, 0.f};
        cur = nxt; cA = nA; cB = nB; ++ui;
        if constexpr (ALIGN_EPI) { if (wr == 1) PG8_BAR; }
    }
    PG8_WAIT_V(0);
    if constexpr (!ALIGN_EPI) { if (wr == 0) PG8_BAR; }
    PG8_BAR;
    if constexpr (Epi::AFTER_DRAIN) { E.fused(acc, cur, wr, wc, fr, fq, lds, wid, lane); S.done(cur); }
#undef PG8_SA
#undef PG8_SB
#undef PG8_STAGE
#undef PG8_LDA
#undef PG8_LDB
#undef PG8_MMA
#undef PG8_WAIT_V
#undef PG8_WAIT_L
#undef PG8_BAR
#undef PG8_SCHED
}
}


namespace pg8 {
__device__ __forceinline__ unsigned cvt_pk_bf16(float lo, float hi) { unsigned r; asm volatile("v_cvt_pk_bf16_f32 %0, %1, %2" : "=v"(r) : "v"(lo), "v"(hi)); return r; }
__device__ __forceinline__ float fast_sigmoid(float x) { return __builtin_amdgcn_rcpf(1.f + __expf(-x)); }
__device__ __forceinline__ float fast_silu(float x) { return x * __builtin_amdgcn_rcpf(1.f + __expf(-x)); }
__device__ __forceinline__ float fast_gelu_tanh(float x) { const float u = 0.7978845608028654f * (x + 0.044715f * x * x * x); const float e = __expf(2.f * u); const float th = 1.f - 2.f * __builtin_amdgcn_rcpf(e + 1.f); return 0.5f * x * (1.f + th); }

struct EpiSwiglu {
    static constexpr bool PERM = true, AFTER_DRAIN = false;
    bf16_t* H; int ldh;
    __device__ __forceinline__ void operator()(const f32x4 (&acc)[2][2][4][2], const Unit& u, int wr, int wc, int fr, int fq) const {
        const int row0 = u.pm * BM + wr * 64 + fr, hc0 = u.pn * HALF + wc * 32 + 8 * fq;
#pragma unroll
        for (int ai = 0; ai < 2; ++ai)
#pragma unroll
            for (int m = 0; m < 4; ++m) {
                bf16_t* rowp = H + (size_t)(row0 + ai * HALF + m * 16) * ldh + hc0;
                const f32x4 a0 = acc[ai][0][m][0], a1 = acc[ai][0][m][1], b0 = acc[ai][1][m][0], b1 = acc[ai][1][m][1];
                float h[8];
#pragma unroll
                for (int j = 0; j < 4; ++j) { h[j] = fast_silu(a0[j]) * b0[j]; h[4 + j] = fast_silu(a1[j]) * b1[j]; }
                u32x4 w; w.x = cvt_pk_bf16(h[0], h[1]); w.y = cvt_pk_bf16(h[2], h[3]); w.z = cvt_pk_bf16(h[4], h[5]); w.w = cvt_pk_bf16(h[6], h[7]);
                *(u32x4*)rowp = w;
            }
    }
};
struct EpiResid {
    static constexpr bool PERM = false, AFTER_DRAIN = false;
    const float* src_lat; const float* src_ctx; float* dst_lat; float* dst_ctx; const float* gate_l; float gsc;
    __device__ __forceinline__ void operator()(const f32x4 (&acc)[2][2][4][2], const Unit& u, int wr, int wc, int fr, int fq) const {
        const bool lat = u.pm < 64; const int mi = lat ? (u.pm >> 5) : 2;
        const int rowl = (lat ? u.pm : u.pm - 64) * BM + wr * 64 + fr, col0 = u.pn * BM + wc * 32 + 4 * fq;
        const float* src = (lat ? src_lat : src_ctx) + (size_t)rowl * 1024 + col0; float* dst = (lat ? dst_lat : dst_ctx) + (size_t)rowl * 1024 + col0;
        const float* gp = gate_l + (size_t)mi * 9216 + col0;
#pragma unroll
        for (int bj = 0; bj < 2; ++bj)
#pragma unroll
            for (int n = 0; n < 2; ++n) { const f32x4 g = *(const f32x4*)(gp + bj * HALF + n * 16) * gsc;
#pragma unroll
                for (int ai = 0; ai < 2; ++ai) {
#pragma unroll
                    for (int m = 0; m < 4; ++m) { const size_t ro = (size_t)(ai * HALF + m * 16) * 1024 + bj * HALF + n * 16;
                        const f32x4 b = *(const f32x4*)(src + ro); *(f32x4*)(dst + ro) = b + g * acc[ai][bj][m][n]; }
                    asm volatile("" ::: "memory"); } }
    }
};
struct EpiInproj {
    static constexpr bool PERM = false, AFTER_DRAIN = false;
    bf16_t* P; const float* rope; const float* lb_l;
    __device__ __forceinline__ void operator()(const f32x4 (&acc)[2][2][4][2], const Unit& u, int wr, int wc, int fr, int fq) const {
        const bool lat = u.pm < 64;
        const int row0 = u.pm * BM + wr * 64 + fr, cw = wc * 32 + 4 * fq;
#pragma unroll
        for (int bj = 0; bj < 2; ++bj) {
            const int seg = u.pn * 2 + bj, colb = seg * HALF + cw;
            f32x4 lbv[2] = {(f32x4){0.f, 0.f, 0.f, 0.f}, (f32x4){0.f, 0.f, 0.f, 0.f}};
            if (seg >= 8 && seg < 12) { const int o = (seg - 8) * HALF + cw; lbv[0] = *(const f32x4*)(lb_l + o); lbv[1] = *(const f32x4*)(lb_l + o + 16); }
#pragma unroll
            for (int ai = 0; ai < 2; ++ai)
#pragma unroll
                for (int m = 0; m < 4; ++m) {
                    const int row = row0 + ai * HALF + m * 16;
                    f32x4 v0 = acc[ai][bj][m][0], v1 = acc[ai][bj][m][1];
                    if (seg < 5) {
                        if (lat) { const int t = row & (SEQ - 1); const int pos = (wc & 1) ? (t & 63) : (t >> 6);
                            const f32x4 cs = *(const f32x4*)(rope + pos * 16 + 4 * fq), sn = *(const f32x4*)(rope + 2048 + pos * 16 + 4 * fq);
                            const f32x4 o0 = v0 * cs - v1 * sn, o1 = v1 * cs + v0 * sn; v0 = o0; v1 = o1; }
                        if (seg < 4) { v0 = v0 * 0.125f; v1 = v1 * 0.125f; }
                    } else if (seg == 6 || seg == 7 || seg == 14 || seg == 15) {
#pragma unroll
                        for (int j = 0; j < 4; ++j) { v0[j] = fast_silu(v0[j]); v1[j] = fast_silu(v1[j]); }
                    } else if (seg >= 8 && seg < 12) {
#pragma unroll
                        for (int j = 0; j < 4; ++j) { v0[j] = __logf(lbv[0][j] + (1.f - lbv[0][j]) * fast_sigmoid(v0[j])); v1[j] = __logf(lbv[1][j] + (1.f - lbv[1][j]) * fast_sigmoid(v1[j])); }
                    } else if (seg >= 18) {
#pragma unroll
                        for (int j = 0; j < 4; ++j) { v0[j] = fast_gelu_tanh(v0[j]); v1[j] = fast_gelu_tanh(v1[j]); }
                    }
                    bf16_t* pp = P + (size_t)row * 2560 + colb;
                    *(uint2*)pp = make_uint2(cvt_pk_bf16(v0[0], v0[1]), cvt_pk_bf16(v0[2], v0[3]));
                    *(uint2*)(pp + 16) = make_uint2(cvt_pk_bf16(v1[0], v1[1]), cvt_pk_bf16(v1[2], v1[3]));
                    asm volatile("" ::: "memory");
                }
        }
    }
};
}
#define LAS __attribute__((address_space(3)))
#ifndef PROBE_MASK
#define PROBE_MASK 0
#endif
constexpr int NWAVES = 8, NTHREADS = 512;
constexpr int LDS_BYTES = 147456;
constexpr int LDS_XB = LDS_BYTES - 64;
constexpr size_t CTL_ZERO_BYTES = 64 * 1024;
struct Params { const float* in[26]; float* out; unsigned char* ws; int ph_lo, ph_hi; };
typedef const __attribute__((address_space(4))) Params KParams;
constexpr int PH_PRO_A = 0, PH_PRO_B = 1, PH_LAYER0 = 2, PH_PER_LAYER = 12, N_PHASES = PH_LAYER0 + DEPTH * PH_PER_LAYER;
enum { S_FFN1_IN = 0, S_FFN1_OUT = 1, S_NORM_MIX = 2, S_INPROJ = 3, S_MIX1 = 4, S_MIX2 = 5, S_MIX3 = 6, S_OUTPROJ = 7, S_NORM_FFN2 = 8, S_FFN2_IN = 9, S_FFN2_OUT = 10, S_NEXT_NORM = 11 };


__device__ __forceinline__ void ctx_mini_gemm(LAS unsigned char* lds, const bf16_t* A, const bf16_t* Bt, int K, const float* src_ctx, float* dst_ctx, const float* gate_ctx, float gsc, int bid) {
    int tid_ = threadIdx.x; asm volatile("" : "+v"(tid_)); const int tid = tid_, lane = tid & 63, wid = __builtin_amdgcn_readfirstlane(tid >> 6), fr = lane & 15, fq = lane >> 4;
    const int rg = bid >> 4, cgp = bid & 15, row0 = rg * 32, col0 = cgp * 64;
    const int ksteps = K / 32, per = (ksteps + 7) / 8, ks0 = wid * per, ks1 = (ks0 + per < ksteps) ? ks0 + per : ksteps;
    f32x4 acc[2][4];
#pragma unroll
    for (int i = 0; i < 2; ++i)
#pragma unroll
        for (int j = 0; j < 4; ++j) acc[i][j] = (f32x4){0.f, 0.f, 0.f, 0.f};
    const bf16_t* ap = A + (size_t)(row0 + fr) * K + fq * 8; const bf16_t* bp = Bt + (size_t)(col0 + fr) * K + fq * 8;
#pragma unroll 2
    for (int ks = ks0; ks < ks1; ++ks) {
        bf16x8 a[2], b[4];
#pragma unroll
        for (int i = 0; i < 2; ++i) a[i] = *(const bf16x8*)(ap + (size_t)(i * 16) * K + ks * 32);
#pragma unroll
        for (int j = 0; j < 4; ++j) b[j] = *(const bf16x8*)(bp + (size_t)(j * 16) * K + ks * 32);
#pragma unroll
        for (int i = 0; i < 2; ++i)
#pragma unroll
            for (int j = 0; j < 4; ++j) acc[i][j] = __builtin_amdgcn_mfma_f32_16x16x32_bf16(a[i], b[j], acc[i][j], 0, 0, 0);
    }
    LAS float* part = (LAS float*)lds;
#pragma unroll
    for (int i = 0; i < 2; ++i)
#pragma unroll
        for (int j = 0; j < 4; ++j)
#pragma unroll
            for (int q = 0; q < 4; ++q) part[wid * 2048 + (i * 16 + fq * 4 + q) * 64 + j * 16 + fr] = acc[i][j][q];
    __syncthreads();
    { const int r = tid >> 4, c4 = (tid & 15) * 4; f32x4 s = (f32x4){0.f, 0.f, 0.f, 0.f};
#pragma unroll
      for (int w8 = 0; w8 < 8; ++w8) s += *(const LAS f32x4*)(part + w8 * 2048 + r * 64 + c4);
      const size_t off = (size_t)(row0 + r) * DM + col0 + c4;
      const f32x4 g = *(const f32x4*)(gate_ctx + col0 + c4) * gsc;
      *(f32x4*)(dst_ctx + off) = *(const f32x4*)(src_ctx + off) + g * s; }
    __syncthreads();
}
constexpr int AT_KS = 72;
constexpr int AT_LDS_K = 0, AT_LDS_V = 64 * AT_KS * 2;
constexpr float LOG2E = 1.4426950408889634f;
__device__ __forceinline__ void attn_unit(LAS unsigned char* lds, const bf16_t* P, const float* sink_l, bf16_t* Y, int b, int qblk, int kvh, bool ctxq) {
    int tid_ = threadIdx.x; asm volatile("" : "+v"(tid_));
    const int tid = tid_, lane = tid & 63, wid = __builtin_amdgcn_readfirstlane(tid >> 6), g = wid & 3, th = wid >> 2, h = kvh * 4 + g, l31 = lane & 31, hi = lane >> 5;
    LAS bf16_t* Ks = (LAS bf16_t*)(lds + AT_LDS_K); LAS bf16_t* Vt = (LAS bf16_t*)(lds + AT_LDS_V);
    const int q0w = qblk * 128 + th * 64;
    const size_t rq0 = (ctxq ? (size_t)MLAT + b * CTXL : (size_t)b * SEQ) + q0w;
    bf16x8 Qf[2][4];
#pragma unroll
    for (int qb = 0; qb < 2; ++qb)
#pragma unroll
        for (int s = 0; s < 4; ++s) Qf[qb][s] = *(const bf16x8*)(P + (rq0 + qb * 32 + l31) * INW + C_Q + h * 64 + s * 16 + hi * 8);
    f32x16 O[2][2];
#pragma unroll
    for (int i = 0; i < 2; ++i)
#pragma unroll
        for (int j = 0; j < 2; ++j)
#pragma unroll
            for (int r = 0; r < 16; ++r) O[i][j][r] = 0.f;
    const float sk = sink_l[h] * LOG2E;
    float m[2] = {sk, sk}, ls[2] = {hi == 0 ? 1.f : 0.f, hi == 0 ? 1.f : 0.f};
    const int jbeg = ctxq ? 6 : 0;
    const int lr = tid >> 3, lc = (tid & 7) * 8;
    u32x4 kreg, vreg; int jn = jbeg;
    auto tile_row0 = [&](int j) -> long { if (j >= 6) return (long)MLAT + b * CTXL + (j - 6) * 64; const int kp0 = qblk * 128 - 128 + 64 * j; return (kp0 < 0 || kp0 >= SEQ) ? -1L : (long)b * SEQ + kp0; };
    while (jn < 10 && tile_row0(jn) < 0) ++jn;
    { const long r0 = tile_row0(jn); kreg = *(const u32x4*)(P + (size_t)(r0 + lr) * INW + C_K + kvh * 64 + lc); vreg = *(const u32x4*)(P + (size_t)(r0 + lr) * INW + C_V + kvh * 64 + lc); }
    while (jn < 10) {
        const int j = jn;
        __syncthreads();
        *(LAS u32x4*)(Ks + lr * AT_KS + lc) = kreg;
        { const unsigned vv[4] = {vreg.x, vreg.y, vreg.z, vreg.w};
#pragma unroll
          for (int i = 0; i < 4; ++i) { Vt[(lc + 2 * i) * AT_KS + lr] = (bf16_t)(vv[i] & 0xffffu); Vt[(lc + 2 * i + 1) * AT_KS + lr] = (bf16_t)(vv[i] >> 16); } }
        __syncthreads();
        ++jn; while (jn < 10 && tile_row0(jn) < 0) ++jn;
        if (jn < 10) { const long r0 = tile_row0(jn); kreg = *(const u32x4*)(P + (size_t)(r0 + lr) * INW + C_K + kvh * 64 + lc); vreg = *(const u32x4*)(P + (size_t)(r0 + lr) * INW + C_V + kvh * 64 + lc); }
        const bool local = j < 6; const int kp0 = qblk * 128 - 128 + 64 * j;
        if (local && (kp0 + 63 < q0w - 128 || kp0 > q0w + 63 + 128)) continue;
        f32x16 St[2][2];
#pragma unroll
        for (int kb = 0; kb < 2; ++kb) {
            bf16x8 Kf[4];
#pragma unroll
            for (int s = 0; s < 4; ++s) Kf[s] = *(const LAS bf16x8*)(Ks + (kb * 32 + l31) * AT_KS + s * 16 + hi * 8);
#pragma unroll
            for (int qb = 0; qb < 2; ++qb) {
                f32x16 a;
#pragma unroll
                for (int r = 0; r < 16; ++r) a[r] = 0.f;
#pragma unroll
                for (int s = 0; s < 4; ++s) a = __builtin_amdgcn_mfma_f32_32x32x16_bf16(Kf[s], Qf[qb][s], a, 0, 0, 0);
                St[kb][qb] = a;
            }
        }
        const bool partial = local && (kp0 < q0w + 63 - 128 || kp0 + 63 > q0w + 128);
#pragma unroll
        for (int qb = 0; qb < 2; ++qb) {
            const int qp = q0w + qb * 32 + l31;
            float tmax = -1e30f;
#pragma unroll
            for (int kb = 0; kb < 2; ++kb)
#pragma unroll
                for (int r = 0; r < 16; ++r) {
                    float s = St[kb][qb][r] * LOG2E;
                    if (partial) { const int kp = kp0 + kb * 32 + (r & 3) + 8 * (r >> 2) + 4 * hi; const int dlt = kp - qp; if (dlt > 128 || dlt < -128) s = -1e30f; }
                    St[kb][qb][r] = s; tmax = fmaxf(tmax, s);
                }
            tmax = fmaxf(tmax, __shfl_xor(tmax, 32));
            const float mn = fmaxf(m[qb], tmax), alpha = __builtin_amdgcn_exp2f(m[qb] - mn);
            m[qb] = mn;
            float psum = 0.f;
#pragma unroll
            for (int kb = 0; kb < 2; ++kb)
#pragma unroll
                for (int r = 0; r < 16; ++r) { const float pv = __builtin_amdgcn_exp2f(St[kb][qb][r] - mn); St[kb][qb][r] = pv; psum += pv; }
            ls[qb] = ls[qb] * alpha + psum;
#pragma unroll
            for (int db = 0; db < 2; ++db)
#pragma unroll
                for (int r = 0; r < 16; ++r) O[db][qb][r] *= alpha;
        }
#pragma unroll
        for (int kb = 0; kb < 2; ++kb)
#pragma unroll
            for (int s2 = 0; s2 < 2; ++s2) {
                bf16x8 Pf[2];
#pragma unroll
                for (int qb = 0; qb < 2; ++qb) { u32x4 w; w.x = pg8::cvt_pk_bf16(St[kb][qb][8 * s2 + 0], St[kb][qb][8 * s2 + 1]); w.y = pg8::cvt_pk_bf16(St[kb][qb][8 * s2 + 2], St[kb][qb][8 * s2 + 3]);
                    w.z = pg8::cvt_pk_bf16(St[kb][qb][8 * s2 + 4], St[kb][qb][8 * s2 + 5]); w.w = pg8::cvt_pk_bf16(St[kb][qb][8 * s2 + 6], St[kb][qb][8 * s2 + 7]); Pf[qb] = __builtin_bit_cast(bf16x8, w); }
#pragma unroll
                for (int db = 0; db < 2; ++db) {
                    const LAS bf16_t* vp = Vt + (db * 32 + l31) * AT_KS + kb * 32 + s2 * 16 + 4 * hi;
                    const u32x2 v0 = *(const LAS u32x2*)vp, v1 = *(const LAS u32x2*)(vp + 8);
                    u32x4 vw; vw.x = v0.x; vw.y = v0.y; vw.z = v1.x; vw.w = v1.y; const bf16x8 Vf = __builtin_bit_cast(bf16x8, vw);
#pragma unroll
                    for (int qb = 0; qb < 2; ++qb) O[db][qb] = __builtin_amdgcn_mfma_f32_32x32x16_bf16(Vf, Pf[qb], O[db][qb], 0, 0, 0);
                }
            }
    }
#pragma unroll
    for (int qb = 0; qb < 2; ++qb) {
        const float lt = ls[qb] + __shfl_xor(ls[qb], 32); const float il = 1.f / lt;
        bf16_t* yr = Y + (rq0 + qb * 32 + l31) * DM + h * 64;
#pragma unroll
        for (int db = 0; db < 2; ++db)
#pragma unroll
            for (int i = 0; i < 4; ++i) *(uint2*)(yr + db * 32 + 8 * i + 4 * hi) = make_uint2(pg8::cvt_pk_bf16(O[db][qb][4 * i] * il, O[db][qb][4 * i + 1] * il), pg8::cvt_pk_bf16(O[db][qb][4 * i + 2] * il, O[db][qb][4 * i + 3] * il));
    }
    __syncthreads();
}
__device__ __forceinline__ void chunk_rows(int dir, int b, int j, int& row0, int& t0, int& len, int& seqbase) {
    if (j < 4) { const int n = dir ? 3 - j : j; t0 = 64 * n; len = CTXL; seqbase = MLAT + b * CTXL; }
    else { const int n = dir ? 127 - (j - 4) : j - 4; t0 = 64 * n; len = SEQ; seqbase = b * SEQ; }
    row0 = seqbase + t0;
}
struct RgW { const float* conv_w; const float* conv_b; const float* ga_b; const float* gx_b; const float* lam; const bf16_t* gw; };
constexpr int RG_US = 264;
constexpr int RG_LDS_US = 0, RG_LDS_HS = 64 * RG_US * 2;
template <bool FINAL> __device__ __forceinline__ void rg_item(LAS unsigned char* lds, const bf16_t* P, const RgW w, int b, int isctx, int n, float* RS, const float* RE, bf16_t* Y) {
    int tid_ = threadIdx.x; asm volatile("" : "+v"(tid_));
    const int tid = tid_, lane = tid & 63, wid = __builtin_amdgcn_readfirstlane(tid >> 6);
    LAS bf16_t* Us = (LAS bf16_t*)(lds + RG_LDS_US); LAS float* Hs = (LAS float*)(lds + RG_LDS_HS);
    const int t0 = 64 * n, len = isctx ? CTXL : SEQ, seqbase = isctx ? MLAT + b * CTXL : b * SEQ;
    {
        const int t = tid >> 3, cg = tid & 7, tt = t0 + t;
#pragma unroll
        for (int s8 = 0; s8 < 4; ++s8) {
            const int c0 = cg * 32 + s8 * 8;
            float u[8];
            { const f32x4 b0 = *(const f32x4*)(w.conv_b + c0), b1 = *(const f32x4*)(w.conv_b + c0 + 4); u[0] = b0[0]; u[1] = b0[1]; u[2] = b0[2]; u[3] = b0[3]; u[4] = b1[0]; u[5] = b1[1]; u[6] = b1[2]; u[7] = b1[3]; }
#pragma unroll
            for (int j = 0; j < 4; ++j) { const int ts = tt + j - 2;
                if (ts >= 0 && ts < len) {
                    const u32x4 xr = *(const u32x4*)(P + (size_t)(seqbase + ts) * INW + C_RX + c0);
                    const f32x4 w0 = *(const f32x4*)(w.conv_w + j * 256 + c0), w1 = *(const f32x4*)(w.conv_w + j * 256 + c0 + 4);
                    u[0] += w0[0] * __uint_as_float(xr.x << 16); u[1] += w0[1] * __uint_as_float(xr.x & 0xffff0000u);
                    u[2] += w0[2] * __uint_as_float(xr.y << 16); u[3] += w0[3] * __uint_as_float(xr.y & 0xffff0000u);
                    u[4] += w1[0] * __uint_as_float(xr.z << 16); u[5] += w1[1] * __uint_as_float(xr.z & 0xffff0000u);
                    u[6] += w1[2] * __uint_as_float(xr.w << 16); u[7] += w1[3] * __uint_as_float(xr.w & 0xffff0000u);
                } }
            u32x4 o; o.x = pg8::cvt_pk_bf16(u[0], u[1]); o.y = pg8::cvt_pk_bf16(u[2], u[3]); o.z = pg8::cvt_pk_bf16(u[4], u[5]); o.w = pg8::cvt_pk_bf16(u[6], u[7]);
            *(LAS u32x4*)(Us + t * RG_US + c0) = o;
        }
        if (FINAL) { for (int i = tid; i < 64 * 256 / 4; i += NTHREADS) ((LAS f32x4*)Hs)[i] = (f32x4){0.f, 0.f, 0.f, 0.f}; }
    }
    __syncthreads();
    {
        const int n4 = wid & 3, dir = wid >> 2, e = lane & 15, q4 = lane >> 4;
        const int j = isctx ? (dir ? 3 - n : n) : 4 + (dir ? 127 - n : n);
        bf16x8 Bf[2][4][2];
#pragma unroll
        for (int gt = 0; gt < 2; ++gt)
#pragma unroll
            for (int nb = 0; nb < 4; ++nb)
#pragma unroll
                for (int ks = 0; ks < 2; ++ks) Bf[gt][nb][ks] = *(const bf16x8*)(w.gw + ((size_t)((dir * 2 + gt) * 4 + n4) * 64 + nb * 16 + e) * 64 + ks * 32 + q4 * 8);
        float ba[4], bx[4], sp[4], carry[4], carryA[4];
#pragma unroll
        for (int nb = 0; nb < 4; ++nb) { const int c = n4 * 64 + nb * 16 + e; ba[nb] = w.ga_b[dir * 256 + c]; bx[nb] = w.gx_b[dir * 256 + c]; sp[nb] = log1pf(__expf(-w.lam[dir * 256 + c]));
            carry[nb] = FINAL ? RE[((size_t)(dir * 2 + b) * NCHK + j) * 256 + c] : 0.f; carryA[nb] = 1.f; }
#pragma unroll
        for (int mi = 0; mi < 4; ++mi) {
            const int mb = dir ? 3 - mi : mi;
            bf16x8 Af[2];
#pragma unroll
            for (int ks = 0; ks < 2; ++ks) Af[ks] = *(const LAS bf16x8*)(Us + (mb * 16 + e) * RG_US + n4 * 64 + ks * 32 + q4 * 8);
            float av[4][4], uv[4][4], hv[4][4];
#pragma unroll
            for (int nb = 0; nb < 4; ++nb) {
                f32x4 ar = (f32x4){0.f, 0.f, 0.f, 0.f}, ai = (f32x4){0.f, 0.f, 0.f, 0.f};
#pragma unroll
                for (int ks = 0; ks < 2; ++ks) { ar = __builtin_amdgcn_mfma_f32_16x16x32_bf16(Af[ks], Bf[0][nb][ks], ar, 0, 0, 0); ai = __builtin_amdgcn_mfma_f32_16x16x32_bf16(Af[ks], Bf[1][nb][ks], ai, 0, 0, 0); }
#pragma unroll
                for (int r = 0; r < 4; ++r) {
                    const float uval = bf2f(Us[(mb * 16 + q4 * 4 + r) * RG_US + n4 * 64 + nb * 16 + e]);
                    const float rr = pg8::fast_sigmoid(ar[r] + ba[nb]), ii = pg8::fast_sigmoid(ai[r] + bx[nb]);
                    const float la = -8.f * rr * sp[nb]; const float a = __expf(la);
                    av[nb][r] = a; uv[nb][r] = sqrtf(fmaxf(1.f - a * a, 0.f)) * (ii * uval); hv[nb][r] = 0.f;
                }
            }
#pragma unroll
            for (int qi = 0; qi < 4; ++qi) {
                const int qs = dir ? 3 - qi : qi;
#pragma unroll
                for (int nb = 0; nb < 4; ++nb) {
                    float h = carry[nb], A = carryA[nb], hn[4];
#pragma unroll
                    for (int ri = 0; ri < 4; ++ri) { const float a_ = dir ? av[nb][3 - ri] : av[nb][ri], u_ = dir ? uv[nb][3 - ri] : uv[nb][ri]; h = a_ * h + u_; A *= a_; hn[ri] = h; }
                    if (q4 == qs) {
#pragma unroll
                        for (int r = 0; r < 4; ++r) hv[nb][r] = dir ? hn[3 - r] : hn[r]; }
                    carry[nb] = __shfl(h, qs * 16 + e); if (!FINAL) carryA[nb] = __shfl(A, qs * 16 + e);
                }
            }
            if (FINAL) {
#pragma unroll
                for (int nb = 0; nb < 4; ++nb)
#pragma unroll
                    for (int r = 0; r < 4; ++r) (void)__hip_atomic_fetch_add(Hs + (mb * 16 + q4 * 4 + r) * 256 + n4 * 64 + nb * 16 + e, hv[nb][r], __ATOMIC_RELAXED, __HIP_MEMORY_SCOPE_WORKGROUP);
            }
        }
        if (!FINAL && q4 == 0) {
#pragma unroll
            for (int nb = 0; nb < 4; ++nb) { const int c = n4 * 64 + nb * 16 + e; float* o = RS + (((size_t)(dir * 2 + b) * NCHK + j) * 256 + c) * 2; o[0] = carryA[nb]; o[1] = carry[nb]; }
        }
    }
    if (FINAL) {
        __syncthreads();
        const int t = tid >> 3, cg = tid & 7; const size_t row = (size_t)seqbase + t0 + t;
#pragma unroll
        for (int s8 = 0; s8 < 4; ++s8) { const int c0 = cg * 32 + s8 * 8;
            const u32x4 gr = *(const u32x4*)(P + row * INW + C_RG + c0);
            const f32x4 h0 = *(const LAS f32x4*)(Hs + t * 256 + c0), h1 = *(const LAS f32x4*)(Hs + t * 256 + c0 + 4);
            u32x4 o; o.x = pg8::cvt_pk_bf16(h0[0] * __uint_as_float(gr.x << 16), h0[1] * __uint_as_float(gr.x & 0xffff0000u));
            o.y = pg8::cvt_pk_bf16(h0[2] * __uint_as_float(gr.y << 16), h0[3] * __uint_as_float(gr.y & 0xffff0000u));
            o.z = pg8::cvt_pk_bf16(h1[0] * __uint_as_float(gr.z << 16), h1[1] * __uint_as_float(gr.z & 0xffff0000u));
            o.w = pg8::cvt_pk_bf16(h1[2] * __uint_as_float(gr.w << 16), h1[3] * __uint_as_float(gr.w & 0xffff0000u));
            *(u32x4*)(Y + row * DM + 768 + c0) = o; }
    }
    __syncthreads();
}

constexpr int HG_PS = 65;
__device__ __forceinline__ void hg_load_tile(LAS float* dst, int stride, const bf16_t* P, size_t row0, int col0, int rev, int tid) {
    const int tau = tid >> 3, c8 = (tid & 7) * 8, t = rev ? 63 - tau : tau;
    const u32x4 v = *(const u32x4*)(P + (row0 + t) * INW + col0 + c8);
    LAS float* d = dst + tau * stride + c8;
    d[0] = __uint_as_float(v.x << 16); d[1] = __uint_as_float(v.x & 0xffff0000u); d[2] = __uint_as_float(v.y << 16); d[3] = __uint_as_float(v.y & 0xffff0000u);
    d[4] = __uint_as_float(v.z << 16); d[5] = __uint_as_float(v.z & 0xffff0000u); d[6] = __uint_as_float(v.w << 16); d[7] = __uint_as_float(v.w & 0xffff0000u);
}
__device__ __forceinline__ void hg_cumsum(LAS float* G, LAS float* Km, LAS float* seg, int tid) {
    const int k = tid & 63, sg = tid >> 6;
    float loc[8]; float run = 0.f;
#pragma unroll
    for (int i = 0; i < 8; ++i) { const float g = G[(sg * 8 + i) * HG_PS + k]; Km[(sg * 8 + i) * HG_PS + k] = 1.f - __expf(g); run += g; loc[i] = run; }
    seg[sg * 64 + k] = run;
    __syncthreads();
    float pre = 0.f;
#pragma unroll
    for (int s = 0; s < 8; ++s) { const float v = seg[s * 64 + k]; pre += (s < sg) ? v : 0.f; }
#pragma unroll
    for (int i = 0; i < 8; ++i) G[(sg * 8 + i) * HG_PS + k] = pre + loc[i];
    __syncthreads();
}
constexpr int HGL_G = 0, HGL_K = 64 * HG_PS * 4, HGL_V = 2 * 64 * HG_PS * 4, HGL_SEG = HGL_V + 64 * 64 * 4;
__device__ __forceinline__ void hgrn_local_item(LAS unsigned char* lds, const bf16_t* P, int dir, int b, int h, int j, float* Lbuf, float* Dbuf) {
    int tid_ = threadIdx.x; asm volatile("" : "+v"(tid_)); const int tid = tid_;
    LAS float* G = (LAS float*)(lds + HGL_G); LAS float* Km = (LAS float*)(lds + HGL_K); LAS float* Vs = (LAS float*)(lds + HGL_V); LAS float* seg = (LAS float*)(lds + HGL_SEG);
    int row0, t0, len, seqbase; chunk_rows(dir, b, j, row0, t0, len, seqbase);
    hg_load_tile(G, HG_PS, P, (size_t)row0, (dir ? C_HB : C_HF) + h * 64, dir, tid);
    hg_load_tile(Vs, 64, P, (size_t)row0, C_HI + h * 64, dir, tid);
    __syncthreads();
    hg_cumsum(G, Km, seg, tid);
    { const int k = tid & 63, sg = tid >> 6; const float be = G[63 * HG_PS + k];
#pragma unroll
      for (int i = 0; i < 8; ++i) { const int tau = sg * 8 + i; Km[tau * HG_PS + k] *= __expf(be - G[tau * HG_PS + k]); }
      if (sg == 0) Dbuf[((size_t)((dir * 2 + b) * 4 + h) * NCHK + j) * 64 + k] = __expf(be); }
    __syncthreads();
    { const int k = tid >> 3, v0 = (tid & 7) * 8; f32x4 a0 = (f32x4){0.f, 0.f, 0.f, 0.f}, a1 = a0;
#pragma unroll 8
      for (int s = 0; s < 64; ++s) { const float kh = Km[s * HG_PS + k]; a0 += kh * *(const LAS f32x4*)(Vs + s * 64 + v0); a1 += kh * *(const LAS f32x4*)(Vs + s * 64 + v0 + 4); }
      float* o = Lbuf + ((size_t)((dir * 2 + b) * 4 + h) * NCHK + j) * 4096 + k * 64 + v0; *(f32x4*)o = a0; *(f32x4*)(o + 4) = a1; }
    __syncthreads();
}
__device__ __forceinline__ void hgrn_state_scan(int chain, int elem, float* Lbuf, const float* Dbuf) {
    float* lp = Lbuf + (size_t)chain * NCHK * 4096 + elem; const float* dp = Dbuf + (size_t)chain * NCHK * 64 + (elem >> 6);
    float S = 0.f;
    for (int j0 = 0; j0 < NCHK; j0 += 33) {
        float Lv[33], dv[33];
#pragma unroll
        for (int i = 0; i < 33; ++i) { Lv[i] = lp[(size_t)(j0 + i) * 4096]; dv[i] = dp[(size_t)(j0 + i) * 64]; }
#pragma unroll
        for (int i = 0; i < 33; ++i) { lp[(size_t)(j0 + i) * 4096] = S; S = dv[i] * S + Lv[i]; }
    }
}
constexpr int HGO_Q = 0, HGO_B = 64 * HG_PS * 4, HGO_K = 2 * 64 * HG_PS * 4, HGO_A = 3 * 64 * HG_PS * 4, HGO_V = 4 * 64 * HG_PS * 4, HGO_S = HGO_V + 16384, HGO_O = HGO_S + 16384, HGO_SEG = HGO_O + 16384;
__device__ __forceinline__ void hgrn_out_item(LAS unsigned char* lds, const bf16_t* P, const float* hg_norm_l, int b, int h, int isctx, int n, const float* Lbuf, bf16_t* Y) {
    int tid_ = threadIdx.x; asm volatile("" : "+v"(tid_)); const int tid = tid_;
    LAS float* Qs = (LAS float*)(lds + HGO_Q); LAS float* Bc = (LAS float*)(lds + HGO_B); LAS float* Km = (LAS float*)(lds + HGO_K); LAS float* At = (LAS float*)(lds + HGO_A);
    LAS float* Vs = (LAS float*)(lds + HGO_V); LAS float* S0 = (LAS float*)(lds + HGO_S); LAS float* Os = (LAS float*)(lds + HGO_O); LAS float* seg = (LAS float*)(lds + HGO_SEG);
    const size_t row0 = (isctx ? (size_t)MLAT + b * CTXL : (size_t)b * SEQ) + 64 * n;
    for (int dir = 0; dir < 2; ++dir) {
        const int j = isctx ? (dir ? 3 - n : n) : 4 + (dir ? 127 - n : n);
        hg_load_tile(Qs, HG_PS, P, row0, C_HQ + h * 64, dir, tid);
        hg_load_tile(Bc, HG_PS, P, row0, (dir ? C_HB : C_HF) + h * 64, dir, tid);
        hg_load_tile(Vs, 64, P, row0, C_HI + h * 64, dir, tid);
        { const float* sp = Lbuf + ((size_t)((dir * 2 + b) * 4 + h) * NCHK + j) * 4096;
#pragma unroll
          for (int i = 0; i < 2; ++i) *(LAS f32x4*)(S0 + (tid + i * NTHREADS) * 4) = *(const f32x4*)(sp + (tid + i * NTHREADS) * 4); }
        __syncthreads();
        hg_cumsum(Bc, Km, seg, tid);
        { const int tau = tid >> 3, s0 = tid & 7; float acc[8];
#pragma unroll
          for (int i = 0; i < 8; ++i) acc[i] = 0.f;
          for (int k = 0; k < 64; ++k) { const float q = Qs[tau * HG_PS + k], bt = Bc[tau * HG_PS + k];
#pragma unroll
              for (int i = 0; i < 8; ++i) { const int sg = s0 + 8 * i; acc[i] += q * Km[sg * HG_PS + k] * __expf(fminf(bt - Bc[sg * HG_PS + k], 0.f)); } }
#pragma unroll
          for (int i = 0; i < 8; ++i) { const int sg = s0 + 8 * i; At[tau * HG_PS + sg] = sg <= tau ? acc[i] : 0.f; } }
        __syncthreads();
        { const int tau = tid >> 3, v0 = (tid & 7) * 8; f32x4 a0 = (f32x4){0.f, 0.f, 0.f, 0.f}, a1 = a0;
#pragma unroll 4
          for (int k = 0; k < 64; ++k) { const float qe = Qs[tau * HG_PS + k] * __expf(Bc[tau * HG_PS + k]); a0 += qe * *(const LAS f32x4*)(S0 + k * 64 + v0); a1 += qe * *(const LAS f32x4*)(S0 + k * 64 + v0 + 4); }
          for (int s = 0; s <= tau; ++s) { const float a = At[tau * HG_PS + s]; a0 += a * *(const LAS f32x4*)(Vs + s * 64 + v0); a1 += a * *(const LAS f32x4*)(Vs + s * 64 + v0 + 4); }
          const int t = dir ? 63 - tau : tau; LAS float* o = Os + t * 64 + v0;
          if (dir == 0) { *(LAS f32x4*)o = a0; *(LAS f32x4*)(o + 4) = a1; } else { *(LAS f32x4*)o = *(LAS f32x4*)o + a0; *(LAS f32x4*)(o + 4) = *(LAS f32x4*)(o + 4) + a1; } }
        __syncthreads();
    }
    { const int t = tid >> 3, v0 = (tid & 7) * 8; const f32x4 o0 = *(const LAS f32x4*)(Os + t * 64 + v0), o1 = *(const LAS f32x4*)(Os + t * 64 + v0 + 4);
      float ss = o0[0] * o0[0] + o0[1] * o0[1] + o0[2] * o0[2] + o0[3] * o0[3] + o1[0] * o1[0] + o1[1] * o1[1] + o1[2] * o1[2] + o1[3] * o1[3];
      ss += __shfl_xor(ss, 1); ss += __shfl_xor(ss, 2); ss += __shfl_xor(ss, 4);
      const float rs = rsqrtf(ss * (1.f / 64.f) + EPS);
      const f32x4 g0 = *(const f32x4*)(hg_norm_l + h * 64 + v0), g1 = *(const f32x4*)(hg_norm_l + h * 64 + v0 + 4);
      const u32x4 gt = *(const u32x4*)(P + (row0 + t) * INW + C_HG + h * 64 + v0);
      u32x4 w; w.x = pg8::cvt_pk_bf16(o0[0] * rs * g0[0] * __uint_as_float(gt.x << 16), o0[1] * rs * g0[1] * __uint_as_float(gt.x & 0xffff0000u));
      w.y = pg8::cvt_pk_bf16(o0[2] * rs * g0[2] * __uint_as_float(gt.y << 16), o0[3] * rs * g0[3] * __uint_as_float(gt.y & 0xffff0000u));
      w.z = pg8::cvt_pk_bf16(o1[0] * rs * g1[0] * __uint_as_float(gt.z << 16), o1[1] * rs * g1[1] * __uint_as_float(gt.z & 0xffff0000u));
      w.w = pg8::cvt_pk_bf16(o1[2] * rs * g1[2] * __uint_as_float(gt.w << 16), o1[3] * rs * g1[3] * __uint_as_float(gt.w & 0xffff0000u));
      *(u32x4*)(Y + (row0 + t) * DM + 512 + h * 64 + v0) = w; }
    __syncthreads();
}

constexpr int HM_RS = 72;
constexpr int HM_QD = 0, HM_KU = 9216, HM_QEH = 18432, HM_KDH = 23040, HM_VT = 27648, HM_S0T = 36864, HM_DIR = 46080;
constexpr int HM_TMP = 2 * HM_DIR, HM_BC = HM_TMP, HM_KM = HM_TMP + 64 * HG_PS * 4, HM_SEG = HM_KM + 64 * HG_PS * 4, HM_O0 = HM_TMP, HM_O1 = HM_TMP + 16384;
__device__ __forceinline__ void hgrn_out_item_mfma(LAS unsigned char* lds, const bf16_t* P, const float* hg_norm_l, int b, int h, int isctx, int n, const float* Lbuf, bf16_t* Y) {
    int tid_ = threadIdx.x; asm volatile("" : "+v"(tid_)); const int tid = tid_, lane = tid & 63, wid = __builtin_amdgcn_readfirstlane(tid >> 6), l31 = lane & 31, hi = lane >> 5;
    const size_t row0 = (isctx ? (size_t)MLAT + b * CTXL : (size_t)b * SEQ) + 64 * n;
    LAS float* Bc = (LAS float*)(lds + HM_BC); LAS float* Km = (LAS float*)(lds + HM_KM); LAS float* seg = (LAS float*)(lds + HM_SEG);
    for (int dir = 0; dir < 2; ++dir) {
        LAS unsigned char* base = lds + dir * HM_DIR;
        const int j = isctx ? (dir ? 3 - n : n) : 4 + (dir ? 127 - n : n);
        hg_load_tile(Bc, HG_PS, P, row0, (dir ? C_HB : C_HF) + h * 64, dir, tid);
        __syncthreads();
        hg_cumsum(Bc, Km, seg, tid);
        {
            const int tau = tid >> 3, c8 = (tid & 7) * 8, t = dir ? 63 - tau : tau, I = tau >> 5;
            const u32x4 qv = *(const u32x4*)(P + (row0 + t) * INW + C_HQ + h * 64 + c8);
            const u32x4 vv = *(const u32x4*)(P + (row0 + t) * INW + C_HI + h * 64 + c8);
            const unsigned qw[4] = {qv.x, qv.y, qv.z, qv.w};
            float qd[8], ku[8], xx[8];
#pragma unroll
            for (int i = 0; i < 8; ++i) {
                const float q = (i & 1) ? __uint_as_float(qw[i >> 1] & 0xffff0000u) : __uint_as_float(qw[i >> 1] << 16);
                const float bt = Bc[tau * HG_PS + c8 + i], c1 = Bc[31 * HG_PS + c8 + i], km = Km[tau * HG_PS + c8 + i];
                const float cI = I ? c1 : 0.f;
                qd[i] = q * __expf(bt - cI); ku[i] = km * __expf(fminf(cI - bt, 80.f));
                xx[i] = I ? q * __expf(bt) : km * __expf(c1 - bt);
            }
            u32x4 w;
            w.x = pg8::cvt_pk_bf16(qd[0], qd[1]); w.y = pg8::cvt_pk_bf16(qd[2], qd[3]); w.z = pg8::cvt_pk_bf16(qd[4], qd[5]); w.w = pg8::cvt_pk_bf16(qd[6], qd[7]);
            *(LAS u32x4*)(base + HM_QD + (tau * HM_RS + c8) * 2) = w;
            w.x = pg8::cvt_pk_bf16(ku[0], ku[1]); w.y = pg8::cvt_pk_bf16(ku[2], ku[3]); w.z = pg8::cvt_pk_bf16(ku[4], ku[5]); w.w = pg8::cvt_pk_bf16(ku[6], ku[7]);
            *(LAS u32x4*)(base + HM_KU + (tau * HM_RS + c8) * 2) = w;
            w.x = pg8::cvt_pk_bf16(xx[0], xx[1]); w.y = pg8::cvt_pk_bf16(xx[2], xx[3]); w.z = pg8::cvt_pk_bf16(xx[4], xx[5]); w.w = pg8::cvt_pk_bf16(xx[6], xx[7]);
            *(LAS u32x4*)(base + (I ? HM_QEH : HM_KDH) + ((tau & 31) * HM_RS + c8) * 2) = w;
            LAS bf16_t* Vt = (LAS bf16_t*)(base + HM_VT);
            const unsigned vw[4] = {vv.x, vv.y, vv.z, vv.w};
#pragma unroll
            for (int i = 0; i < 4; ++i) { Vt[(c8 + 2 * i) * HM_RS + tau] = (bf16_t)(vw[i] & 0xffffu); Vt[(c8 + 2 * i + 1) * HM_RS + tau] = (bf16_t)(vw[i] >> 16); }
            const int k = tid >> 3, v8 = (tid & 7) * 8;
            const float* sp = Lbuf + ((size_t)((dir * 2 + b) * 4 + h) * NCHK + j) * 4096 + k * 64 + v8;
            const f32x4 s0 = *(const f32x4*)sp, s1 = *(const f32x4*)(sp + 4);
            LAS bf16_t* S0t = (LAS bf16_t*)(base + HM_S0T);
#pragma unroll
            for (int i = 0; i < 4; ++i) { S0t[(v8 + i) * HM_RS + k] = f2bf(s0[i]); S0t[(v8 + 4 + i) * HM_RS + k] = f2bf(s1[i]); }
        }
        __syncthreads();
    }
    {
        const int dir = wid >> 2, vblk = (wid >> 1) & 1, tblk = wid & 1;
        LAS unsigned char* base = lds + dir * HM_DIR;
        const LAS bf16_t* QD = (const LAS bf16_t*)(base + HM_QD); const LAS bf16_t* KU = (const LAS bf16_t*)(base + HM_KU); const LAS bf16_t* QEH = (const LAS bf16_t*)(base + HM_QEH);
        const LAS bf16_t* KDH = (const LAS bf16_t*)(base + HM_KDH); const LAS bf16_t* Vt = (const LAS bf16_t*)(base + HM_VT); const LAS bf16_t* S0t = (const LAS bf16_t*)(base + HM_S0T);
        f32x16 O;
#pragma unroll
        for (int r = 0; r < 16; ++r) O[r] = 0.f;
        bf16x8 Qf[4];
#pragma unroll
        for (int s = 0; s < 4; ++s) Qf[s] = *(const LAS bf16x8*)(QD + (tblk * 32 + l31) * HM_RS + s * 16 + hi * 8);
#pragma unroll
        for (int s = 0; s < 4; ++s) {
            const bf16x8 Af = *(const LAS bf16x8*)(S0t + (vblk * 32 + l31) * HM_RS + s * 16 + hi * 8);
            const bf16x8 Bf = tblk ? *(const LAS bf16x8*)(QEH + l31 * HM_RS + s * 16 + hi * 8) : Qf[s];
            O = __builtin_amdgcn_mfma_f32_32x32x16_bf16(Af, Bf, O, 0, 0, 0);
        }
#pragma unroll
        for (int sbi = 0; sbi < 2; ++sbi) {
            if (sbi > tblk) break;
            const bool diag = sbi == tblk;
            f32x16 St;
#pragma unroll
            for (int r = 0; r < 16; ++r) St[r] = 0.f;
#pragma unroll
            for (int s = 0; s < 4; ++s) {
                const bf16x8 Af = diag ? *(const LAS bf16x8*)(KU + (sbi * 32 + l31) * HM_RS + s * 16 + hi * 8) : *(const LAS bf16x8*)(KDH + l31 * HM_RS + s * 16 + hi * 8);
                St = __builtin_amdgcn_mfma_f32_32x32x16_bf16(Af, Qf[s], St, 0, 0, 0);
            }
            if (diag) {
#pragma unroll
                for (int r = 0; r < 16; ++r) { const int sg = (r & 3) + 8 * (r >> 2) + 4 * hi; if (sg > l31) St[r] = 0.f; }
            }
#pragma unroll
            for (int s2 = 0; s2 < 2; ++s2) {
                u32x4 w; w.x = pg8::cvt_pk_bf16(St[8 * s2 + 0], St[8 * s2 + 1]); w.y = pg8::cvt_pk_bf16(St[8 * s2 + 2], St[8 * s2 + 3]); w.z = pg8::cvt_pk_bf16(St[8 * s2 + 4], St[8 * s2 + 5]); w.w = pg8::cvt_pk_bf16(St[8 * s2 + 6], St[8 * s2 + 7]);
                const bf16x8 Pf = __builtin_bit_cast(bf16x8, w);
                const LAS bf16_t* vp = Vt + (vblk * 32 + l31) * HM_RS + sbi * 32 + s2 * 16 + 4 * hi;
                const u32x2 v0 = *(const LAS u32x2*)vp, v1 = *(const LAS u32x2*)(vp + 8);
                u32x4 vw; vw.x = v0.x; vw.y = v0.y; vw.z = v1.x; vw.w = v1.y;
                O = __builtin_amdgcn_mfma_f32_32x32x16_bf16(__builtin_bit_cast(bf16x8, vw), Pf, O, 0, 0, 0);
            }
        }
        __syncthreads();
        LAS float* Od = (LAS float*)(lds + (dir ? HM_O1 : HM_O0));
        const int tau = tblk * 32 + l31, t = dir ? 63 - tau : tau;
#pragma unroll
        for (int i = 0; i < 4; ++i) *(LAS f32x4*)(Od + t * 64 + vblk * 32 + 8 * i + 4 * hi) = (f32x4){O[4 * i], O[4 * i + 1], O[4 * i + 2], O[4 * i + 3]};
    }
    __syncthreads();
    { const LAS float* O0 = (const LAS float*)(lds + HM_O0); const LAS float* O1 = (const LAS float*)(lds + HM_O1);
      const int t = tid >> 3, v0 = (tid & 7) * 8; const f32x4 o0 = *(const LAS f32x4*)(O0 + t * 64 + v0) + *(const LAS f32x4*)(O1 + t * 64 + v0), o1 = *(const LAS f32x4*)(O0 + t * 64 + v0 + 4) + *(const LAS f32x4*)(O1 + t * 64 + v0 + 4);
      float ss = o0[0] * o0[0] + o0[1] * o0[1] + o0[2] * o0[2] + o0[3] * o0[3] + o1[0] * o1[0] + o1[1] * o1[1] + o1[2] * o1[2] + o1[3] * o1[3];
      ss += __shfl_xor(ss, 1); ss += __shfl_xor(ss, 2); ss += __shfl_xor(ss, 4);
      const float rs = rsqrtf(ss * (1.f / 64.f) + EPS);
      const f32x4 g0 = *(const f32x4*)(hg_norm_l + h * 64 + v0), g1 = *(const f32x4*)(hg_norm_l + h * 64 + v0 + 4);
      const u32x4 gt = *(const u32x4*)(P + (row0 + t) * INW + C_HG + h * 64 + v0);
      u32x4 w; w.x = pg8::cvt_pk_bf16(o0[0] * rs * g0[0] * __uint_as_float(gt.x << 16), o0[1] * rs * g0[1] * __uint_as_float(gt.x & 0xffff0000u));
      w.y = pg8::cvt_pk_bf16(o0[2] * rs * g0[2] * __uint_as_float(gt.y << 16), o0[3] * rs * g0[3] * __uint_as_float(gt.y & 0xffff0000u));
      w.z = pg8::cvt_pk_bf16(o1[0] * rs * g1[0] * __uint_as_float(gt.z << 16), o1[1] * rs * g1[1] * __uint_as_float(gt.z & 0xffff0000u));
      w.w = pg8::cvt_pk_bf16(o1[2] * rs * g1[2] * __uint_as_float(gt.w << 16), o1[3] * rs * g1[3] * __uint_as_float(gt.w & 0xffff0000u));
      *(u32x4*)(Y + (row0 + t) * DM + 512 + h * 64 + v0) = w; }
    __syncthreads();
}

constexpr int HLM_BC = 0, HLM_KM = 64 * HG_PS * 4, HLM_SEG = 2 * 64 * HG_PS * 4, HLM_KET = HLM_SEG + 2048, HLM_VT = HLM_KET + 64 * HM_RS * 2;
__device__ __forceinline__ void hgrn_local_phase_mfma(LAS unsigned char* lds, const bf16_t* P, float* Lbuf, float* Dbuf, int bid, int G) {
    int tid_ = threadIdx.x; asm volatile("" : "+v"(tid_)); const int tid = tid_, lane = tid & 63, wid = __builtin_amdgcn_readfirstlane(tid >> 6), l31 = lane & 31, hi = lane >> 5;
    LAS float* Bc = (LAS float*)(lds + HLM_BC); LAS float* Km = (LAS float*)(lds + HLM_KM); LAS float* seg = (LAS float*)(lds + HLM_SEG);
    LAS bf16_t* KEt = (LAS bf16_t*)(lds + HLM_KET); LAS bf16_t* Vt = (LAS bf16_t*)(lds + HLM_VT);
    const int tau = tid >> 3, c8 = (tid & 7) * 8, total = 16 * NCHK;
    u32x4 gq = (u32x4){0u, 0u, 0u, 0u}, vq = gq;
    int it = bid;
    if (it < total) { const int chain = it / NCHK, j = it % NCHK, dir = chain >> 3, b = (chain >> 2) & 1, h = chain & 3; int row0, t0, len, sb; chunk_rows(dir, b, j, row0, t0, len, sb);
        const int t = dir ? 63 - tau : tau; gq = *(const u32x4*)(P + (size_t)(row0 + t) * INW + (dir ? C_HB : C_HF) + h * 64 + c8); vq = *(const u32x4*)(P + (size_t)(row0 + t) * INW + C_HI + h * 64 + c8); }
    while (it < total) {
        const int chain = it / NCHK, j = it % NCHK;
        { LAS float* d = Bc + tau * HG_PS + c8;
          d[0] = __uint_as_float(gq.x << 16); d[1] = __uint_as_float(gq.x & 0xffff0000u); d[2] = __uint_as_float(gq.y << 16); d[3] = __uint_as_float(gq.y & 0xffff0000u);
          d[4] = __uint_as_float(gq.z << 16); d[5] = __uint_as_float(gq.z & 0xffff0000u); d[6] = __uint_as_float(gq.w << 16); d[7] = __uint_as_float(gq.w & 0xffff0000u);
          const unsigned vw[4] = {vq.x, vq.y, vq.z, vq.w};
#pragma unroll
          for (int i = 0; i < 4; ++i) { Vt[(c8 + 2 * i) * HM_RS + tau] = (bf16_t)(vw[i] & 0xffffu); Vt[(c8 + 2 * i + 1) * HM_RS + tau] = (bf16_t)(vw[i] >> 16); } }
        const int nx = it + G;
        if (nx < total) { const int chain2 = nx / NCHK, j2 = nx % NCHK, dir = chain2 >> 3, b = (chain2 >> 2) & 1, h = chain2 & 3; int row0, t0, len, sb; chunk_rows(dir, b, j2, row0, t0, len, sb);
            const int t = dir ? 63 - tau : tau; gq = *(const u32x4*)(P + (size_t)(row0 + t) * INW + (dir ? C_HB : C_HF) + h * 64 + c8); vq = *(const u32x4*)(P + (size_t)(row0 + t) * INW + C_HI + h * 64 + c8); }
        __syncthreads();
        hg_cumsum(Bc, Km, seg, tid);
        { const int k = tid & 63, sg = tid >> 6; const float be = Bc[63 * HG_PS + k]; float ke[8];
#pragma unroll
          for (int i = 0; i < 8; ++i) { const int s = sg * 8 + i; ke[i] = Km[s * HG_PS + k] * __expf(be - Bc[s * HG_PS + k]); }
          u32x4 w; w.x = pg8::cvt_pk_bf16(ke[0], ke[1]); w.y = pg8::cvt_pk_bf16(ke[2], ke[3]); w.z = pg8::cvt_pk_bf16(ke[4], ke[5]); w.w = pg8::cvt_pk_bf16(ke[6], ke[7]);
          *(LAS u32x4*)(KEt + k * HM_RS + sg * 8) = w;
          if (sg == 0) Dbuf[((size_t)chain * NCHK + j) * 64 + k] = __expf(be); }
        __syncthreads();
        if (wid < 4) {
            const int kblk = wid >> 1, vblk = wid & 1;
            f32x16 acc;
#pragma unroll
            for (int r = 0; r < 16; ++r) acc[r] = 0.f;
#pragma unroll
            for (int s = 0; s < 4; ++s) { const bf16x8 Af = *(const LAS bf16x8*)(KEt + (kblk * 32 + l31) * HM_RS + s * 16 + hi * 8), Bf = *(const LAS bf16x8*)(Vt + (vblk * 32 + l31) * HM_RS + s * 16 + hi * 8);
                acc = __builtin_amdgcn_mfma_f32_32x32x16_bf16(Af, Bf, acc, 0, 0, 0); }
            float* o = Lbuf + ((size_t)chain * NCHK + j) * 4096 + vblk * 32 + l31;
#pragma unroll
            for (int r = 0; r < 16; ++r) o[(kblk * 32 + (r & 3) + 8 * (r >> 2) + 4 * hi) * 64] = acc[r];
        }
        __syncthreads();
        it = nx;
    }
}
__device__ __forceinline__ void rg_carry_scan(int gt, const float* RS, float* RE) {
    const int c = gt & 255, db = gt >> 8;
    const float* rs = RS + ((size_t)db * NCHK * 256 + c) * 2; float* re = RE + (size_t)db * NCHK * 256 + c;
    float h = 0.f;
    for (int j0 = 0; j0 < NCHK; j0 += 33) {
        float A[33], Hl[33];
#pragma unroll
        for (int i = 0; i < 33; ++i) { const float2 v = *(const float2*)(rs + (size_t)(j0 + i) * 512); A[i] = v.x; Hl[i] = v.y; }
#pragma unroll
        for (int i = 0; i < 33; ++i) { re[(size_t)(j0 + i) * 256] = h; h = A[i] * h + Hl[i]; }
    }
}
__device__ __forceinline__ void rg_gate_weights_prep(const float* ga_w, const float* gx_w, bf16_t* gw_all, int bid, int G, int tid) {
    const int total = DEPTH * 2 * 2 * 4 * 64 * 64;
    for (int i = bid * NTHREADS + tid; i < total; i += G * NTHREADS) {
        const int d = i & 63, e = (i >> 6) & 63, n4 = (i >> 12) & 3, gt = (i >> 14) & 1, dir = (i >> 15) & 1, l = i >> 16;
        const float* srcw = gt ? gx_w : ga_w;
        gw_all[i] = f2bf(srcw[((((size_t)l * 2 + dir) * 4 + n4) * 64 + d) * 64 + e]);
    }
}

#define XB_TMO      128
#define XB_XCNT(j)  (256  + 64 * (j))
#define XB_XSUB(j)  (1280 + 64 * (j))
#define XB_XGEN(j)  (2304 + 64 * (j))
#define XB_TOP      3328
#define XB_TOPGEN   3392
#define XCD_BAR_WORDS 3456
#define XB_SPIN_CAP (1u << 18)

__device__ __forceinline__ unsigned xb_ld(unsigned* p)              { return __hip_atomic_load(p, __ATOMIC_RELAXED, __HIP_MEMORY_SCOPE_AGENT); }
__device__ __forceinline__ unsigned xb_add(unsigned* p, unsigned v) { return __hip_atomic_fetch_add(p, v, __ATOMIC_RELAXED, __HIP_MEMORY_SCOPE_AGENT); }
__device__ __forceinline__ unsigned xb_xcc_id() { return (unsigned)__builtin_amdgcn_s_getreg((3 << 11) | 20) & 0xFu; }
#define XB_SPIN(cond, bar) do { unsigned _sp = 0; while (cond) { __builtin_amdgcn_s_sleep(1); \
    if ((++_sp & 255u) == 0u) { if (xb_ld(&(bar)[XB_TMO])) break; if (_sp > XB_SPIN_CAP) { atomicAdd(&(bar)[XB_TMO], 1u); break; } } } } while (0)

struct XcdBarrier {
    unsigned* bar; unsigned x;
    volatile LAS unsigned* st;
};

__device__ __forceinline__ XcdBarrier xcd_barrier_post(unsigned* bar, volatile LAS unsigned* st) {
    XcdBarrier b; b.bar = bar; b.x = xb_xcc_id(); b.st = st;
    if (threadIdx.x == 0) (void)xb_add(&bar[XB_XCNT(b.x)], 1u);
    return b;
}
__device__ __forceinline__ void xcd_barrier_complete(unsigned* bar, unsigned x, unsigned& nloc, unsigned& nx) {
    const unsigned G = gridDim.x * gridDim.y * gridDim.z;
    unsigned sum, cnt, mine, sp = 0u;
    for (;;) {
        sum = 0u; cnt = 0u; mine = 0u;
#pragma unroll
        for (unsigned j = 0; j < 16; ++j) { const unsigned c = xb_ld(&bar[XB_XCNT(j)]); sum += c; cnt += (c > 0u) ? 1u : 0u; mine = (j == x) ? c : mine; }
        if (sum == G) break;
        __builtin_amdgcn_s_sleep(1);
        if ((++sp & 255u) == 0u) { if (xb_ld(&bar[XB_TMO])) break; if (sp > XB_SPIN_CAP) { atomicAdd(&bar[XB_TMO], 1u); break; } }
    }
    nloc = mine > 0u ? mine : 1u; nx = cnt > 0u ? cnt : 1u;
}

__device__ __forceinline__ void xcd_barrier(const XcdBarrier& b) {
    asm volatile("s_waitcnt vmcnt(0)" ::: "memory");
    __syncthreads();
    if (threadIdx.x == 0) {
        unsigned* bar = b.bar;
        __builtin_amdgcn_s_waitcnt(0);
        unsigned nloc = b.st[0], nx = b.st[1];
        if (nloc == 0u) { xcd_barrier_complete(bar, b.x, nloc, nx); b.st[0] = nloc; b.st[1] = nx; }
        const unsigned old = xb_add(&bar[XB_XSUB(b.x)], 1u);
        const unsigned gen = old / nloc;
        if (old + 1u == (gen + 1u) * nloc) {
            __builtin_amdgcn_fence(__ATOMIC_RELEASE, "agent");
            asm volatile("s_waitcnt vmcnt(0)" ::: "memory");
            const unsigned og = xb_add(&bar[XB_TOP], 1u);
            const unsigned tg = og / nx;
            if (og + 1u == (tg + 1u) * nx) xb_add(&bar[XB_TOPGEN], 1u);
            else XB_SPIN(xb_ld(&bar[XB_TOPGEN]) == tg, bar);
            __builtin_amdgcn_fence(__ATOMIC_ACQUIRE, "agent");
            xb_add(&bar[XB_XGEN(b.x)], 1u);
            asm volatile("s_waitcnt vmcnt(0)" ::: "memory");
        } else {
            XB_SPIN(xb_ld(&bar[XB_XGEN(b.x)]) == gen, bar);
            __builtin_amdgcn_fence(__ATOMIC_ACQUIRE, "agent");
            asm volatile("s_waitcnt vmcnt(0)" ::: "memory");
        }
    }
    __syncthreads();
}

__device__ __forceinline__ void ph_normmod(const float* xlat, const float* xctx, const float* g, const float* mods_l, int i_shift, int i_scale, bf16_t* XN, int nrows) {
    int tid_ = threadIdx.x; asm volatile("" : "+v"(tid_));
    int bid_ = blockIdx.x, G_ = gridDim.x; asm volatile("" : "+s"(bid_), "+s"(G_));
    const int lane = tid_ & 63, gw = bid_ * NWAVES + (tid_ >> 6), ngw = G_ * NWAVES;
    for (int row = gw; row < nrows; row += ngw) {
        const float* xr = row < MLAT ? xlat + (size_t)row * DM : xctx + (size_t)(row - MLAT) * DM;
        const int mi = row < MLAT ? row / SEQ : 2;
        const float* sh = mods_l + (size_t)mi * NMODS * DM + i_shift * DM; const float* sc = mods_l + (size_t)mi * NMODS * DM + i_scale * DM;
        f32x4 v[4]; float ss = 0.f;
#pragma unroll
        for (int j = 0; j < 4; ++j) { v[j] = *(const f32x4*)(xr + 256 * j + 4 * lane); ss += v[j].x * v[j].x + v[j].y * v[j].y + v[j].z * v[j].z + v[j].w * v[j].w; }
        const float rstd = rsqrtf(wave_sum(ss) * (1.f / DM) + EPS);
#pragma unroll
        for (int j = 0; j < 4; ++j) { const int c0 = 256 * j + 4 * lane; const f32x4 gg = *(const f32x4*)(g + c0), s1 = *(const f32x4*)(sc + c0), s0 = *(const f32x4*)(sh + c0);
            const f32x4 o = v[j] * rstd * gg * (s1 + 1.f) + s0;
            *(uint2*)(XN + (size_t)row * DM + c0) = make_uint2(pg8::cvt_pk_bf16(o[0], o[1]), pg8::cvt_pk_bf16(o[2], o[3])); }
    }
}
__device__ __forceinline__ void ph_final_norm(float* x, const float* g) {
    int tid_ = threadIdx.x; asm volatile("" : "+v"(tid_));
    int bid_ = blockIdx.x, G_ = gridDim.x; asm volatile("" : "+s"(bid_), "+s"(G_));
    const int lane = tid_ & 63, gw = bid_ * NWAVES + (tid_ >> 6), ngw = G_ * NWAVES;
    for (int row = gw; row < MLAT; row += ngw) {
        float* xr = x + (size_t)row * DM;
        f32x4 v[4]; float ss = 0.f;
#pragma unroll
        for (int j = 0; j < 4; ++j) { v[j] = *(const f32x4*)(xr + 256 * j + 4 * lane); ss += v[j].x * v[j].x + v[j].y * v[j].y + v[j].z * v[j].z + v[j].w * v[j].w; }
        const float rstd = rsqrtf(wave_sum(ss) * (1.f / DM) + EPS);
#pragma unroll
        for (int j = 0; j < 4; ++j) { const int c0 = 256 * j + 4 * lane; const f32x4 gg = *(const f32x4*)(g + c0); *(f32x4*)(xr + c0) = v[j] * rstd * gg; }
    }
}


__device__ __forceinline__ void pro_transpose_item(const float* W, int K, int N, bf16_t* WT, bool swi, LAS float* scr, int item, int lane) {
    const int nblk = N / 32, kb = item / nblk, nb = item % nblk, k0 = 64 * kb, n0 = 32 * nb;
    int nd0 = n0; if (swi) { const int half = n0 >= FH, nn = half ? n0 - FH : n0; nd0 = 256 * (nn / 128) + 128 * half + (nn % 128); }
#pragma unroll 8
    for (int i = 0; i < 32; ++i) { const int kk = 2 * i + (lane >> 5); scr[kk * 33 + (lane & 31)] = W[(size_t)(k0 + kk) * N + n0 + (lane & 31)]; }
    asm volatile("s_waitcnt lgkmcnt(0)" ::: "memory");
    const int c = lane & 7;
#pragma unroll
    for (int j = 0; j < 4; ++j) { const int n = (lane >> 3) + 8 * j; const LAS float* s = scr + (8 * c) * 33 + n;
        u32x4 o; o.x = pg8::cvt_pk_bf16(s[0 * 33], s[1 * 33]); o.y = pg8::cvt_pk_bf16(s[2 * 33], s[3 * 33]); o.z = pg8::cvt_pk_bf16(s[4 * 33], s[5 * 33]); o.w = pg8::cvt_pk_bf16(s[6 * 33], s[7 * 33]);
        *(u32x4*)(WT + (size_t)(nd0 + n) * K + k0 + 8 * c) = o; }
    asm volatile("s_waitcnt lgkmcnt(0)" ::: "memory");
}
__device__ __forceinline__ void ph_prologue_a(KParams& p, LAS unsigned char* lds, int bid, int G, int tid) {
    unsigned char* ws = p.ws; const int lane = tid & 63, wid = __builtin_amdgcn_readfirstlane(tid >> 6);
    {
        LAS float* sc = (LAS float*)lds;
        LAS float* part = (LAS float*)(lds + 12288);
        if (bid < 288) {
            for (int i = tid; i < 3 * DM; i += NTHREADS) { const int mi = i >> 10, k = i & 1023; const float v = mi < 2 ? p.in[1][mi * DM + k] : p.in[3][k]; sc[i] = siluf_(v); }
            __syncthreads();
            for (int u = bid; u < 288; u += G) {
                const int l = u / 144, n0 = (u % 144) * 64;
                const float* wp = p.in[4] + (size_t)l * DM * NMODS * DM + (size_t)(wid * 128) * (NMODS * DM) + n0 + lane;
                float a0 = 0.f, a1 = 0.f, a2 = 0.f;
#pragma unroll 16
                for (int k = 0; k < 128; ++k) { const float wv = wp[(size_t)k * (NMODS * DM)]; const int kk = wid * 128 + k; a0 += sc[kk] * wv; a1 += sc[1024 + kk] * wv; a2 += sc[2048 + kk] * wv; }
                part[(wid * 3 + 0) * 64 + lane] = a0; part[(wid * 3 + 1) * 64 + lane] = a1; part[(wid * 3 + 2) * 64 + lane] = a2;
                __syncthreads();
                if (tid < 192) { const int mi = tid >> 6, c = tid & 63; float s = p.in[5][l * NMODS * DM + n0 + c];
#pragma unroll
                    for (int w8 = 0; w8 < 8; ++w8) s += part[(w8 * 3 + mi) * 64 + c];
                    ((float*)(ws + WS_MODS))[((size_t)l * 3 + mi) * NMODS * DM + n0 + c] = s; }
                __syncthreads();
            }
        }
    }
    if (bid == G - 1) {
        float* rope = (float*)(ws + WS_ROPE); float* lb = (float*)(ws + WS_LB);
        for (int i = tid; i < 2048; i += NTHREADS) { const int pos = i >> 4, f = i & 15; const float inv = powf(10000.f, -(float)f / 16.f); const float ang = (float)pos * inv; rope[i] = cosf(ang); rope[2048 + i] = sinf(ang); }
        if (tid < 512) { const float l0 = p.in[13][tid], l1 = p.in[13][512 + tid]; const float mx = fmaxf(l0, l1); const float e0 = expf(l0 - mx), e1 = expf(l1 - mx); lb[tid] = 0.f; lb[512 + tid] = e1 / (e0 + e1); }
    }
    rg_gate_weights_prep(p.in[17], p.in[19], (bf16_t*)(ws + WS_GW), bid, G, tid);
    {
        __syncthreads();
        LAS float* scr = (LAS float*)(lds + wid * 8448);
        constexpr int I_1IN = (DM / 64) * (2 * FH / 32), I_1OUT = (FH / 64) * (DM / 32), I_IN = (DM / 64) * (INW / 32), I_OUT = (DM / 64) * (DM / 32);
        constexpr int I_LAYER = 2 * I_1IN + 2 * I_1OUT + I_IN + I_OUT;
        const int gw = bid * NWAVES + wid, ngw = G * NWAVES;
        for (int it = gw; it < DEPTH * I_LAYER; it += ngw) {
            const int l = it / I_LAYER; int r = it % I_LAYER; unsigned char* wl = ws + WS_W + l * W_L_STRIDE;
            if (r < I_1IN) { pro_transpose_item(p.in[7] + (size_t)l * DM * 2 * FH, DM, 2 * FH, (bf16_t*)(wl + W_1IN), true, scr, r, lane); continue; } r -= I_1IN;
            if (r < I_1IN) { pro_transpose_item(p.in[23] + (size_t)l * DM * 2 * FH, DM, 2 * FH, (bf16_t*)(wl + W_2IN), true, scr, r, lane); continue; } r -= I_1IN;
            if (r < I_1OUT) { pro_transpose_item(p.in[8] + (size_t)l * FH * DM, FH, DM, (bf16_t*)(wl + W_1OUT), false, scr, r, lane); continue; } r -= I_1OUT;
            if (r < I_1OUT) { pro_transpose_item(p.in[24] + (size_t)l * FH * DM, FH, DM, (bf16_t*)(wl + W_2OUT), false, scr, r, lane); continue; } r -= I_1OUT;
            if (r < I_IN) { pro_transpose_item(p.in[10] + (size_t)l * DM * INW, DM, INW, (bf16_t*)(wl + W_IN), false, scr, r, lane); continue; } r -= I_IN;
            pro_transpose_item(p.in[11] + (size_t)l * DM * DM, DM, DM, (bf16_t*)(wl + W_OUT), false, scr, r, lane);
        }
        __syncthreads();
    }
}
__device__ __forceinline__ void run_phase(KParams& p, LAS unsigned char* lds, int ph) {
    unsigned char* ws = p.ws; float* out = p.out;
    float* mods = (float*)(ws + WS_MODS); float* rope = (float*)(ws + WS_ROPE); float* lb = (float*)(ws + WS_LB); float* xctx = (float*)(ws + WS_XCTX);
    bf16_t* XN = (bf16_t*)(ws + WS_XN); bf16_t* Y = XN; bf16_t* H = (bf16_t*)(ws + WS_H); bf16_t* P = H;
    int G = gridDim.x, bid = blockIdx.x, tid = threadIdx.x; asm volatile("" : "+s"(G), "+s"(bid), "+v"(tid));
    if (ph == PH_PRO_A) { ph_prologue_a(p, lds, bid, G, tid); return; }
    if (ph == PH_PRO_B) { ph_normmod(p.in[0], p.in[2], p.in[6], mods, 0, 1, XN, MTOT); return; }
    const int q = ph - PH_LAYER0, l = q / PH_PER_LAYER, s = q % PH_PER_LAYER;
    const bool wctx = l < DEPTH - 1; const int Mmix = wctx ? MTOT : MLAT;
    unsigned char* wl = ws + WS_W + l * W_L_STRIDE; const float* mods_l = mods + (size_t)l * 3 * NMODS * DM;
    const float* src_lat = l == 0 ? p.in[0] : out; const float* src_ctx = l == 0 ? p.in[2] : xctx;
    switch (s) {
    case S_FFN1_IN: case S_FFN2_IN: {
        const int M = s == S_FFN1_IN ? MTOT : Mmix;
        pg8::Gemm g{XN, (const bf16_t*)(wl + (s == S_FFN1_IN ? W_1IN : W_2IN)), M, 2 * FH, DM}; pg8::StaticOrder S; S.init(M, 2 * FH, G, bid);
        pg8::EpiSwiglu E{H, FH};
        pg8::gemm_phase<pg8::EpiSwiglu, pg8::StaticOrder, true, true>(lds, g, S, E);
    } break;
    case S_FFN1_OUT: case S_OUTPROJ: case S_FFN2_OUT: {
        const int M = s == S_FFN1_OUT ? MTOT : Mmix; const int K = s == S_OUTPROJ ? DM : FH;
        const bf16_t* A = s == S_OUTPROJ ? Y : H; const size_t wo = s == S_FFN1_OUT ? W_1OUT : (s == S_OUTPROJ ? W_OUT : W_2OUT);
        const int ig = s == S_FFN1_OUT ? 2 : (s == S_OUTPROJ ? 5 : 8);
        const float gsc = s == S_OUTPROJ ? 1.f : 0.5f;
        pg8::Gemm g{A, (const bf16_t*)(wl + wo), MLAT, DM, K}; pg8::StaticOrder S; S.init(MLAT, DM, G, bid);
        pg8::EpiResid E{s == S_FFN1_OUT ? src_lat : out, s == S_FFN1_OUT ? src_ctx : xctx, out, xctx, mods_l + ig * DM, gsc};
        pg8::gemm_phase<pg8::EpiResid, pg8::StaticOrder, true, true>(lds, g, S, E);
        if (M == MTOT) { for (int blk = bid; blk < 256; blk += G) ctx_mini_gemm(lds, A + (size_t)MLAT * K, (const bf16_t*)(wl + wo), K, s == S_FFN1_OUT ? src_ctx : xctx, xctx, mods_l + 2 * NMODS * DM + ig * DM, gsc, blk); }
    } break;
    case S_INPROJ: {
        pg8::Gemm g{XN, (const bf16_t*)(wl + W_IN), MTOT, INW, DM}; pg8::StaticOrder S; S.init(MTOT, INW, G, bid);
        pg8::EpiInproj E{P, rope, lb + l * 512};
        pg8::gemm_phase<pg8::EpiInproj, pg8::StaticOrder, true, true>(lds, g, S, E);
    } break;
    case S_NORM_MIX: ph_normmod(out, xctx, p.in[9] + l * DM, mods_l, 3, 4, XN, MTOT); break;
    case S_NORM_FFN2: ph_normmod(out, xctx, p.in[22] + l * DM, mods_l, 6, 7, XN, Mmix); break;
    case S_NEXT_NORM:
        if (l + 1 < DEPTH) ph_normmod(out, xctx, p.in[6] + (l + 1) * DM, mods_l + 3 * NMODS * DM, 0, 1, XN, MTOT);
        else ph_final_norm(out, p.in[25]);
        break;
    case S_MIX1: {
        { const int nat = wctx ? 264 : 256;
          for (int it = bid; it < nat; it += G) { if (it < 256) attn_unit(lds, P, p.in[12] + l * 8, Y, it >> 7, (it >> 1) & 63, it & 1, false); else { const int c = it - 256; attn_unit(lds, P, p.in[12] + l * 8, Y, c >> 2, (c >> 1) & 1, c & 1, true); } } }
        const RgW w{p.in[15] + l * 1024, p.in[16] + l * 256, p.in[18] + l * 512, p.in[20] + l * 512, p.in[21] + l * 512, (const bf16_t*)(ws + WS_GW) + (size_t)l * 65536};
        hgrn_local_phase_mfma(lds, P, (float*)(ws + WS_T), (float*)(ws + WS_HD), bid, G);
        for (int it = bid; it < 2 * NCHK; it += G) { const int b = it / NCHK, jj = it % NCHK; rg_item<false>(lds, P, w, b, jj < 4, jj < 4 ? jj : jj - 4, (float*)(ws + WS_RS), nullptr, Y); }
    } break;
    case S_MIX2: {
        const int gt = (bid - (G - 2)) * NTHREADS + tid;
        if (bid >= G - 2) rg_carry_scan(gt, (const float*)(ws + WS_RS), (float*)(ws + WS_RE));
        if (bid < 128) hgrn_state_scan(bid >> 3, (bid & 7) * NTHREADS + tid, (float*)(ws + WS_T), (const float*)(ws + WS_HD));
    } break;
    case S_MIX3: {
        const RgW w{p.in[15] + l * 1024, p.in[16] + l * 256, p.in[18] + l * 512, p.in[20] + l * 512, p.in[21] + l * 512, (const bf16_t*)(ws + WS_GW) + (size_t)l * 65536};
        { const int nhi = wctx ? 8 * NCHK : 8 * 128;
          for (int it = bid; it < nhi; it += G) { int bh, isctx, n; if (wctx) { bh = it / NCHK; const int jj = it % NCHK; isctx = jj < 4; n = isctx ? jj : jj - 4; } else { bh = it >> 7; isctx = 0; n = it & 127; }
              hgrn_out_item_mfma(lds, P, p.in[14] + l * 256, bh >> 2, bh & 3, isctx, n, (const float*)(ws + WS_T), Y); } }
        const int nit = wctx ? 2 * NCHK : 2 * 128;
        for (int it = bid; it < nit; it += G) { int b, isctx, n; if (wctx) { b = it / NCHK; const int jj = it % NCHK; isctx = jj < 4; n = isctx ? jj : jj - 4; } else { b = it >> 7; isctx = 0; n = it & 127; }
            rg_item<true>(lds, P, w, b, isctx, n, nullptr, (const float*)(ws + WS_RE), Y); }
    } break;
    default: break;
    }
}

__global__ void __launch_bounds__(NTHREADS, 2) mk(Params p) {
    extern __shared__ __attribute__((aligned(16))) unsigned char lds_raw[];
    LAS unsigned char* lds = (LAS unsigned char*)lds_raw;
    cg::grid_group grid = cg::this_grid();
    volatile LAS unsigned* xst = (volatile LAS unsigned*)(lds + LDS_XB);
    if (threadIdx.x < 16) xst[threadIdx.x] = 0u;
    __syncthreads();
    XcdBarrier bar = xcd_barrier_post((unsigned*)(p.ws + WS_CTL), xst);
    for (int ph = p.ph_lo; ph < p.ph_hi; ++ph) {
        KParams* kp = (KParams*)__builtin_amdgcn_kernarg_segment_ptr(); asm volatile("" : "+s"(kp));
        int nrep = 1;
#if PROBE_MASK
        { int bit = 0; if (ph == PH_PRO_A) bit = 8; else if (ph == PH_PRO_B) bit = 4; else { const int s_ = (ph - PH_LAYER0) % PH_PER_LAYER, l_ = (ph - PH_LAYER0) / PH_PER_LAYER;
            if (s_ == S_FFN1_IN || s_ == S_FFN2_IN || s_ == S_INPROJ) bit = 1; else if (s_ == S_MIX1) bit = 2; else if (s_ == S_MIX3) bit = 16; else if (s_ == S_NORM_MIX || s_ == S_NORM_FFN2 || (s_ == S_NEXT_NORM && l_ + 1 < DEPTH)) bit = 4;
            else if (s_ == S_FFN1_OUT && l_ == 0) bit = 32; }
          if (PROBE_MASK & bit) nrep = 2; }
#endif
        for (int rep = 0; rep < nrep; ++rep) { run_phase(*kp, lds, ph); if (rep + 1 < nrep) xcd_barrier(bar); }
        if (ph + 1 < p.ph_hi) { if (ph == p.ph_lo) grid.sync(); else xcd_barrier(bar); }
    }
}
}

extern "C" void kernel_launch(void* const* d_in, const int* in_sizes, int n_in, void* d_out, int out_size, void* d_ws, size_t ws_size, hipStream_t stream) {
    if (n_in != 26 || out_size != MLAT * DM || ws_size < WS_END) { fprintf(stderr, "kernel_launch: unexpected problem (n_in %d out %d ws %zu)\n", n_in, out_size, ws_size); return; }
    static int grid = 0;
    if (grid == 0) {
        int dev = 0, cus = 0, per_cu = 0;
        hipGetDevice(&dev); hipDeviceGetAttribute(&cus, hipDeviceAttributeMultiprocessorCount, dev);
        hipFuncSetAttribute((const void*)mk, hipFuncAttributeMaxDynamicSharedMemorySize, LDS_BYTES);
        hipOccupancyMaxActiveBlocksPerMultiprocessor(&per_cu, (const void*)mk, NTHREADS, LDS_BYTES);
        if (per_cu < 1) { fprintf(stderr, "kernel_launch: occupancy query says %d blocks per CU\n", per_cu); per_cu = 1; }
        grid = cus * (per_cu < 1 ? 1 : 1);
        (void)hipGetLastError();
    }
    unsigned char* ws = (unsigned char*)d_ws;
    Params prm{}; for (int i = 0; i < 26; ++i) prm.in[i] = (const float*)d_in[i]; prm.out = (float*)d_out; prm.ws = ws;
    prm.ph_lo = 0; prm.ph_hi = N_PHASES;
    if (hipMemsetAsync(ws + WS_CTL, 0, CTL_ZERO_BYTES, stream) != hipSuccess) { fprintf(stderr, "kernel_launch: memset failed\n"); return; }
    void* args[] = {&prm};
    const hipError_t le = hipLaunchCooperativeKernel((const void*)mk, dim3(grid), dim3(NTHREADS), args, LDS_BYTES, stream);
    if (le != hipSuccess) fprintf(stderr, "kernel_launch: cooperative launch failed: %s (grid %d)\n", hipGetErrorString(le), grid);
}
```
